# Optimizing an MI355X kernel written in HIP

```python
import jax, jax.numpy as jnp
from jax import lax
import numpy as np

D_MODEL = 1024
BATCH = 8
SEQ = 2048
DEPTH = 2
DEC_BATCH = 128
DEC_SEQ = 4
PAST_LEN = 2048
PAGE_SIZE = 128

N_META = 16
N_A_LAYERS = (DEPTH + 1) // 2
N_C_LAYERS = DEPTH // 2
W_A = D_MODEL // 2
H_A = 8
DH_A = W_A // H_A
Q_BLOCK = 128
SB_BIAS_INIT = -6.0
W_B = D_MODEL // 2
POOL_WINDOWS = (2, 4, 8, 16)
POOL_GROUPS = len(POOL_WINDOWS)
POOL_GC = W_B // POOL_GROUPS
POOL_MAX = max(POOL_WINDOWS)
INNER_C = 2 * D_MODEL
H_C = 4
DH_C = INNER_C // H_C
CONV_W = 4
CHUNK = 128
EPS = 1e-6
F32 = jnp.float32

kernel_name = 'hybrid_stickbreak_pool_mlstm_decoder_step'


def rmsnorm(x, g):
    xf = x.astype(F32)
    y = xf * lax.rsqrt(jnp.mean(xf * xf, axis=-1, keepdims=True) + EPS)
    return (y * g.astype(F32)).astype(x.dtype)


def sb_block(q, k, v, bias, q_pos, k_pos):
    z = jnp.einsum('bqhd,bkhd->bhqk', q.astype(F32), k.astype(F32)) * (DH_A ** -0.5)
    z = z + bias.astype(F32)[None, :, None, None]
    mask = k_pos[None, :] < q_pos[:, None]
    lneg = jnp.where(mask, jax.nn.log_sigmoid(-z), 0.0)
    tail = lax.cumsum(lneg, axis=3, reverse=True) - lneg
    a = jnp.where(mask, jnp.exp(jax.nn.log_sigmoid(z) + tail), 0.0)
    return jnp.einsum('bhqk,bkhd->bqhd', a, v.astype(F32))


def sb_prompt(q, k, v, bias):
    B, L = q.shape[0], q.shape[1]
    pos = jnp.arange(L)
    o_meta = sb_block(q[:, :N_META], k[:, :N_META], v[:, :N_META], bias, pos[:N_META], pos[:N_META])
    nb = (L - N_META) // Q_BLOCK
    qb = jnp.moveaxis(q[:, N_META:].reshape(B, nb, Q_BLOCK, H_A, DH_A), 1, 0)
    pb = pos[N_META:].reshape(nb, Q_BLOCK)
    o_real = lax.map(lambda a: sb_block(a[0], k, v, bias, a[1], pos), (qb, pb))
    o_real = jnp.moveaxis(o_real, 0, 1).reshape(B, L - N_META, H_A, DH_A)
    return jnp.concatenate([o_meta, o_real], axis=1)


def pool_mix(u_ext, pos, w_pool, scale):
    P = POOL_MAX - 1
    B, Lx, _ = u_ext.shape
    T = Lx - P
    uf = u_ext.astype(F32)
    cs = jnp.concatenate([jnp.zeros((B, 1, W_B), F32), jnp.cumsum(uf, axis=1)], axis=1)
    means = []
    for g, w in enumerate(POOL_WINDOWS):
        c0 = g * POOL_GC
        win = cs[:, P + 1:P + 1 + T, c0:c0 + POOL_GC] - cs[:, P + 1 - w:P + 1 - w + T, c0:c0 + POOL_GC]
        cnt = jnp.minimum(w, pos + 1).astype(F32)
        means.append(win / cnt[None, :, None])
    mean = jnp.stack(means, axis=2)
    diff = mean - uf[:, P:].reshape(B, T, POOL_GROUPS, POOL_GC)
    y = jnp.einsum('btgc,gce->btge', diff, w_pool.astype(F32)).reshape(B, T, W_B)
    return y * scale.astype(F32)


def even_mixer(xn, pos, pool_prefix, sb_fn, w_in, w_out, sb_bias, w_pool, pool_scale):
    B, T, _ = xn.shape
    proj = xn @ w_in
    q = proj[..., 0:W_A].reshape(B, T, H_A, DH_A)
    k = proj[..., W_A:2 * W_A].reshape(B, T, H_A, DH_A)
    v = proj[..., 2 * W_A:3 * W_A].reshape(B, T, H_A, DH_A)
    g_a = proj[..., 3 * W_A:4 * W_A].astype(F32)
    u = proj[..., 4 * W_A:4 * W_A + W_B]
    g_b = proj[..., 4 * W_A + W_B:].astype(F32)
    o_a = sb_fn(q, k, v, sb_bias).reshape(B, T, W_A)
    u_ext = jnp.concatenate([pool_prefix.astype(u.dtype), u], axis=1)
    o_b = pool_mix(u_ext, pos, w_pool, pool_scale)
    mixed = jnp.concatenate([o_a * jax.nn.silu(g_a), o_b * jax.nn.silu(g_b)], axis=-1).astype(xn.dtype)
    return mixed @ w_out, k, v, u_ext[:, -(POOL_MAX - 1):]


def mlstm_chunk(C, n, m, q, k, v, logi, logf):
    C = C.astype(F32)
    n = n.astype(F32)
    m = m.astype(F32)
    T = q.shape[2]
    b = jnp.cumsum(logf, axis=-1)
    causal = jnp.tril(jnp.ones((T, T), dtype=bool))
    d = jnp.where(causal, b[..., :, None] - b[..., None, :] + logi[..., None, :], -jnp.inf)
    m_inter = b + m[..., None]
    m_t = jnp.maximum(m_inter, jnp.max(d, axis=-1))
    w_inter = jnp.exp(m_inter - m_t)
    s = jnp.einsum('bhtd,bhsd->bhts', q, k) * jnp.exp(d - m_t[..., None])
    num = w_inter[..., None] * jnp.einsum('bhtd,bhde->bhte', q, C) + jnp.einsum('bhts,bhse->bhte', s, v)
    den = w_inter * jnp.einsum('bhtd,bhd->bht', q, n) + jnp.sum(s, axis=-1)
    h = num / jnp.maximum(jnp.abs(den), jnp.exp(-m_t))[..., None]
    m_new = m_t[..., -1]
    w_s = jnp.exp(b[..., -1:] - b + logi - m_new[..., None])
    decay = jnp.exp(b[..., -1] + m - m_new)
    C_new = decay[..., None, None] * C + jnp.einsum('bhsd,bhse->bhde', k * w_s[..., None], v)
    n_new = decay[..., None] * n + jnp.einsum('bhs,bhsd->bhd', w_s, k)
    return h, C_new, n_new, m_new


def mlstm_prompt(state, q, k, v, logi, logf):
    B, H, L, _ = q.shape
    h_meta, C, n, m = mlstm_chunk(*state, q[:, :, :N_META], k[:, :, :N_META], v[:, :, :N_META],
                                  logi[:, :, :N_META], logf[:, :, :N_META])
    nc = (L - N_META) // CHUNK

    def to_chunks(a):
        a = a[:, :, N_META:]
        return jnp.moveaxis(a.reshape((B, H, nc, CHUNK) + a.shape[3:]), 2, 0)

    def step(carry, xs):
        h, C1, n1, m1 = mlstm_chunk(*carry, *xs)
        return (C1, n1, m1), h

    (C, n, m), hs = lax.scan(step, (C, n, m), tuple(to_chunks(a) for a in (q, k, v, logi, logf)))
    hs = jnp.moveaxis(hs, 0, 2).reshape(B, H, L - N_META, DH_C)
    return jnp.concatenate([h_meta, hs], axis=2), C, n, m


def mlstm_sample(state, q, k, v, logi, logf):
    return mlstm_chunk(*state, q, k, v, logi, logf)


def head_layernorm(h, g):
    mu = jnp.mean(h, axis=-1, keepdims=True)
    var = jnp.mean(jnp.square(h - mu), axis=-1, keepdims=True)
    hn = (h - mu) * lax.rsqrt(var + EPS)
    B, H, T, dh = h.shape
    return jnp.transpose(hn, (0, 2, 1, 3)).reshape(B, T, H * dh) * g.astype(F32)


def odd_mixer(xn, conv_prefix, state, scan_fn, w_in, b_gate, conv_w, conv_b, w_q, w_k, w_v, skip, on_g, w_out):
    B, T, _ = xn.shape
    proj = xn @ w_in
    xm = proj[..., :INNER_C]
    z = proj[..., INNER_C:2 * INNER_C].astype(F32)
    gates = (proj[..., 2 * INNER_C:] + b_gate).astype(F32)
    logi = jnp.transpose(gates[..., :H_C], (0, 2, 1))
    logf = jnp.transpose(jax.nn.log_sigmoid(gates[..., H_C:]), (0, 2, 1))
    xm_ext = jnp.concatenate([conv_prefix.astype(xm.dtype), xm], axis=1)
    conv = conv_b.astype(F32)
    for j in range(CONV_W):
        conv = conv + xm_ext[:, j:j + T].astype(F32) * conv_w[j].astype(F32)
    ca = jax.nn.silu(conv)
    ca_h = ca.reshape(B, T, H_C, DH_C)
    q = jnp.einsum('bthd,hde->bhte', ca_h, w_q.astype(F32))
    k = jnp.einsum('bthd,hde->bhte', ca_h, w_k.astype(F32)) * (DH_C ** -0.5)
    v = jnp.einsum('bthd,hde->bhte', xm.astype(F32).reshape(B, T, H_C, DH_C), w_v.astype(F32))
    h, C, n, m = scan_fn(state, q, k, v, logi, logf)
    out = (head_layernorm(h, on_g) + skip.astype(F32) * ca) * jax.nn.silu(z)
    return out.astype(xn.dtype) @ w_out, C, n, m, xm_ext[:, -(CONV_W - 1):]


def setup_inputs(seed: int = 0) -> dict:
    key = jax.random.key(seed)
    ks = jax.random.split(key, 32)
    n_pages = PAST_LEN // PAGE_SIZE
    n_used = DEC_BATCH * n_pages
    n_pool = n_used + max(1, n_used // 4)
    perm = jax.random.permutation(ks[0], n_pool)
    page_table = perm[:n_used].reshape(DEC_BATCH, n_pages).astype(jnp.int32)

    def nrm(k, shape, s):
        return jax.random.normal(k, shape, F32) * s

    b_i = nrm(ks[21], (N_C_LAYERS, H_C), 0.1)
    b_f = jnp.linspace(3.0, 6.0, H_C, dtype=F32)[None, :] + nrm(ks[22], (N_C_LAYERS, H_C), 0.1)
    return {
        'x_prompt': nrm(ks[1], (BATCH, SEQ, D_MODEL), 1.0),
        'x_sample': nrm(ks[2], (DEC_BATCH, DEC_SEQ, D_MODEL), 1.0),
        'cache_sb_k': nrm(ks[3], (N_A_LAYERS, n_pool, PAGE_SIZE, H_A, DH_A), 1.0),
        'cache_sb_v': nrm(ks[4], (N_A_LAYERS, n_pool, PAGE_SIZE, H_A, DH_A), 1.0),
        'page_table': page_table,
        'state_pool': nrm(ks[5], (N_A_LAYERS, DEC_BATCH, POOL_MAX - 1, W_B), 1.0),
        'state_C': nrm(ks[6], (N_C_LAYERS, DEC_BATCH, H_C, DH_C, DH_C), 0.02),
        'state_n': nrm(ks[7], (N_C_LAYERS, DEC_BATCH, H_C, DH_C), 0.1),
        'state_m': nrm(ks[8], (N_C_LAYERS, DEC_BATCH, H_C), 1.0),
        'state_conv': nrm(ks[9], (N_C_LAYERS, DEC_BATCH, CONV_W - 1, INNER_C), 1.0),
        'meta_tokens': nrm(ks[10], (N_META, D_MODEL), 1.0),
        'norm_g': 1.0 + nrm(ks[11], (DEPTH, D_MODEL), 0.02),
        'final_norm_g': 1.0 + nrm(ks[12], (D_MODEL,), 0.02),
        'w_in_a': nrm(ks[13], (N_A_LAYERS, D_MODEL, 4 * W_A + 2 * W_B), D_MODEL ** -0.5),
        'w_out_a': nrm(ks[14], (N_A_LAYERS, W_A + W_B, D_MODEL), (W_A + W_B) ** -0.5),
        'sb_bias': SB_BIAS_INIT + nrm(ks[28], (N_A_LAYERS, H_A), 0.1),
        'w_pool': nrm(ks[15], (N_A_LAYERS, POOL_GROUPS, POOL_GC, POOL_GC), POOL_GC ** -0.5),
        'pool_scale': 1.0 + nrm(ks[16], (N_A_LAYERS, W_B), 0.1),
        'w_in_c': nrm(ks[17], (N_C_LAYERS, D_MODEL, 2 * INNER_C + 2 * H_C), D_MODEL ** -0.5),
        'b_gate_c': jnp.concatenate([b_i, b_f], axis=-1),
        'conv_w': nrm(ks[18], (N_C_LAYERS, CONV_W, INNER_C), CONV_W ** -0.5),
        'conv_b': nrm(ks[19], (N_C_LAYERS, INNER_C), 0.02),
        'w_q': nrm(ks[20], (N_C_LAYERS, H_C, DH_C, DH_C), DH_C ** -0.5),
        'w_k': nrm(ks[23], (N_C_LAYERS, H_C, DH_C, DH_C), DH_C ** -0.5),
        'w_v': nrm(ks[24], (N_C_LAYERS, H_C, DH_C, DH_C), DH_C ** -0.5),
        'skip_c': 1.0 + nrm(ks[25], (N_C_LAYERS, INNER_C), 0.1),
        'outnorm_g': 1.0 + nrm(ks[26], (N_C_LAYERS, INNER_C), 0.02),
        'w_out_c': nrm(ks[27], (N_C_LAYERS, INNER_C, D_MODEL), INNER_C ** -0.5),
    }


def reference(x_prompt, x_sample, cache_sb_k, cache_sb_v, page_table, state_pool, state_C, state_n, state_m,
              state_conv, meta_tokens, norm_g, final_norm_g, w_in_a, w_out_a, sb_bias, w_pool, pool_scale, w_in_c,
              b_gate_c, conv_w, conv_b, w_q, w_k, w_v, skip_c, outnorm_g, w_out_c):
    Bp = x_prompt.shape[0]
    Bs, Ts, _ = x_sample.shape
    past = page_table.shape[1] * cache_sb_k.shape[2]
    meta = jnp.broadcast_to(meta_tokens.astype(x_prompt.dtype)[None], (Bp, N_META, D_MODEL))
    h_p = jnp.concatenate([meta, x_prompt], axis=1)
    h_s = x_sample
    pos_p = jnp.arange(h_p.shape[1])
    pos_s = past + jnp.arange(Ts)
    kpos_s = jnp.arange(past + Ts)
    sbk_p, sbv_p, sbk_s, sbv_s, pool_p, pool_s = [], [], [], [], [], []
    C_p, C_s, n_p, n_s, m_p, m_s, cv_p, cv_s = [], [], [], [], [], [], [], []
    for layer in range(DEPTH):
        if layer % 2 == 0:
            ie = layer // 2
            wa = (w_in_a[ie], w_out_a[ie], sb_bias[ie], w_pool[ie], pool_scale[ie])
            zeros_pool = jnp.zeros((Bp, POOL_MAX - 1, W_B), h_p.dtype)
            y, k, v, pst = even_mixer(rmsnorm(h_p, norm_g[layer]), pos_p, zeros_pool, sb_prompt, *wa)
            h_p = h_p + y
            sbk_p.append(k)
            sbv_p.append(v)
            pool_p.append(pst)
            k_past = cache_sb_k[ie][page_table].reshape(Bs, past, H_A, DH_A)
            v_past = cache_sb_v[ie][page_table].reshape(Bs, past, H_A, DH_A)

            def sb_sample(q, k, v, bias, k_past=k_past, v_past=v_past):
                k_all = jnp.concatenate([k_past.astype(k.dtype), k], axis=1)
                v_all = jnp.concatenate([v_past.astype(v.dtype), v], axis=1)
                return sb_block(q, k_all, v_all, bias, pos_s, kpos_s)

            y, k, v, pst = even_mixer(rmsnorm(h_s, norm_g[layer]), pos_s, state_pool[ie], sb_sample, *wa)
            h_s = h_s + y
            sbk_s.append(k)
            sbv_s.append(v)
            pool_s.append(pst)
        else:
            io = layer // 2
            wc = (w_in_c[io], b_gate_c[io], conv_w[io], conv_b[io], w_q[io], w_k[io], w_v[io],
                  skip_c[io], outnorm_g[io], w_out_c[io])
            init = (jnp.zeros((Bp, H_C, DH_C, DH_C), F32), jnp.zeros((Bp, H_C, DH_C), F32),
                    jnp.zeros((Bp, H_C), F32))
            zeros_conv = jnp.zeros((Bp, CONV_W - 1, INNER_C), h_p.dtype)
            y, C, n, m, cv = odd_mixer(rmsnorm(h_p, norm_g[layer]), zeros_conv, init, mlstm_prompt, *wc)
            h_p = h_p + y
            C_p.append(C)
            n_p.append(n)
            m_p.append(m)
            cv_p.append(cv)
            st = (state_C[io], state_n[io], state_m[io])
            y, C, n, m, cv = odd_mixer(rmsnorm(h_s, norm_g[layer]), state_conv[io], st, mlstm_sample, *wc)
            h_s = h_s + y
            C_s.append(C)
            n_s.append(n)
            m_s.append(m)
            cv_s.append(cv)
    y_prompt = rmsnorm(h_p, final_norm_g)[:, N_META:]
    y_sample = rmsnorm(h_s, final_norm_g)
    return (y_prompt, y_sample,
            jnp.stack(sbk_p), jnp.stack(sbv_p), jnp.stack(sbk_s), jnp.stack(sbv_s),
            jnp.stack(pool_p), jnp.stack(pool_s),
            jnp.stack(C_p), jnp.stack(C_s), jnp.stack(n_p), jnp.stack(n_s),
            jnp.stack(m_p), jnp.stack(m_s), jnp.stack(cv_p), jnp.stack(cv_s))
```

```cpp
#include <hip/hip_runtime.h>
#include <cstdio>
#include <cstdint>

#define LAS __attribute__((address_space(3)))
#define DI __device__ __forceinline__

typedef unsigned short bf16_t;
typedef short bf16x8 __attribute__((ext_vector_type(8)));
typedef short bf16x4 __attribute__((ext_vector_type(4)));
typedef float f32x4 __attribute__((ext_vector_type(4)));
typedef float f32x2 __attribute__((ext_vector_type(2)));
typedef float f32x16 __attribute__((ext_vector_type(16)));
typedef unsigned u32x4 __attribute__((ext_vector_type(4)));
typedef unsigned u32x2 __attribute__((ext_vector_type(2)));
typedef __bf16 bf16v2 __attribute__((ext_vector_type(2)));

constexpr int D = 1024, BP = 8, SEQ = 2048, NMETA = 16, LP = NMETA + SEQ  , MP = BP * LP  ;
constexpr int BS = 128, TS = 4, MS = BS * TS  , MT = MP + MS  , MPAD = 17152  ;
constexpr int WA = 512, HA = 8, DHA = 64, WB = 512, NG = 4, GC = 128, PMAX = 16;
constexpr int INNER = 2048, HC = 4, DHC = 512, NCH = 17;
constexpr int NPAGES = 16, PAGE = 128, NPOOL = 2560;
constexpr int LPV = 2112;
constexpr int NA = 3072, NC = 4104;
constexpr float EPS = 1e-6f;
constexpr int NSEQ = BP * HC + BS * HC;

constexpr size_t O_YP = 0;
constexpr size_t O_YS = O_YP + (size_t)BP * SEQ * D;
constexpr size_t O_KP = O_YS + (size_t)MS * D;
constexpr size_t O_VP = O_KP + (size_t)MP * WA;
constexpr size_t O_KS = O_VP + (size_t)MP * WA;
constexpr size_t O_VS = O_KS + (size_t)MS * WA;
constexpr size_t O_POOLP = O_VS + (size_t)MS * WA;
constexpr size_t O_POOLS = O_POOLP + (size_t)BP * 15 * WB;
constexpr size_t O_CP = O_POOLS + (size_t)BS * 15 * WB;
constexpr size_t O_CS = O_CP + (size_t)BP * HC * DHC * DHC;
constexpr size_t O_NP = O_CS + (size_t)BS * HC * DHC * DHC;
constexpr size_t O_NS = O_NP + (size_t)BP * HC * DHC;
constexpr size_t O_MP = O_NS + (size_t)BS * HC * DHC;
constexpr size_t O_MS = O_MP + (size_t)BP * HC;
constexpr size_t O_CVP = O_MS + (size_t)BS * HC;
constexpr size_t O_CVS = O_CVP + (size_t)BP * 3 * INNER;
constexpr size_t O_END = O_CVS + (size_t)BS * 3 * INNER;

constexpr size_t al256(size_t x) { return (x + 255) & ~(size_t)255; }
constexpr size_t WS_CTL = 0;
constexpr size_t WS_H = 65536;
constexpr size_t WS_XN = al256(WS_H + (size_t)MPAD * D * 2);
constexpr size_t WS_WTINA = al256(WS_XN + (size_t)MPAD * D * 2);
constexpr size_t WS_WTOUTA = al256(WS_WTINA + (size_t)NA * D * 2);
constexpr size_t WS_WTPOOL = al256(WS_WTOUTA + (size_t)D * D * 2);
constexpr size_t WS_WTINC = al256(WS_WTPOOL + (size_t)NG * GC * GC * 2);
constexpr size_t WS_WG = al256(WS_WTINC + (size_t)4096 * D * 2);
constexpr size_t WS_WTQ = al256(WS_WG + (size_t)8 * D * 4);
constexpr size_t WS_WTK = WS_WTQ + (size_t)HC * DHC * DHC * 2;
constexpr size_t WS_WTV = al256(WS_WTK + (size_t)HC * DHC * DHC * 2);
constexpr size_t WS_WTOUTC = al256(WS_WTV + (size_t)HC * DHC * DHC * 2);
constexpr size_t WS_PROJA = al256(WS_WTOUTC + (size_t)D * INNER * 2);
constexpr size_t WS_U32 = al256(WS_PROJA + (size_t)MPAD * NA * 2);
constexpr size_t WS_VTA = al256(WS_U32 + (size_t)MPAD * WB * 4);
constexpr size_t WS_MIXED = al256(WS_VTA + (size_t)BP * WA * LPV * 2);
constexpr size_t WS_SPART = al256(WS_MIXED + (size_t)MPAD * D * 2);
constexpr size_t WS_ST = al256(WS_SPART + (size_t)BS * NPAGES * HA * TS * DHA * 4);
constexpr size_t WS_LOGI = al256(WS_ST + (size_t)BS * NPAGES * 32 * 4);
constexpr size_t WS_LOGF = al256(WS_LOGI + (size_t)MPAD * 4 * 4);
constexpr size_t WS_SA = al256(WS_LOGF + (size_t)MPAD * 4 * 4);
constexpr size_t WS_SM = al256(WS_SA + (size_t)MPAD * 4 * 4);
constexpr size_t WS_SB = al256(WS_SM + (size_t)MPAD * 4 * 4);
constexpr size_t WS_MPREV = al256(WS_SB + (size_t)MPAD * 4 * 4);
constexpr size_t WS_MTOP = al256(WS_MPREV + (size_t)(32 * NCH + 512) * 4);
constexpr size_t WS_XMZ = al256(WS_MTOP + (size_t)(32 * NCH + 512) * 4);
constexpr size_t WS_CA = al256(WS_XMZ + (size_t)MPAD * 4096 * 2);
constexpr size_t WS_QC = al256(WS_CA + (size_t)MPAD * INNER * 2);
constexpr size_t WS_KC = al256(WS_QC + (size_t)MPAD * INNER * 2);
constexpr size_t WS_KTC = al256(WS_KC + (size_t)MPAD * INNER * 2);
constexpr size_t WS_VTC = al256(WS_KTC + (size_t)32 * 17 * 65536 * 2);
constexpr size_t WS_SD = al256(WS_VTC + (size_t)MPAD * INNER * 2);
constexpr size_t WS_RS = al256(WS_SD + (size_t)32 * NCH * 128 * 128 * 2);
constexpr size_t WS_DN = al256(WS_RS + (size_t)32 * NCH * 128 * 4);
constexpr size_t WS_HH = al256(WS_DN + (size_t)32 * NCH * 512 * 4);
constexpr size_t WS_A2 = al256(WS_HH + (size_t)MPAD * INNER * 2);
constexpr size_t WS_PART = al256(WS_A2 + (size_t)MPAD * INNER * 2);
constexpr size_t WS_QF = al256(WS_PART + (size_t)8 * 768 * D * 4);
constexpr size_t WS_END = al256(WS_QF + (size_t)32 * 17 * 65536 * 2);

constexpr int MMAIN = 16384;
constexpr int LDS_BYTES = 147456;
constexpr int LDS_CTL_OFF = 147456 - 256;
constexpr int NTHREADS = 512;

struct Params {
    const float* in[28];
    float* out;
    unsigned char* ws;
    int ph_lo, ph_hi;
};

DI unsigned pk2(float a, float b) { bf16v2 v = __builtin_convertvector((f32x2){a, b}, bf16v2); return __builtin_bit_cast(unsigned, v); }
DI bf16_t f2bf(float a) { return (bf16_t)(pk2(a, 0.f) & 0xffffu); }
DI float bf2f(bf16_t v) { return __uint_as_float(((unsigned)v) << 16); }
DI float bflo(unsigned w) { return __uint_as_float(w << 16); }
DI float bfhi(unsigned w) { return __uint_as_float(w & 0xffff0000u); }
DI float wave_sum_bperm(float v) {
#pragma unroll
    for (int o = 32; o > 0; o >>= 1) v += __shfl_xor(v, o);
    return v;
}
template <int CTRL> DI float dpp_mov_f(float v) { return __builtin_bit_cast(float, __builtin_amdgcn_update_dpp(0, __builtin_bit_cast(int, v), CTRL, 0xF, 0xF, false)); }
template <int CTRL> DI float dpp_shl_zero(float v) { return __builtin_bit_cast(float, __builtin_amdgcn_update_dpp(0, __builtin_bit_cast(int, v), CTRL, 0xF, 0xF, true)); }
DI float row16_sum(float v) { v += dpp_mov_f<0x128>(v); v += dpp_mov_f<0x124>(v); v += dpp_mov_f<0x122>(v); v += dpp_mov_f<0x121>(v); return v; }
template <int CTRL, int RMASK> DI float dpp_old_f(float old, float v) { return __builtin_bit_cast(float, __builtin_amdgcn_update_dpp(__builtin_bit_cast(int, old), __builtin_bit_cast(int, v), CTRL, RMASK, 0xF, false)); }
DI float wave_scan_add(float v) {
    v += dpp_old_f<0x111, 0xF>(0.f, v); v += dpp_old_f<0x112, 0xF>(0.f, v); v += dpp_old_f<0x114, 0xF>(0.f, v); v += dpp_old_f<0x118, 0xF>(0.f, v);
    v += dpp_old_f<0x142, 0xA>(0.f, v); v += dpp_old_f<0x143, 0xC>(0.f, v);
    return v;
}
DI float wave_scan_max(float v) {
    const float ninf = -INFINITY;
    v = fmaxf(v, dpp_old_f<0x111, 0xF>(ninf, v)); v = fmaxf(v, dpp_old_f<0x112, 0xF>(ninf, v)); v = fmaxf(v, dpp_old_f<0x114, 0xF>(ninf, v)); v = fmaxf(v, dpp_old_f<0x118, 0xF>(ninf, v));
    v = fmaxf(v, dpp_old_f<0x142, 0xA>(ninf, v)); v = fmaxf(v, dpp_old_f<0x143, 0xC>(ninf, v));
    return v;
}
DI float wave_sum(float v) { v = row16_sum(v); v += __shfl_xor(v, 16); v += __shfl_xor(v, 32); return v; }
DI float softplus_f(float z) {
    const float t = __expf(-fabsf(z));
    const float l = (t < 0.02f) ? t * (1.f - t * (0.5f - t * (0.33333333f - 0.25f * t))) : __logf(1.f + t);
    return fmaxf(z, 0.f) + l;
}
DI float silu_f(float x) { return x / (1.f + __expf(-x)); }
DI bf16x8 pack8(const f32x16& x, int s) {
    u32x4 p;
    p.x = pk2(x[8 * s + 0], x[8 * s + 1]); p.y = pk2(x[8 * s + 2], x[8 * s + 3]); p.z = pk2(x[8 * s + 4], x[8 * s + 5]); p.w = pk2(x[8 * s + 6], x[8 * s + 7]);
    return __builtin_bit_cast(bf16x8, p);
}
DI bf16x8 cat4(bf16x4 a, bf16x4 b) { return __builtin_shufflevector(a, b, 0, 1, 2, 3, 4, 5, 6, 7); }
#define MFMA32(a, b, c) __builtin_amdgcn_mfma_f32_32x32x16_bf16((a), (b), (c), 0, 0, 0)
DI f32x16 zero16() { f32x16 z;
#pragma unroll
    for (int i = 0; i < 16; ++i) z[i] = 0.f;
    return z; }
DI int crow(int reg, int h) { return (reg & 3) + 8 * (reg >> 2) + 4 * h; }

#define XB_TMO      128
#define XB_XCNT(j)  (256  + 64 * (j))
#define XB_XSUB(j)  (1280 + 64 * (j))
#define XB_XGEN(j)  (2304 + 64 * (j))
#define XB_TOP      3328
#define XB_TOPGEN   3392
#define XCD_BAR_WORDS 3456
#define XB_SPIN_CAP (1u << 18)

__device__ __forceinline__ unsigned xb_ld(unsigned* p)              { return __hip_atomic_load(p, __ATOMIC_RELAXED, __HIP_MEMORY_SCOPE_AGENT); }
__device__ __forceinline__ unsigned xb_add(unsigned* p, unsigned v) { return __hip_atomic_fetch_add(p, v, __ATOMIC_RELAXED, __HIP_MEMORY_SCOPE_AGENT); }
__device__ __forceinline__ unsigned xb_xcc_id() { return (unsigned)__builtin_amdgcn_s_getreg((3 << 11) | 20) & 0xFu; }
#define XB_SPIN(cond, bar) do { unsigned _sp = 0; while (cond) { __builtin_amdgcn_s_sleep(1); \
    if ((++_sp & 255u) == 0u) { if (xb_ld(&(bar)[XB_TMO])) break; if (_sp > XB_SPIN_CAP) { atomicAdd(&(bar)[XB_TMO], 1u); break; } } } } while (0)

struct XcdBarrier { unsigned* bar; unsigned x; volatile LAS unsigned* st; };

__device__ __forceinline__ XcdBarrier xcd_barrier_post(unsigned* bar, volatile LAS unsigned* st) {
    XcdBarrier b; b.bar = bar; b.x = xb_xcc_id(); b.st = st;
    if (threadIdx.x == 0) (void)xb_add(&bar[XB_XCNT(b.x)], 1u);
    return b;
}
__device__ __forceinline__ void xcd_barrier_complete(unsigned* bar, unsigned x, unsigned& nloc, unsigned& nx) {
    const unsigned G = gridDim.x * gridDim.y * gridDim.z;
    unsigned sum, cnt, mine, sp = 0u;
    for (;;) {
        sum = 0u; cnt = 0u; mine = 0u;
#pragma unroll
        for (unsigned j = 0; j < 16; ++j) { const unsigned c = xb_ld(&bar[XB_XCNT(j)]); sum += c; cnt += (c > 0u) ? 1u : 0u; mine = (j == x) ? c : mine; }
        if (sum == G) break;
        __builtin_amdgcn_s_sleep(1);
        if ((++sp & 255u) == 0u) { if (xb_ld(&bar[XB_TMO])) break; if (sp > XB_SPIN_CAP) { atomicAdd(&bar[XB_TMO], 1u); break; } }
    }
    nloc = mine > 0u ? mine : 1u; nx = cnt > 0u ? cnt : 1u;
}
__device__ __forceinline__ void xcd_barrier(const XcdBarrier& b) {
    asm volatile("s_waitcnt vmcnt(0)" ::: "memory");
    __syncthreads();
    if (threadIdx.x == 0) {
        unsigned* bar = b.bar;
        __builtin_amdgcn_s_waitcnt(0);
        unsigned nloc = b.st[0], nx = b.st[1];
        if (nloc == 0u) { xcd_barrier_complete(bar, b.x, nloc, nx); b.st[0] = nloc; b.st[1] = nx; }
        const unsigned old = xb_add(&bar[XB_XSUB(b.x)], 1u);
        const unsigned gen = old / nloc;
        if (old + 1u == (gen + 1u) * nloc) {
            __builtin_amdgcn_fence(__ATOMIC_RELEASE, "agent");
            asm volatile("s_waitcnt vmcnt(0)" ::: "memory");
            const unsigned og = xb_add(&bar[XB_TOP], 1u);
            const unsigned tg = og / nx;
            if (og + 1u == (tg + 1u) * nx) xb_add(&bar[XB_TOPGEN], 1u);
            else XB_SPIN(xb_ld(&bar[XB_TOPGEN]) == tg, bar);
            __builtin_amdgcn_fence(__ATOMIC_ACQUIRE, "agent");
            xb_add(&bar[XB_XGEN(b.x)], 1u);
            asm volatile("s_waitcnt vmcnt(0)" ::: "memory");
        } else {
            XB_SPIN(xb_ld(&bar[XB_XGEN(b.x)]) == gen, bar);
            __builtin_amdgcn_fence(__ATOMIC_ACQUIRE, "agent");
            asm volatile("s_waitcnt vmcnt(0)" ::: "memory");
        }
    }
    __syncthreads();
}

namespace pg8 {
constexpr int BM = 256, BK = 64, HALF = 128, HTB = HALF * BK * 2, STAGE_BYTES = 8 * HTB, NXCD = 8, WGM = 8;
__host__ __device__ __forceinline__ int lds_byte(int r, int c) { const int st = (r >> 4) * 2 + (c >> 5), rr = r & 15, cc = c & 31, ob = rr * 64 + cc * 2; return st * 1024 + (ob ^ (((ob >> 9) & 1) << 5)); }
__host__ __device__ __forceinline__ void stage_rc(int b, int& R, int& C) { const int st = b / 1024, sb = b % 1024, swz = sb ^ (((sb >> 9) & 1) << 5); R = (st >> 1) * 16 + swz / 64; C = (st & 1) * 32 + (swz % 64) / 2; }
__host__ __device__ __forceinline__ int perm32(int rho) { const int n = rho >> 4, i = rho & 15; return 8 * (i >> 2) + 4 * n + (i & 3); }

struct Unit { int pm, pn, aoff, boff; };
struct Gemm { const bf16_t* A; const bf16_t* Bt; int lda, ldb, K; };

template <int OFFK> struct StaticOrder {
    int nM, nN, nwg, G, c;
    __device__ void init(int M, int N, int G_, int c_) { nM = M / BM; nN = N / BM; nwg = nM * nN; G = G_; c = c_; }
    __device__ bool next(int i, Unit& u) const {
        const long L = (long)i * G + c; if (L >= nwg) return false;
        int wgid = (int)L; { const int q = nwg / NXCD, r = nwg % NXCD, xcd = wgid % NXCD, off = wgid / NXCD; wgid = (xcd < r ? xcd * (q + 1) : r * (q + 1) + (xcd - r) * q) + off; }
        const int nig = WGM * nN, gid = wgid / nig, fm = gid * WGM, gsz = (nM - fm) < WGM ? (nM - fm) : WGM;
        u.pm = fm + ((wgid % nig) % gsz); u.pn = (wgid % nig) / gsz;
        u.aoff = (OFFK == 1) ? ((u.pn >> 1) & 3) * 512 : 0; u.boff = (OFFK == 2) ? (u.pm >> 1) * 512 : 0;
        return true;
    }
};

__device__ __forceinline__ void so_map(int L, int nM, int nN, Unit& u) {
    const int nwg = nM * nN;
    int wgid = L; { const int q = nwg / NXCD, r = nwg % NXCD, xcd = wgid % NXCD, off = wgid / NXCD; wgid = (xcd < r ? xcd * (q + 1) : r * (q + 1) + (xcd - r) * q) + off; }
    const int nig = WGM * nN, gid = wgid / nig, fm = gid * WGM, gsz = (nM - fm) < WGM ? (nM - fm) : WGM;
    u.pm = fm + ((wgid % nig) % gsz); u.pn = (wgid % nig) / gsz;
}
struct InCMainOrder {
    int G, b;
    __device__ bool next(int i, Unit& u) const {
        int L;
        if (G == 256) { if (i < 3) L = i * 256 + b; else if (i == 3 && !(b >= 64 && b < 68)) L = 768 + (b < 64 ? b : b - 4); else return false; }
        else { const long LL = (long)i * G + b; if (LL >= 1020) return false; L = (int)LL; }
        if (L < 960) so_map(L, 60, 16, u);
        else if (L < 972) { u.pm = 60; u.pn = L - 960; }
        else { const int j = L - 972; u.pm = 61 + j % 6; u.pn = j / 6; }
        u.aoff = 0; u.boff = 0;
        return true;
    }
};
struct InCTailOrder {
    int G, b;
    __device__ bool next(int i, Unit& u) const {
        const long LL = (long)i * G + (b + 52) % G; if (LL >= 52) return false;
        const int j = (int)LL;
        if (j < 48) { u.pm = 61 + j % 6; u.pn = 8 + j / 6; } else { u.pm = 60; u.pn = 12 + (j - 48); }
        u.aoff = 0; u.boff = 0;
        return true;
    }
};
struct VtOrder {
    int G, b;
    __device__ bool next(int i, Unit& u) const {
        int L;
        if (G == 256) { if (i == 0) L = b; else if (i == 1 && b < 204) L = 256 + b; else if (i == 2 && b >= 48 && b < 124) L = 460 + (b - 48); else return false; }
        else { const long LL = (long)i * G + (b + 48) % G; if (LL >= 536) return false; L = (int)LL; }
        so_map(L, 8, 67, u);
        u.aoff = 0; u.boff = (u.pm >> 1) * 512;
        return true;
    }
};

struct TailOrder {
    int nks, ksl, G, c;
    __device__ void init(int nks_, int ksl_, int G_, int c_) { nks = nks_; ksl = ksl_; G = G_; c = c_; }
    __device__ bool next(int i, Unit& u) const {
        const int L = i * G + c; if (L >= 12 * nks) return false;
        const int ks = L % nks, t = L / nks;
        u.pm = 64 + (t >> 2); u.pn = t & 3; u.aoff = ks * ksl; u.boff = ks * ksl;
        return true;
    }
};

template <class Epi, class Sched>
__device__ __forceinline__ void gemm_phase(LAS unsigned char* lds, const Gemm g, const Sched& S, const Epi& E) {
    const int tid = threadIdx.x, wid = __builtin_amdgcn_readfirstlane(tid >> 6), lane = tid & 63, wr = wid >> 2, wc = wid & 3, fr = lane & 15, fq = lane >> 4;
    const int K = g.K, nt = K / BK;
    unsigned voffA[2], voffB[2];
#pragma unroll
    for (int i = 0; i < 2; ++i) { int R, C; stage_rc(tid * 16 + i * 8192, R, C); const int Rb = Epi::PERM ? ((R & ~31) + perm32(R & 31)) : R;
        voffA[i] = (unsigned)(R * g.lda + C) * 2u; voffB[i] = (unsigned)(Rb * g.ldb + C) * 2u; }
    const size_t kstep = (size_t)(BK * 2);
    const size_t hsA = (size_t)HALF * g.lda * 2, hsB = (size_t)HALF * g.ldb * 2;
    const size_t tsA = 2 * hsA, tsB = 2 * hsB;
    const unsigned ldsw = (unsigned)wid * 1024u;
    const int aoff = lds_byte(wr * 64 + fr, fq * 8), boff = lds_byte(wc * 32 + fr, fq * 8);
#define PG8_SA(b, h) (((b) * 2 + (h)) * HTB)
#define PG8_SB(b, h) ((4 + (b) * 2 + (h)) * HTB)
#define PG8_STAGE(bufoff, gbase, voff) do { _Pragma("unroll") for (int _i = 0; _i < 2; ++_i) \
        __builtin_amdgcn_global_load_lds((const unsigned*)((const char*)(gbase) + (voff)[_i]), (LAS unsigned*)(lds + (bufoff) + ldsw + _i * 8192), 16, 0, 0); } while (0)
#define PG8_LDA(dst, b, h) do { _Pragma("unroll") for (int m = 0; m < 4; ++m) _Pragma("unroll") for (int k = 0; k < 2; ++k) dst[m][k] = *(const LAS bf16x8*)(lds + PG8_SA(b, h) + aoff + m * 2048 + k * 1024); } while (0)
#define PG8_LDB(dst, b, h) do { _Pragma("unroll") for (int n = 0; n < 2; ++n) _Pragma("unroll") for (int k = 0; k < 2; ++k) dst[n][k] = *(const LAS bf16x8*)(lds + PG8_SB(b, h) + boff + n * 2048 + k * 1024); } while (0)
#define PG8_MMA(ai, bj, At, Bt) do { __builtin_amdgcn_s_setprio(1); _Pragma("unroll") for (int m = 0; m < 4; ++m) _Pragma("unroll") for (int n = 0; n < 2; ++n) _Pragma("unroll") for (int k = 0; k < 2; ++k) \
        acc[ai][bj][m][n] = __builtin_amdgcn_mfma_f32_16x16x32_bf16(Bt[n][k], At[m][k], acc[ai][bj][m][n], 0, 0, 0); __builtin_amdgcn_s_setprio(0); } while (0)
#define PG8_WAIT_V(n) asm volatile("s_waitcnt vmcnt(" #n ")" ::: "memory")
#define PG8_WAIT_L(n) asm volatile("s_waitcnt lgkmcnt(" #n ")" ::: "memory")
#define PG8_BAR __builtin_amdgcn_s_barrier()
#define PG8_SCHED __builtin_amdgcn_sched_barrier(0)
    Unit cur, nxt; int ui = 0;
    if (!S.next(0, cur)) return;
    f32x4 acc[2][2][4][2];
#pragma unroll
    for (int a = 0; a < 2; ++a)
#pragma unroll
        for (int b = 0; b < 2; ++b)
#pragma unroll
            for (int m = 0; m < 4; ++m)
#pragma unroll
                for (int n = 0; n < 2; ++n) acc[a][b][m][n] = (f32x4){0.f, 0.f, 0.f, 0.f};
    bf16x8 At[4][2], B0[2][2], B1[2][2];
    const char* cA = (const char*)g.A + (size_t)cur.pm * tsA + (size_t)cur.aoff * 2; const char* cB = (const char*)g.Bt + (size_t)cur.pn * tsB + (size_t)cur.boff * 2;
    PG8_STAGE(PG8_SB(0, 0), cB, voffB); PG8_STAGE(PG8_SA(0, 0), cA, voffA); PG8_STAGE(PG8_SB(0, 1), cB + hsB, voffB); PG8_STAGE(PG8_SA(0, 1), cA + hsA, voffA);
    if (wr == 1) PG8_BAR;
    PG8_WAIT_V(4); PG8_BAR;
    PG8_STAGE(PG8_SB(1, 0), cB + kstep, voffB); PG8_STAGE(PG8_SA(1, 0), cA + kstep, voffA); PG8_STAGE(PG8_SB(1, 1), cB + hsB + kstep, voffB);
    PG8_WAIT_V(6); PG8_BAR;
    for (;;) {
        const bool has_next = S.next(ui + 1, nxt);
        const char* nA = has_next ? (const char*)g.A + (size_t)nxt.pm * tsA + (size_t)nxt.aoff * 2 : cA; const char* nB = has_next ? (const char*)g.Bt + (size_t)nxt.pn * tsB + (size_t)nxt.boff * 2 : cB;
        for (int t = 0; t < nt; t += 2) {
            const bool last = (t == nt - 2);
            const char* a1 = cA + (size_t)(t + 1) * kstep;
            const char* a2 = last ? nA : cA + (size_t)(t + 2) * kstep; const char* b2 = last ? nB : cB + (size_t)(t + 2) * kstep;
            const char* a3 = a2 + kstep; const char* b3 = b2 + kstep;
            PG8_LDB(B0, 0, 0); PG8_SCHED; PG8_LDA(At, 0, 0); PG8_STAGE(PG8_SA(1, 1), a1 + hsA, voffA);
            PG8_WAIT_L(8); PG8_BAR; PG8_WAIT_L(0); PG8_MMA(0, 0, At, B0); PG8_BAR; PG8_SCHED;
            PG8_LDB(B1, 0, 1); PG8_STAGE(PG8_SB(0, 0), b2, voffB);
            PG8_BAR; PG8_WAIT_L(0); PG8_MMA(0, 1, At, B1); PG8_BAR;
            PG8_LDA(At, 0, 1); PG8_STAGE(PG8_SA(0, 0), a2, voffA);
            PG8_BAR; PG8_WAIT_L(0); PG8_MMA(1, 0, At, B0); PG8_BAR; PG8_SCHED;
            PG8_STAGE(PG8_SB(0, 1), b2 + hsB, voffB);
            PG8_WAIT_V(6); PG8_BAR; PG8_MMA(1, 1, At, B1); PG8_BAR;
            PG8_LDB(B0, 1, 0); PG8_SCHED; PG8_LDA(At, 1, 0); PG8_STAGE(PG8_SA(0, 1), a2 + hsA, voffA);
            PG8_WAIT_L(8); PG8_BAR; PG8_WAIT_L(0); PG8_MMA(0, 0, At, B0); PG8_BAR; PG8_SCHED;
            PG8_LDB(B1, 1, 1); PG8_STAGE(PG8_SB(1, 0), b3, voffB);
            PG8_BAR; PG8_WAIT_L(0); PG8_MMA(0, 1, At, B1); PG8_BAR;
            PG8_LDA(At, 1, 1); PG8_STAGE(PG8_SA(1, 0), a3, voffA);
            PG8_BAR; PG8_WAIT_L(0); PG8_MMA(1, 0, At, B0); PG8_BAR; PG8_SCHED;
            PG8_STAGE(PG8_SB(1, 1), b3 + hsB, voffB);
            PG8_WAIT_V(6); PG8_BAR; PG8_MMA(1, 1, At, B1); PG8_BAR;
        }
        E(acc, cur, wr, wc, fr, fq);
        if (!has_next) break;
#pragma unroll
        for (int a = 0; a < 2; ++a)
#pragma unroll
            for (int b = 0; b < 2; ++b)
#pragma unroll
                for (int m = 0; m < 4; ++m)
#pragma unroll
                    for (int n = 0; n < 2; ++n) acc[a][b][m][n] = (f32x4){0.f, 0.f, 0.f, 0.f};
        cur = nxt; cA = nA; cB = nB; ++ui;
    }
    PG8_WAIT_V(0);
    if (wr == 0) PG8_BAR;
    PG8_BAR;
#undef PG8_SA
#undef PG8_SB
#undef PG8_STAGE
#undef PG8_LDA
#undef PG8_LDB
#undef PG8_MMA
#undef PG8_WAIT_V
#undef PG8_WAIT_L
#undef PG8_BAR
#undef PG8_SCHED
}
}

using pg8::Unit;
typedef f32x4 AccT[2][2][4][2];

DI u32x4 pack_row8(const f32x4& v0, const f32x4& v1) { u32x4 w; w.x = pk2(v0[0], v0[1]); w.y = pk2(v0[2], v0[3]); w.z = pk2(v1[0], v1[1]); w.w = pk2(v1[2], v1[3]); return w; }

struct EpiInA {
    static constexpr bool PERM = true;
    bf16_t* proja; float* u32; float* out; bf16_t* vta;
    DI void operator()(const AccT& acc, const Unit& u, int wr, int wc, int fr, int fq) const {
        const int region = u.pn >> 1;
#pragma unroll
        for (int ai = 0; ai < 2; ++ai)
#pragma unroll
            for (int m = 0; m < 4; ++m) {
                const int row = u.pm * 256 + ai * 128 + wr * 64 + m * 16 + fr;
#pragma unroll
                for (int bj = 0; bj < 2; ++bj) {
                    const int col = u.pn * 256 + bj * 128 + wc * 32 + 8 * fq;
                    const f32x4 v0 = acc[ai][bj][m][0], v1 = acc[ai][bj][m][1];
                    *(u32x4*)(proja + (size_t)row * NA + col) = pack_row8(v0, v1);
                    if (region == 1 || region == 2) {
                        const int cc = col - region * 512;
                        float* dst = nullptr;
                        if (row < MP) dst = out + (region == 1 ? O_KP : O_VP) + (size_t)row * WA + cc;
                        else if (row < MT) dst = out + (region == 1 ? O_KS : O_VS) + (size_t)(row - MP) * WA + cc;
                        if (dst) { *(f32x4*)dst = v0; *(f32x4*)(dst + 4) = v1; }
                    }
                }
            }
    }
};

struct EpiPart {
    static constexpr bool PERM = false;
    float* part; int ksl;
    DI void operator()(const AccT& acc, const Unit& u, int wr, int wc, int fr, int fq) const {
        float* base = part + (size_t)(u.aoff / ksl) * 768 * D;
#pragma unroll
        for (int ai = 0; ai < 2; ++ai)
#pragma unroll
            for (int m = 0; m < 4; ++m) {
                const int row = u.pm * 256 + ai * 128 + wr * 64 + m * 16 + fr - MMAIN;
                float* rowp = base + (size_t)row * D + u.pn * 256 + wc * 32 + 4 * fq;
#pragma unroll
                for (int bj = 0; bj < 2; ++bj)
#pragma unroll
                    for (int n = 0; n < 2; ++n) *(f32x4*)(rowp + bj * 128 + n * 16) = acc[ai][bj][m][n];
            }
    }
};
struct EpiResX {
    static constexpr bool PERM = true;
    bf16_t* hb; const float* xp; const float* xs; const float* meta;
    DI void operator()(const AccT& acc, const Unit& u, int wr, int wc, int fr, int fq) const {
#pragma unroll
        for (int ai = 0; ai < 2; ++ai)
#pragma unroll
            for (int m = 0; m < 4; ++m) {
                const int row = u.pm * 256 + ai * 128 + wr * 64 + m * 16 + fr;
                const float* src = nullptr;
                if (row < MP) { const int b = row / LP, t = row - b * LP; src = (t < NMETA) ? meta + (size_t)t * D : xp + ((size_t)b * SEQ + (t - NMETA)) * D; }
                else if (row < MT) src = xs + (size_t)(row - MP) * D;
#pragma unroll
                for (int bj = 0; bj < 2; ++bj) {
                    const int col = u.pn * 256 + bj * 128 + wc * 32 + 8 * fq;
                    f32x4 v0 = acc[ai][bj][m][0], v1 = acc[ai][bj][m][1];
                    if (src) { v0 += *(const f32x4*)(src + col); v1 += *(const f32x4*)(src + col + 4); }
                    *(u32x4*)(hb + (size_t)row * D + col) = pack_row8(v0, v1);
                }
            }
    }
};
struct EpiAddHB {
    static constexpr bool PERM = true;
    bf16_t* hb;
    DI void operator()(const AccT& acc, const Unit& u, int wr, int wc, int fr, int fq) const {
#pragma unroll
        for (int ai = 0; ai < 2; ++ai)
#pragma unroll
            for (int m = 0; m < 4; ++m) {
                const int row = u.pm * 256 + ai * 128 + wr * 64 + m * 16 + fr;
#pragma unroll
                for (int bj = 0; bj < 2; ++bj) {
                    const int col = u.pn * 256 + bj * 128 + wc * 32 + 8 * fq;
                    u32x4* pp = (u32x4*)(hb + (size_t)row * D + col);
                    const u32x4 w = *pp;
                    const f32x4 v0 = acc[ai][bj][m][0] + (f32x4){bflo(w.x), bfhi(w.x), bflo(w.y), bfhi(w.y)};
                    const f32x4 v1 = acc[ai][bj][m][1] + (f32x4){bflo(w.z), bfhi(w.z), bflo(w.w), bfhi(w.w)};
                    *pp = pack_row8(v0, v1);
                }
            }
    }
};

struct EpiInC {
    static constexpr bool PERM = true;
    bf16_t* xmz; float* out;
    DI void operator()(const AccT& acc, const Unit& u, int wr, int wc, int fr, int fq) const {
#pragma unroll
        for (int ai = 0; ai < 2; ++ai)
#pragma unroll
            for (int m = 0; m < 4; ++m) {
                const int row = u.pm * 256 + ai * 128 + wr * 64 + m * 16 + fr;
                float* cdst = nullptr;
                if (u.pn < 8) {
                    if (row < MP) { const int b = row / LP, t = row - b * LP; if (t >= LP - 3) cdst = out + O_CVP + ((size_t)b * 3 + (t - (LP - 3))) * INNER; }
                    else if (row < MT) { const int sb = (row - MP) >> 2, i = (row - MP) & 3; if (i >= 1) cdst = out + O_CVS + ((size_t)sb * 3 + (i - 1)) * INNER; }
                }
#pragma unroll
                for (int bj = 0; bj < 2; ++bj) {
                    const int col = u.pn * 256 + bj * 128 + wc * 32 + 8 * fq;
                    const f32x4 v0 = acc[ai][bj][m][0], v1 = acc[ai][bj][m][1];
                    *(u32x4*)(xmz + (size_t)row * 4096 + col) = pack_row8(v0, v1);
                    if (cdst) { *(f32x4*)(cdst + col) = v0; *(f32x4*)(cdst + col + 4) = v1; }
                }
            }
    }
};

struct EpiQK {
    static constexpr bool PERM = true;
    bf16_t* qc; bf16_t* kc; bf16_t* ktc; bf16_t* qf;
    DI void operator()(const AccT& acc, const Unit& u, int wr, int wc, int fr, int fq) const {
        const bool isk = u.pn >= 8;
        bf16_t* base = isk ? kc : qc;
        const int colt = (u.pn & 7) * 256;
#pragma unroll
        for (int ai = 0; ai < 2; ++ai)
#pragma unroll
            for (int m = 0; m < 4; ++m) {
                const int row = u.pm * 256 + ai * 128 + wr * 64 + m * 16 + fr;
#pragma unroll
                for (int bj = 0; bj < 2; ++bj) {
                    const int col = colt + bj * 128 + wc * 32 + 8 * fq;
                    const u32x4 w = pack_row8(acc[ai][bj][m][0], acc[ai][bj][m][1]);
                    if (!isk && row < MP) {
                        const int b_ = row / LP, tl = row - b_ * LP;
                        const int c_ = (tl < NMETA) ? 0 : 1 + ((tl - NMETA) >> 7), pos = (tl < NMETA) ? tl : ((tl - NMETA) & 127);
                        const int hd = col >> 9, d_ = col & 511;
                        *(u32x4*)(qf + ((size_t)(((b_ * 4 + hd) * NCH + c_) * 8 + (pos >> 4)) * 16 + (d_ >> 5)) * 512 + (((d_ >> 3) & 3) * 16 + (pos & 15)) * 8) = w;
                    } else
                        *(u32x4*)(base + (size_t)row * INNER + col) = w;
                    if (isk && row < MP) {
                        const int b_ = row / LP, tl = row - b_ * LP;
                        const int c_ = (tl < NMETA) ? 0 : 1 + ((tl - NMETA) >> 7), pos = (tl < NMETA) ? tl : ((tl - NMETA) & 127);
                        const int hd = col >> 9, d_ = col & 511;
                        const int i_ = 8 * (pos >> 6) + 4 * ((d_ >> 5) & 1) + ((pos >> 3) & 3);
                        bf16_t* kt = ktc + ((size_t)(((b_ * 4 + hd) * NCH + c_) * 8 + (d_ >> 6)) * 16 + i_) * 512 + (32 * ((pos >> 5) & 1) + (d_ & 31)) * 8 + (pos & 7);
                        asm volatile("" : "+v"(kt));
                        kt[0] = (bf16_t)(w.x & 0xffffu); kt[8] = (bf16_t)(w.x >> 16); kt[16] = (bf16_t)(w.y & 0xffffu); kt[24] = (bf16_t)(w.y >> 16);
                        kt[32] = (bf16_t)(w.z & 0xffffu); kt[40] = (bf16_t)(w.z >> 16); kt[48] = (bf16_t)(w.w & 0xffffu); kt[56] = (bf16_t)(w.w >> 16);
                    }
                }
            }
    }
};

struct EpiPlain {
    static constexpr bool PERM = true;
    bf16_t* o; int ldc;
    DI void operator()(const AccT& acc, const Unit& u, int wr, int wc, int fr, int fq) const {
#pragma unroll
        for (int ai = 0; ai < 2; ++ai)
#pragma unroll
            for (int m = 0; m < 4; ++m) {
                const int row = u.pm * 256 + ai * 128 + wr * 64 + m * 16 + fr;
#pragma unroll
                for (int bj = 0; bj < 2; ++bj) {
                    const int col = u.pn * 256 + bj * 128 + wc * 32 + 8 * fq;
                    *(u32x4*)(o + (size_t)row * ldc + col) = pack_row8(acc[ai][bj][m][0], acc[ai][bj][m][1]);
                }
            }
    }
};

struct EpiVTs {
    static constexpr bool PERM = true;
    bf16_t* o; const float* sa; const float* mtop;
    DI void operator()(const AccT& acc, const Unit& u, int wr, int wc, int fr, int fq) const {
        const int h = u.pm >> 1;
        float w[2][8];
#pragma unroll
        for (int bj = 0; bj < 2; ++bj)
#pragma unroll
            for (int j = 0; j < 8; ++j) {
                const int r = u.pn * 256 + bj * 128 + wc * 32 + 8 * fq + j;
                float wv = 1.f;
                if (r < MP) { const int b = r / LP, t = r - b * LP; const int c = (t < NMETA) ? 0 : 1 + ((t - NMETA) >> 7); wv = __expf(sa[(size_t)r * 4 + h] - mtop[(b * 4 + h) * NCH + c]); }
                w[bj][j] = wv;
            }
#pragma unroll
        for (int ai = 0; ai < 2; ++ai)
#pragma unroll
            for (int m = 0; m < 4; ++m) {
                const int row = u.pm * 256 + ai * 128 + wr * 64 + m * 16 + fr;
#pragma unroll
                for (int bj = 0; bj < 2; ++bj) {
                    const int col = u.pn * 256 + bj * 128 + wc * 32 + 8 * fq;
                    const f32x4 a0 = acc[ai][bj][m][0], a1 = acc[ai][bj][m][1];
                    const f32x4 v0 = (f32x4){a0[0] * w[bj][0], a0[1] * w[bj][1], a0[2] * w[bj][2], a0[3] * w[bj][3]};
                    const f32x4 v1 = (f32x4){a1[0] * w[bj][4], a1[1] * w[bj][5], a1[2] * w[bj][6], a1[3] * w[bj][7]};
                    *(u32x4*)(o + (size_t)row * MPAD + col) = pack_row8(v0, v1);
                }
            }
    }
};

struct Frame {
    unsigned char* lds;
    int tid, lane, wave, G, bid;
};
DI Frame make_frame(unsigned char* lds) {
    Frame F; int t = threadIdx.x; asm volatile("" : "+v"(t));
    F.lds = lds; F.tid = t; F.lane = t & 63; F.wave = __builtin_amdgcn_readfirstlane(t >> 6); F.G = gridDim.x; F.bid = blockIdx.x;
    return F;
}

DI void tr_tile_wave(const float* src, int sld, bf16_t* dst, int dld, int k0, int n0, float scale, float* tile, int lane) {
    f32x4 v[16];
#pragma unroll
    for (int p = 0; p < 16; ++p) v[p] = *(const f32x4*)(src + (size_t)(k0 + p * 4 + (lane >> 4)) * sld + n0 + (lane & 15) * 4);
#pragma unroll
    for (int p = 0; p < 16; ++p) { float* t = tile + (p * 4 + (lane >> 4)) * 65 + (lane & 15) * 4; t[0] = v[p][0]; t[1] = v[p][1]; t[2] = v[p][2]; t[3] = v[p][3]; }
    __builtin_amdgcn_fence(__ATOMIC_RELEASE, "wavefront"); __builtin_amdgcn_wave_barrier(); __builtin_amdgcn_fence(__ATOMIC_ACQUIRE, "wavefront");
#pragma unroll
    for (int kc = 0; kc < 8; ++kc) {
        const float* t = tile + (kc * 8) * 65 + lane;
        u32x4 w;
        w.x = pk2(t[0] * scale, t[65] * scale); w.y = pk2(t[2 * 65] * scale, t[3 * 65] * scale); w.z = pk2(t[4 * 65] * scale, t[5 * 65] * scale); w.w = pk2(t[6 * 65] * scale, t[7 * 65] * scale);
        *(u32x4*)(dst + (size_t)(n0 + lane) * dld + k0 + kc * 8) = w;
    }
    __builtin_amdgcn_fence(__ATOMIC_RELEASE, "wavefront"); __builtin_amdgcn_wave_barrier(); __builtin_amdgcn_fence(__ATOMIC_ACQUIRE, "wavefront");
}

DI void p0_prologue(const Params& p, const Frame& F) {
    unsigned char* ws = p.ws;
    float* tile = (float*)F.lds + F.wave * (64 * 65);
    const float* wq_ = p.in[22]; const float* wk_ = p.in[23]; const float* wv_ = p.in[24];
    asm volatile("" : "+s"(wq_), "+s"(wk_), "+s"(wv_));
    const int gw = F.bid * 8 + F.wave, nw = F.G * 8, lane = F.lane;
    constexpr int T0 = 768, T1 = T0 + 256, T2 = T1 + 1024, T3 = T2 + 768, T4 = T3 + 512, T5 = T4 + 16;
    for (int ti = gw; ti < T5; ti += nw) {
        const float* src; int sld, dld, k0, n0; bf16_t* dst; float scale = 1.f;
        if (ti < T0) { const int j = ti; src = p.in[13]; sld = NA; dst = (bf16_t*)(ws + WS_WTINA); dld = D; k0 = (j / 48) * 64; n0 = (j % 48) * 64; }
        else if (ti < T1) { const int j = ti - T0; src = p.in[14]; sld = D; dst = (bf16_t*)(ws + WS_WTOUTA); dld = D; k0 = (j / 16) * 64; n0 = (j % 16) * 64; }
        else if (ti < T2) { const int j = ti - T1; src = p.in[18]; sld = NC; dst = (bf16_t*)(ws + WS_WTINC); dld = D; k0 = (j / 64) * 64; n0 = (j % 64) * 64; }
        else if (ti < T3) { const int j = ti - T2; const int mat = j / 64, t = j % 64, which = mat / 4, hd = mat % 4;
            src = (which == 0 ? wq_ : which == 1 ? wk_ : wv_) + (size_t)hd * DHC * DHC; sld = DHC;
            dst = (bf16_t*)(ws + (which == 0 ? WS_WTQ : which == 1 ? WS_WTK : WS_WTV)) + (size_t)hd * DHC * DHC; dld = DHC; k0 = (t / 8) * 64; n0 = (t % 8) * 64;
            if (which == 1) scale = 0.044194173824159216f; }
        else if (ti < T4) { const int j = ti - T3; src = p.in[27]; sld = D; dst = (bf16_t*)(ws + WS_WTOUTC); dld = INNER; k0 = (j / 16) * 64; n0 = (j % 16) * 64; }
        else { const int j = ti - T4; const int g = j / 4, t = j % 4; src = p.in[16] + (size_t)g * GC * GC; sld = GC; dst = (bf16_t*)(ws + WS_WTPOOL) + (size_t)g * GC * GC; dld = GC; k0 = (t / 2) * 64; n0 = (t % 2) * 64; }
        tr_tile_wave(src, sld, dst, dld, k0, n0, scale, tile, lane);
    }
    {
        float* wg = (float*)(ws + WS_WG);
        for (int i = F.bid * NTHREADS + F.tid; i < 8 * D; i += F.G * NTHREADS) { const int j = i / D, k = i % D; wg[i] = p.in[18][(size_t)k * NC + 4096 + j]; }
    }
    {
        bf16_t* XN = (bf16_t*)(ws + WS_XN);
        const float* g0 = p.in[11];
        constexpr int RB = 2;
        for (int r0 = gw * RB; r0 < MPAD; r0 += nw * RB) {
            f32x4 v[RB][4];
#pragma unroll
            for (int rr = 0; rr < RB; ++rr) {
                const int r = r0 + rr;
                if (r < MT) {
                    const float* src;
                    if (r < MP) { const int b = r / LP, t = r - b * LP; src = (t < NMETA) ? p.in[10] + (size_t)t * D : p.in[0] + ((size_t)b * SEQ + (t - NMETA)) * D; }
                    else src = p.in[1] + (size_t)(r - MP) * D;
#pragma unroll
                    for (int j = 0; j < 4; ++j) v[rr][j] = *(const f32x4*)(src + j * 256 + lane * 4);
                } else {
#pragma unroll
                    for (int j = 0; j < 4; ++j) v[rr][j] = (f32x4){0.f, 0.f, 0.f, 0.f};
                }
            }
#pragma unroll
            for (int rr = 0; rr < RB; ++rr) {
                const int r = r0 + rr;
                float ss = 0.f;
#pragma unroll
                for (int j = 0; j < 4; ++j) ss += v[rr][j][0] * v[rr][j][0] + v[rr][j][1] * v[rr][j][1] + v[rr][j][2] * v[rr][j][2] + v[rr][j][3] * v[rr][j][3];
                ss = wave_sum(ss);
                const float rstd = rsqrtf(ss * (1.f / D) + EPS);
#pragma unroll
                for (int j = 0; j < 4; ++j) {
                    const int c = j * 256 + lane * 4;
                    const f32x4 g = *(const f32x4*)(g0 + c);
                    u32x2 w; w.x = pk2(v[rr][j][0] * rstd * g[0], v[rr][j][1] * rstd * g[1]); w.y = pk2(v[rr][j][2] * rstd * g[2], v[rr][j][3] * rstd * g[3]);
                    *(u32x2*)(XN + (size_t)r * D + c) = w;
                }
            }
        }
    }
}

DI void attn_prompt_tile(const bf16_t* __restrict__ PA, const bf16_t* __restrict__ VTA, bf16_t* __restrict__ MIX, const float* __restrict__ sb_bias, int bh, int qt, int lane, int tmax) {
    const int b = bh >> 3, h = bh & 7, r31 = lane & 31, hh = lane >> 5;
    const size_t rowbase = (size_t)b * LP;
    const int t0 = qt * 32, tq = t0 + r31;
    bf16x8 qf[4];
#pragma unroll
    for (int i = 0; i < 4; ++i) qf[i] = *(const bf16x8*)(PA + (rowbase + tq) * NA + h * 64 + 16 * i + 8 * hh);
    const float bias = sb_bias[h];
    bf16x8 tm[2];
#pragma unroll
    for (int s = 0; s < 2; ++s)
#pragma unroll
        for (int j = 0; j < 8; ++j) { const int sin = 16 * s + 8 * (j >> 2) + 4 * hh + (j & 3); tm[s][j] = (sin >= r31) ? (short)0x3F80 : (short)0; }
    f32x16 o0 = zero16(), o1 = zero16();
    float R = 0.f;
    const bf16_t* vnat = PA + rowbase * NA + 1024 + h * 64 + r31;
#define VGATH(s_, e_off) ((bf16x4){(short)vnat[(size_t)((s_) + 4 * hh + 0) * NA + (e_off)], (short)vnat[(size_t)((s_) + 4 * hh + 1) * NA + (e_off)], (short)vnat[(size_t)((s_) + 4 * hh + 2) * NA + (e_off)], (short)vnat[(size_t)((s_) + 4 * hh + 3) * NA + (e_off)]})
    const bf16_t* kbase = PA + (rowbase + r31) * NA + 512 + h * 64 + 8 * hh;
    bf16x8 kc[4]; bf16x4 vc[8];
    {
        const int s0 = qt * 32;
        const bf16_t* kp = kbase + (size_t)s0 * NA;
#pragma unroll
        for (int i = 0; i < 4; ++i) kc[i] = *(const bf16x8*)(kp + 16 * i);
#pragma unroll
        for (int i = 0; i < 4; ++i) { vc[i] = VGATH(s0 + 8 * i, 0); vc[4 + i] = VGATH(s0 + 8 * i, 32); }
    }
    const float c1 = 0.125f * 1.4426950408889634f, bias2 = bias * 1.4426950408889634f;
    for (int kb = qt; kb >= 0; --kb) {
        const int s0 = kb * 32;
        bf16x8 kn[4]; bf16x4 vn[8];
        {
            const int sn = (kb > 0 ? kb - 1 : 0) * 32;
            const bf16_t* kp = kbase + (size_t)sn * NA;
#pragma unroll
            for (int i = 0; i < 4; ++i) kn[i] = *(const bf16x8*)(kp + 16 * i);
#pragma unroll
            for (int i = 0; i < 4; ++i) { vn[i] = VGATH(sn + 8 * i, 0); vn[4 + i] = VGATH(sn + 8 * i, 32); }
        }
        f32x16 S = zero16();
#pragma unroll
        for (int i = 0; i < 4; ++i) S = MFMA32(kc[i], qf[i], S);
        f32x16 L, Z;
        const int lim = tq - s0 - 4 * hh;
        if (kb == qt) {
#pragma unroll
            for (int reg = 0; reg < 16; ++reg) {
                const float z2 = fminf(__builtin_fmaf(S[reg], c1, bias2), 100.f);
                const float l2 = -__builtin_amdgcn_logf(1.f + __builtin_amdgcn_exp2f(z2));
                L[reg] = (crow(reg, 0) < lim) ? l2 : 0.f;
                Z[reg] = z2;
            }
        } else {
#pragma unroll
            for (int reg = 0; reg < 16; ++reg) {
                const float z2 = fminf(__builtin_fmaf(S[reg], c1, bias2), 100.f);
                L[reg] = -__builtin_amdgcn_logf(1.f + __builtin_amdgcn_exp2f(z2));
                Z[reg] = z2;
            }
        }
        const bf16x8 lb0 = pack8(L, 0), lb1 = pack8(L, 1);
        f32x16 Y = MFMA32(tm[0], lb0, zero16());
        Y = MFMA32(tm[1], lb1, Y);
        f32x16 Aw;
        if (kb == qt) {
#pragma unroll
            for (int reg = 0; reg < 16; ++reg) { const float a = __builtin_amdgcn_exp2f(Z[reg] + R + Y[reg]); Aw[reg] = (crow(reg, 0) < lim) ? a : 0.f; }
        } else {
#pragma unroll
            for (int reg = 0; reg < 16; ++reg) Aw[reg] = __builtin_amdgcn_exp2f(Z[reg] + R + Y[reg]);
        }
        const bf16x8 ab0 = pack8(Aw, 0), ab1 = pack8(Aw, 1);
        o0 = MFMA32(cat4(vc[0], vc[1]), ab0, o0); o1 = MFMA32(cat4(vc[4], vc[5]), ab0, o1);
        o0 = MFMA32(cat4(vc[2], vc[3]), ab1, o0); o1 = MFMA32(cat4(vc[6], vc[7]), ab1, o1);
        R += __shfl(Y[0], r31);
#pragma unroll
        for (int i = 0; i < 4; ++i) kc[i] = kn[i];
#pragma unroll
        for (int i = 0; i < 8; ++i) vc[i] = vn[i];
    }
    if (tq < tmax) {
        const size_t row = rowbase + tq;
        const bf16_t* gap = PA + row * NA + 1536 + h * 64;
        bf16_t* mp = MIX + row * D + h * 64;
#pragma unroll
        for (int et = 0; et < 2; ++et)
#pragma unroll
            for (int g = 0; g < 4; ++g) {
                const int e0 = 32 * et + 8 * g + 4 * hh;
                const u32x2 gw = *(const u32x2*)(gap + e0);
                const f32x16& o = et ? o1 : o0;
                u32x2 w;
                w.x = pk2(o[4 * g + 0] * silu_f(bflo(gw.x)), o[4 * g + 1] * silu_f(bfhi(gw.x)));
                w.y = pk2(o[4 * g + 2] * silu_f(bflo(gw.y)), o[4 * g + 3] * silu_f(bfhi(gw.y)));
                *(u32x2*)(mp + e0) = w;
            }
    }
}

#undef VGATH
DI void att_block(const unsigned char* kb_, int j, int it, int r31, int hh, const bf16x8 (&qf)[4], const bf16x8 (&tm)[2], float c1, float bias2, f32x16& o0, f32x16& o1, float& R) {
    constexpr int KROW = 144, VROW = 72, KBYTES = 32 * KROW;
    const unsigned char* vb_ = kb_ + KBYTES;
    f32x16 S = zero16();
#pragma unroll
    for (int i = 0; i < 4; ++i) { const bf16x8 kf = *(const bf16x8*)(kb_ + r31 * KROW + 32 * i + 16 * hh); S = MFMA32(kf, qf[i], S); }
    bf16x4 vc[8];
#pragma unroll
    for (int i = 0; i < 4; ++i) { vc[i] = *(const bf16x4*)(vb_ + r31 * VROW + 8 * hh + 16 * i); vc[4 + i] = *(const bf16x4*)(vb_ + (32 + r31) * VROW + 8 * hh + 16 * i); }
    f32x16 L, Z;
    const bool diag = (j == it + 1), first = (j == 0);
    if (diag || first) {
#pragma unroll
        for (int reg = 0; reg < 16; ++reg) {
            const float z2 = fminf(__builtin_fmaf(S[reg], c1, bias2), 100.f);
            const float l2 = __builtin_amdgcn_logf(1.f + __builtin_amdgcn_exp2f(z2));
            const int cr = crow(reg, 0) + 4 * hh;
            const bool valid = diag ? (cr < r31) : (cr >= 16);
            L[reg] = valid ? l2 : 0.f;
            Z[reg] = z2;
        }
    } else {
#pragma unroll
        for (int reg = 0; reg < 16; ++reg) {
            const float z2 = fminf(__builtin_fmaf(S[reg], c1, bias2), 100.f);
            L[reg] = __builtin_amdgcn_logf(1.f + __builtin_amdgcn_exp2f(z2));
            Z[reg] = z2;
        }
    }
    const bf16x8 lb0 = pack8(L, 0), lb1 = pack8(L, 1);
    f32x16 Y = MFMA32(tm[0], lb0, zero16());
    Y = MFMA32(tm[1], lb1, Y);
    f32x16 Aw;
    if (diag || first) {
#pragma unroll
        for (int reg = 0; reg < 16; ++reg) {
            const float a = __builtin_amdgcn_exp2f(Z[reg] + R + Y[reg]);
            const int cr = crow(reg, 0) + 4 * hh;
            const bool valid = diag ? (cr < r31) : (cr >= 16);
            Aw[reg] = valid ? a : 0.f;
        }
    } else {
#pragma unroll
        for (int reg = 0; reg < 16; ++reg) Aw[reg] = __builtin_amdgcn_exp2f(Z[reg] + R + Y[reg]);
    }
    const bf16x8 ab0 = pack8(Aw, 0), ab1 = pack8(Aw, 1);
    o0 = MFMA32(cat4(vc[0], vc[1]), ab0, o0); o1 = MFMA32(cat4(vc[4], vc[5]), ab0, o1);
    o0 = MFMA32(cat4(vc[2], vc[3]), ab1, o0); o1 = MFMA32(cat4(vc[6], vc[7]), ab1, o1);
    R += __shfl(Y[0], r31);
}

DI void attn_prompt_unit(const bf16_t* __restrict__ PA, bf16_t* __restrict__ MIX, const float* __restrict__ sb_bias, unsigned char* lds, int bh, int g, int tid, int wave, int lane) {
    constexpr int KROW = 144, VROW = 72, KBYTES = 32 * KROW  , BUF = KBYTES + 64 * VROW  ;
    const int b = bh >> 3, h = bh & 7, r31 = lane & 31, hh = lane >> 5;
    const size_t rowbase = (size_t)b * LP;
    const int it = 8 * g + wave;
    const int tq = 16 + 32 * it + r31;
    bf16x8 qf[4];
#pragma unroll
    for (int i = 0; i < 4; ++i) qf[i] = *(const bf16x8*)(PA + (rowbase + tq) * NA + h * 64 + 16 * i + 8 * hh);
    const float bias = sb_bias[h];
    bf16x8 tm[2];
#pragma unroll
    for (int s = 0; s < 2; ++s)
#pragma unroll
        for (int j = 0; j < 8; ++j) { const int sin = 16 * s + 8 * (j >> 2) + 4 * hh + (j & 3); tm[s][j] = (sin >= r31) ? (short)0xBF80 : (short)0; }
    f32x16 o0 = zero16(), o1 = zero16();
    float R = 0.f;
    const float c1 = 0.125f * 1.4426950408889634f, bias2 = bias * 1.4426950408889634f;
    const bool isk = tid < 256;
    const int sr = (tid & 255) >> 3, sc = tid & 7;
    const int scol = (isk ? 512 : 1024) + h * 64 + 8 * sc;
#define ATT_STAGE_LOAD(j_) (*(const u32x4*)(PA + (rowbase + ((32 * (j_) - 16 + sr) > 0 ? (32 * (j_) - 16 + sr) : 0)) * NA + scol))
#define ATT_STAGE_WRITE(base_, stg_) do { if (isk) *(u32x4*)((base_) + sr * KROW + 16 * sc) = stg_; \
        else { bf16_t* vt_ = (bf16_t*)((base_) + KBYTES + (8 * sc) * VROW + 2 * sr); \
            vt_[0 * (VROW / 2)] = (bf16_t)(stg_.x & 0xffffu); vt_[1 * (VROW / 2)] = (bf16_t)(stg_.x >> 16); vt_[2 * (VROW / 2)] = (bf16_t)(stg_.y & 0xffffu); vt_[3 * (VROW / 2)] = (bf16_t)(stg_.y >> 16); \
            vt_[4 * (VROW / 2)] = (bf16_t)(stg_.z & 0xffffu); vt_[5 * (VROW / 2)] = (bf16_t)(stg_.z >> 16); vt_[6 * (VROW / 2)] = (bf16_t)(stg_.w & 0xffffu); vt_[7 * (VROW / 2)] = (bf16_t)(stg_.w >> 16); } } while (0)
    const int jmax = 8 * g + 8;
    u32x4 stgA = ATT_STAGE_LOAD(jmax), stgB = ATT_STAGE_LOAD(jmax - 1);
    ATT_STAGE_WRITE(lds, stgA); ATT_STAGE_WRITE(lds + BUF, stgB);
    __syncthreads();
    int cur = 0;
    for (int jp = jmax; jp >= 0; jp -= 2) {
        const int na = jp - 2, nb2 = jp - 3;
        if (na >= 0) { stgA = ATT_STAGE_LOAD(na); stgB = ATT_STAGE_LOAD(nb2 >= 0 ? nb2 : 0); }
        const unsigned char* cb = lds + cur * 2 * BUF;
        if (jp <= it + 1) att_block(cb, jp, it, r31, hh, qf, tm, c1, bias2, o0, o1, R);
        if (jp >= 1 && jp - 1 <= it + 1) att_block(cb + BUF, jp - 1, it, r31, hh, qf, tm, c1, bias2, o0, o1, R);
        if (na >= 0) { unsigned char* nb = lds + (cur ^ 1) * 2 * BUF; ATT_STAGE_WRITE(nb, stgA); ATT_STAGE_WRITE(nb + BUF, stgB); }
        __syncthreads();
        cur ^= 1;
    }
    {
        const size_t row = rowbase + tq;
        const bf16_t* gap = PA + row * NA + 1536 + h * 64;
        bf16_t* mp = MIX + row * D + h * 64;
#pragma unroll
        for (int et = 0; et < 2; ++et)
#pragma unroll
            for (int gq = 0; gq < 4; ++gq) {
                const int e0 = 32 * et + 8 * gq + 4 * hh;
                const u32x2 gw = *(const u32x2*)(gap + e0);
                const f32x16& o = et ? o1 : o0;
                u32x2 w;
                w.x = pk2(o[4 * gq + 0] * silu_f(bflo(gw.x)), o[4 * gq + 1] * silu_f(bfhi(gw.x)));
                w.y = pk2(o[4 * gq + 2] * silu_f(bflo(gw.y)), o[4 * gq + 3] * silu_f(bfhi(gw.y)));
                *(u32x2*)(mp + e0) = w;
            }
    }
}
#undef ATT_STAGE_LOAD
#undef ATT_STAGE_WRITE
DI void p2_attn_prompt(const Params& p, const Frame& F) {
    const bf16_t* PA = (const bf16_t*)(p.ws + WS_PROJA); const bf16_t* VTA = (const bf16_t*)(p.ws + WS_VTA); bf16_t* MIX = (bf16_t*)(p.ws + WS_MIXED);
    const float* bias = p.in[15];
    {
        const int gw = F.bid * 8 + F.wave, nw = F.G * 8;
        for (int task = gw; task < 64; task += nw) attn_prompt_tile(PA, VTA, MIX, bias, task, 0, F.lane, NMETA);
    }
    for (int u = F.bid; u < 256; u += F.G) {
        const int bh = (u & 7) * 8 + ((u >> 3) & 7), g = u >> 6;
        attn_prompt_unit(PA, MIX, bias, F.lds, bh, g, F.tid, F.wave, F.lane);
        attn_prompt_unit(PA, MIX, bias, F.lds, bh, 7 - g, F.tid, F.wave, F.lane);
    }
}

DI void p2_attn_sample(const Params& p, const Frame& F) {
    const bf16_t* PA = (const bf16_t*)(p.ws + WS_PROJA);
    float* SPART = (float*)(p.ws + WS_SPART); float* ST = (float*)(p.ws + WS_ST);
    const float* cache_k = p.in[2]; const float* cache_v = p.in[3]; const int* ptab = (const int*)p.in[4];
    const float* sbb = p.in[15];
    float* zl = (float*)F.lds;
    float* red = (float*)(F.lds + 16384);
    float* res = (float*)(F.lds + 86016);
    float* pw = red + F.wave * 2176;
    const int tid = F.tid, lane = F.lane, wave = F.wave;
    const int hh = (tid >> 4) & 7, dch = tid & 15, sg = tid >> 7;
    f32x4 b0[8], b1[8], b2[8], b3[8];
#define SA_LOAD(buf, base, bt) do { _Pragma("unroll") for (int u_ = 0; u_ < 8; ++u_) buf[u_] = __builtin_nontemporal_load((const f32x4*)((base) + (size_t)((bt) * 8 + u_) * 2048 + tid * 4)); } while (0)
#define SA_QK(buf, bt) do { _Pragma("unroll") for (int u_ = 0; u_ < 8; ++u_) { \
        f32x4 pq_; \
        pq_[0] = buf[u_][0] * qr[0][0] + buf[u_][1] * qr[0][1] + buf[u_][2] * qr[0][2] + buf[u_][3] * qr[0][3]; \
        pq_[1] = buf[u_][0] * qr[1][0] + buf[u_][1] * qr[1][1] + buf[u_][2] * qr[1][2] + buf[u_][3] * qr[1][3]; \
        pq_[2] = buf[u_][0] * qr[2][0] + buf[u_][1] * qr[2][1] + buf[u_][2] * qr[2][2] + buf[u_][3] * qr[2][3]; \
        pq_[3] = buf[u_][0] * qr[3][0] + buf[u_][1] * qr[3][1] + buf[u_][2] * qr[3][2] + buf[u_][3] * qr[3][3]; \
        *(f32x4*)(pw + (u_ * 4 + (lane >> 4)) * 68 + (lane & 15) * 4) = pq_; } \
        __builtin_amdgcn_fence(__ATOMIC_RELEASE, "wavefront"); __builtin_amdgcn_wave_barrier(); __builtin_amdgcn_fence(__ATOMIC_ACQUIRE, "wavefront"); \
        { const int u2_ = lane >> 3, r_ = (lane >> 1) & 3, ip_ = lane & 1; const float* src_ = pw + (u2_ * 4 + r_) * 68 + 2 * ip_; \
          f32x2 za_ = *(const f32x2*)src_; \
          _Pragma("unroll") for (int j_ = 1; j_ < 16; ++j_) za_ += *(const f32x2*)(src_ + 4 * j_); \
          const int row_ = wave * 4 + r_; \
          *(f32x2*)(zl + ((row_ & 7) * 128 + ((bt) * 8 + u2_) * 4 + (row_ >> 3)) * 4 + 2 * ip_) = za_; } \
        __builtin_amdgcn_fence(__ATOMIC_RELEASE, "wavefront"); __builtin_amdgcn_wave_barrier(); __builtin_amdgcn_fence(__ATOMIC_ACQUIRE, "wavefront"); } while (0)
#define SA_PV(buf, bt) do { _Pragma("unroll") for (int u_ = 0; u_ < 8; ++u_) { const int s_ = ((bt) * 8 + u_) * 4 + sg; const f32x4 a_ = *(const f32x4*)(zl + (hh * 128 + s_) * 4); \
        _Pragma("unroll") for (int i_ = 0; i_ < 4; ++i_) oa[i_] += buf[u_] * a_[i_]; } } while (0)
    int item = F.bid, cnt = 0, first_item = F.bid;
    const float* Kp = nullptr; const float* Vp = nullptr;
    if (item < BS * NPAGES) { const int phys = ptab[item]; Kp = cache_k + (size_t)phys * PAGE * WA; Vp = cache_v + (size_t)phys * PAGE * WA; SA_LOAD(b0, Kp, 0); SA_LOAD(b1, Kp, 1); SA_LOAD(b2, Kp, 2); }
    for (; item < BS * NPAGES; item += F.G) {
        const int sb = item >> 4;
        const int nitem = item + F.G;
        const float* Kn = Kp; const float* Vn = Vp;
        if (nitem < BS * NPAGES) { const int phys = ptab[nitem]; Kn = cache_k + (size_t)phys * PAGE * WA; Vn = cache_v + (size_t)phys * PAGE * WA; }
        f32x4 qr[4];
#pragma unroll
        for (int i = 0; i < 4; ++i) {
            const u32x2 w = *(const u32x2*)(PA + (size_t)(MP + sb * 4 + i) * NA + hh * 64 + dch * 4);
            qr[i] = (f32x4){bflo(w.x) * 0.125f, bfhi(w.x) * 0.125f, bflo(w.y) * 0.125f, bfhi(w.y) * 0.125f};
        }
        SA_LOAD(b3, Kp, 3); SA_QK(b0, 0);
        SA_LOAD(b0, Vp, 0); SA_QK(b1, 1);
        SA_LOAD(b1, Vp, 1); SA_QK(b2, 2);
        SA_LOAD(b2, Vp, 2); SA_QK(b3, 3);
        __syncthreads();
        {
            const int row = tid >> 4, seg = tid & 15, h = row >> 2, i = row & 3;
            const float bias = sbb[h];
            float zz[8], suf[8];
            float run = 0.f;
#pragma unroll
            for (int k = 7; k >= 0; --k) { zz[k] = zl[(h * 128 + seg * 8 + k) * 4 + i] + bias; run += -softplus_f(zz[k]); suf[k] = run; }
            float inc = run;
            inc += dpp_shl_zero<0x101>(inc); inc += dpp_shl_zero<0x102>(inc); inc += dpp_shl_zero<0x104>(inc); inc += dpp_shl_zero<0x108>(inc);
            const float off = inc - run;
#pragma unroll
            for (int k = 0; k < 8; ++k) zl[(h * 128 + seg * 8 + k) * 4 + i] = __expf(zz[k] + suf[k] + off);
            if (seg == 0) res[cnt * 2080 + 2048 + row] = inc;
        }
        __syncthreads();
        f32x4 oa[4];
#pragma unroll
        for (int i = 0; i < 4; ++i) oa[i] = (f32x4){0.f, 0.f, 0.f, 0.f};
        SA_LOAD(b3, Vp, 3); SA_PV(b0, 0);
        SA_LOAD(b0, Kn, 0); SA_PV(b1, 1);
        SA_LOAD(b1, Kn, 1); SA_PV(b2, 2);
        SA_LOAD(b2, Kn, 2); SA_PV(b3, 3);
#pragma unroll
        for (int i = 0; i < 4; ++i) *(f32x4*)(red + ((sg * 8 + hh) * 4 + i) * 64 + dch * 4) = oa[i];
        __syncthreads();
        {
            const f32x4 r0 = *(const f32x4*)(red + tid * 4), r1 = *(const f32x4*)(red + 2048 + tid * 4), r2 = *(const f32x4*)(red + 4096 + tid * 4), r3 = *(const f32x4*)(red + 6144 + tid * 4);
            *(f32x4*)(res + cnt * 2080 + tid * 4) = (r0 + r1) + (r2 + r3);
        }
        ++cnt;
        __syncthreads();
        if (cnt == 4 || nitem >= BS * NPAGES) {
            for (int k = 0; k < cnt; ++k) {
                const size_t it = (size_t)first_item + (size_t)k * F.G;
                *(f32x4*)(SPART + it * 2048 + tid * 4) = *(const f32x4*)(res + k * 2080 + tid * 4);
                if (tid < 32) ST[it * 32 + tid] = res[k * 2080 + 2048 + tid];
            }
            first_item = nitem; cnt = 0;
            __syncthreads();
        }
        Kp = Kn; Vp = Vn;
    }
#undef SA_LOAD
#undef SA_QK
#undef SA_PV
}

DI void p2_pool(const Params& p, const Frame& F) {
    const bf16_t* PA = (const bf16_t*)(p.ws + WS_PROJA); bf16_t* MIX = (bf16_t*)(p.ws + WS_MIXED);
    const bf16_t* WTP = (const bf16_t*)(p.ws + WS_WTPOOL);
    const float* spool = p.in[5]; const float* scale = p.in[17];
    bf16_t* dl = (bf16_t*)F.lds;
    bf16_t* wl = (bf16_t*)(F.lds + 17408);
    const int tid = F.tid, lane = F.lane, r31 = lane & 31, hh = lane >> 5;
    constexpr int NT = MT / 64;
    for (int unit = F.bid; unit < NT * NG; unit += F.G) {
        const int g = unit & 3, tile = unit >> 2;
        const int w = 2 << g;
        for (int i = tid; i < 128 * 16; i += NTHREADS) { const int e = i >> 4, c8 = (i & 15) * 8; *(u32x4*)(wl + e * 136 + c8) = *(const u32x4*)(WTP + ((size_t)g * GC + e) * GC + c8); }
        {
            const int tl = tid >> 3, cc = (tid & 7) * 16;
            const int r = tile * 64 + tl;
            const int col = g * GC + cc;
            float sum[16];
#pragma unroll
            for (int k = 0; k < 16; ++k) sum[k] = 0.f;
            float cnt;
            const bf16_t* ur = PA + (size_t)r * NA + 2048 + col;
            const u32x4 ua = *(const u32x4*)ur, ub = *(const u32x4*)(ur + 8);
            const float u0[16] = {bflo(ua.x), bfhi(ua.x), bflo(ua.y), bfhi(ua.y), bflo(ua.z), bfhi(ua.z), bflo(ua.w), bfhi(ua.w), bflo(ub.x), bfhi(ub.x), bflo(ub.y), bfhi(ub.y), bflo(ub.z), bfhi(ub.z), bflo(ub.w), bfhi(ub.w)};
#define POOL_ADD_BF(src_) do { const u32x4 a_ = *(const u32x4*)(src_), b_ = *(const u32x4*)((src_) + 8); \
                sum[0] += bflo(a_.x); sum[1] += bfhi(a_.x); sum[2] += bflo(a_.y); sum[3] += bfhi(a_.y); sum[4] += bflo(a_.z); sum[5] += bfhi(a_.z); sum[6] += bflo(a_.w); sum[7] += bfhi(a_.w); \
                sum[8] += bflo(b_.x); sum[9] += bfhi(b_.x); sum[10] += bflo(b_.y); sum[11] += bfhi(b_.y); sum[12] += bflo(b_.z); sum[13] += bfhi(b_.z); sum[14] += bflo(b_.w); sum[15] += bfhi(b_.w); } while (0)
#define POOL_WINDOW(W) do { \
                if (r < MP) { const int t = r % LP; cnt = (float)((W) < t + 1 ? (W) : t + 1); \
                    _Pragma("unroll") for (int j = 0; j < (W); ++j) { if (j <= t) { const bf16_t* src = ur - (size_t)j * NA; POOL_ADD_BF(src); } } } \
                else { const int sb = (r - MP) >> 2, i = (r - MP) & 3; cnt = (float)(W); \
                    _Pragma("unroll") for (int j = 0; j < (W); ++j) { \
                        if (j <= i) { const bf16_t* src = ur - (size_t)j * NA; POOL_ADD_BF(src); } \
                        else { const float* src = spool + ((size_t)sb * 15 + (15 + i - j)) * WB + col; \
                            _Pragma("unroll") for (int q = 0; q < 4; ++q) { const f32x4 v = *(const f32x4*)(src + 4 * q); sum[4 * q] += v[0]; sum[4 * q + 1] += v[1]; sum[4 * q + 2] += v[2]; sum[4 * q + 3] += v[3]; } } } } } while (0)
            if (g == 0) POOL_WINDOW(2); else if (g == 1) POOL_WINDOW(4); else if (g == 2) POOL_WINDOW(8); else POOL_WINDOW(16);
#undef POOL_WINDOW
#undef POOL_ADD_BF
            const float inv = 1.f / cnt;
            u32x4 w0, w1;
            w0.x = pk2(sum[0] * inv - u0[0], sum[1] * inv - u0[1]); w0.y = pk2(sum[2] * inv - u0[2], sum[3] * inv - u0[3]);
            w0.z = pk2(sum[4] * inv - u0[4], sum[5] * inv - u0[5]); w0.w = pk2(sum[6] * inv - u0[6], sum[7] * inv - u0[7]);
            w1.x = pk2(sum[8] * inv - u0[8], sum[9] * inv - u0[9]); w1.y = pk2(sum[10] * inv - u0[10], sum[11] * inv - u0[11]);
            w1.z = pk2(sum[12] * inv - u0[12], sum[13] * inv - u0[13]); w1.w = pk2(sum[14] * inv - u0[14], sum[15] * inv - u0[15]);
            *(u32x4*)(dl + tl * 136 + cc) = w0; *(u32x4*)(dl + tl * 136 + cc + 8) = w1;
        }
        __syncthreads();
        {
            const int tt = F.wave >> 2, et = F.wave & 3;
            f32x16 acc = zero16();
#pragma unroll
            for (int ks = 0; ks < 8; ++ks) {
                const bf16x8 a = *(const bf16x8*)(wl + (32 * et + r31) * 136 + 16 * ks + 8 * hh);
                const bf16x8 bq = *(const bf16x8*)(dl + (32 * tt + r31) * 136 + 16 * ks + 8 * hh);
                acc = MFMA32(a, bq, acc);
            }
            const int r = tile * 64 + 32 * tt + r31;
#pragma unroll
            for (int gq = 0; gq < 4; ++gq) {
                const int e = g * GC + 32 * et + 8 * gq + 4 * hh;
                const f32x4 sc = *(const f32x4*)(scale + e);
                const u32x2 gw = *(const u32x2*)(PA + (size_t)r * NA + 2560 + e);
                u32x2 w2;
                w2.x = pk2(acc[4 * gq + 0] * sc[0] * silu_f(bflo(gw.x)), acc[4 * gq + 1] * sc[1] * silu_f(bfhi(gw.x)));
                w2.y = pk2(acc[4 * gq + 2] * sc[2] * silu_f(bflo(gw.y)), acc[4 * gq + 3] * sc[3] * silu_f(bfhi(gw.y)));
                *(u32x2*)(MIX + (size_t)r * D + 512 + e) = w2;
            }
        }
        __syncthreads();
    }
    {
        float* outp = p.out + O_POOLP; float* outs = p.out + O_POOLS;
        const int gt = F.bid * NTHREADS + tid, nt = F.G * NTHREADS;
        for (int i = gt; i < BP * 15 * (WB / 4); i += nt) { const int c4 = i % (WB / 4), j = (i / (WB / 4)) % 15, b = i / (15 * (WB / 4));
            const u32x2 w = *(const u32x2*)(PA + ((size_t)b * LP + (LP - 15) + j) * NA + 2048 + c4 * 4);
            *(f32x4*)(outp + ((size_t)b * 15 + j) * WB + c4 * 4) = (f32x4){bflo(w.x), bfhi(w.x), bflo(w.y), bfhi(w.y)}; }
        for (int i = gt; i < BS * 15 * (WB / 4); i += nt) { const int c4 = i % (WB / 4), j = (i / (WB / 4)) % 15, sb = i / (15 * (WB / 4));
            f32x4 v;
            if (j < 11) v = *(const f32x4*)(spool + ((size_t)sb * 15 + j + 4) * WB + c4 * 4);
            else { const u32x2 w = *(const u32x2*)(PA + ((size_t)(MP + sb * 4 + (j - 11))) * NA + 2048 + c4 * 4); v = (f32x4){bflo(w.x), bfhi(w.x), bflo(w.y), bfhi(w.y)}; }
            *(f32x4*)(outs + ((size_t)sb * 15 + j) * WB + c4 * 4) = v; }
    }
}

DI void p2d_combine(const Params& p, const Frame& F) {
    const bf16_t* PA = (const bf16_t*)(p.ws + WS_PROJA); bf16_t* MIX = (bf16_t*)(p.ws + WS_MIXED);
    const float* SPART = (const float*)(p.ws + WS_SPART); const float* ST = (const float*)(p.ws + WS_ST);
    const float* sbb = p.in[15];
    const int gt = F.bid * NTHREADS + F.tid, nt = F.G * NTHREADS;
    for (int idx = gt; idx < BS * HA * TS * 16; idx += nt) {
        const int e4 = idx & 15, i = (idx >> 4) & 3, h = (idx >> 6) & 7, sb = idx >> 9;
        const size_t rq = (size_t)(MP + sb * 4 + i);
        const float bias = sbb[h];
        f32x4 o = (f32x4){0.f, 0.f, 0.f, 0.f};
        float R = 0.f;
        for (int ip = i - 1; ip >= 0; --ip) {
            const size_t rk = (size_t)(MP + sb * 4 + ip);
            float dot = 0.f;
            for (int d = 0; d < 64; d += 8) {
                const u32x4 qa = *(const u32x4*)(PA + rq * NA + h * 64 + d), ka = *(const u32x4*)(PA + rk * NA + 512 + h * 64 + d);
                dot += bflo(qa.x) * bflo(ka.x) + bfhi(qa.x) * bfhi(ka.x) + bflo(qa.y) * bflo(ka.y) + bfhi(qa.y) * bfhi(ka.y)
                     + bflo(qa.z) * bflo(ka.z) + bfhi(qa.z) * bfhi(ka.z) + bflo(qa.w) * bflo(ka.w) + bfhi(qa.w) * bfhi(ka.w);
            }
            const float z = dot * 0.125f + bias;
            const float ln = -softplus_f(z);
            const float a = __expf(z + R + ln);
            const u32x2 vw = *(const u32x2*)(PA + rk * NA + 1024 + h * 64 + e4 * 4);
            o[0] += a * bflo(vw.x); o[1] += a * bfhi(vw.x); o[2] += a * bflo(vw.y); o[3] += a * bfhi(vw.y);
            R += ln;
        }
        for (int pg = NPAGES - 1; pg >= 0; --pg) {
            const size_t it = (size_t)sb * NPAGES + pg;
            const f32x4 po = *(const f32x4*)(SPART + it * 2048 + (h * 4 + i) * 64 + e4 * 4);
            const float w = __expf(R);
            o += po * w;
            R += ST[it * 32 + h * 4 + i];
        }
        const u32x2 gw = *(const u32x2*)(PA + rq * NA + 1536 + h * 64 + e4 * 4);
        u32x2 w;
        w.x = pk2(o[0] * silu_f(bflo(gw.x)), o[1] * silu_f(bfhi(gw.x)));
        w.y = pk2(o[2] * silu_f(bflo(gw.y)), o[3] * silu_f(bfhi(gw.y)));
        *(u32x2*)(MIX + rq * D + h * 64 + e4 * 4) = w;
    }
}

DI void p3b_norm_gates(const Params& p, const Frame& F) {
    const bf16_t* HB = (const bf16_t*)(p.ws + WS_H); bf16_t* HBw = (bf16_t*)(p.ws + WS_H); bf16_t* XN = (bf16_t*)(p.ws + WS_XN);
    const float* PART = (const float*)(p.ws + WS_PART);
    const float* WG = (const float*)(p.ws + WS_WG);
    float* LOGI = (float*)(p.ws + WS_LOGI); float* LOGF = (float*)(p.ws + WS_LOGF);
    const float* g1 = p.in[11] + D; const float* bg = p.in[19];
    const int gw = F.bid * 8 + F.wave, nw = F.G * 8, lane = F.lane;
    constexpr int RB = 2;
    for (int r0 = gw * RB; r0 < MT; r0 += nw * RB) {
        float v[RB][2][8]; float rstd[RB];
        if (r0 < MMAIN) {
            u32x4 hw[RB][2];
#pragma unroll
            for (int rr = 0; rr < RB; ++rr)
#pragma unroll
                for (int j = 0; j < 2; ++j) hw[rr][j] = *(const u32x4*)(HB + (size_t)(r0 + rr) * D + j * 512 + lane * 8);
#pragma unroll
            for (int rr = 0; rr < RB; ++rr)
#pragma unroll
                for (int j = 0; j < 2; ++j) {
                    const u32x4 w = hw[rr][j];
                    v[rr][j][0] = bflo(w.x); v[rr][j][1] = bfhi(w.x); v[rr][j][2] = bflo(w.y); v[rr][j][3] = bfhi(w.y); v[rr][j][4] = bflo(w.z); v[rr][j][5] = bfhi(w.z); v[rr][j][6] = bflo(w.w); v[rr][j][7] = bfhi(w.w);
                }
        } else {
#pragma unroll
            for (int rr = 0; rr < RB; ++rr) {
                const int r = r0 + rr;
                const float* src;
                if (r < MP) { const int b = r / LP, t = r - b * LP; src = (t < NMETA) ? p.in[10] + (size_t)t * D : p.in[0] + ((size_t)b * SEQ + (t - NMETA)) * D; }
                else src = p.in[1] + (size_t)(r - MP) * D;
#pragma unroll
                for (int j = 0; j < 2; ++j) {
                    const int c = j * 512 + lane * 8;
                    f32x4 a0 = *(const f32x4*)(src + c), a1 = *(const f32x4*)(src + c + 4);
#pragma unroll
                    for (int ks = 0; ks < 4; ++ks) { const float* pp = PART + ((size_t)ks * 768 + (r - MMAIN)) * D + c; a0 += *(const f32x4*)pp; a1 += *(const f32x4*)(pp + 4); }
                    v[rr][j][0] = a0[0]; v[rr][j][1] = a0[1]; v[rr][j][2] = a0[2]; v[rr][j][3] = a0[3]; v[rr][j][4] = a1[0]; v[rr][j][5] = a1[1]; v[rr][j][6] = a1[2]; v[rr][j][7] = a1[3];
                    *(u32x4*)(HBw + (size_t)r * D + c) = pack_row8(a0, a1);
                }
            }
        }
#pragma unroll
        for (int rr = 0; rr < RB; ++rr) {
            float ss = 0.f;
#pragma unroll
            for (int j = 0; j < 2; ++j)
#pragma unroll
                for (int k = 0; k < 8; ++k) ss += v[rr][j][k] * v[rr][j][k];
            rstd[rr] = rsqrtf(wave_sum(ss) * (1.f / D) + EPS);
        }
        float gsum[RB][8];
#pragma unroll
        for (int rr = 0; rr < RB; ++rr)
#pragma unroll
            for (int q = 0; q < 8; ++q) gsum[rr][q] = 0.f;
#pragma unroll
        for (int j = 0; j < 2; ++j) {
            const int c = j * 512 + lane * 8;
            const f32x4 ga = *(const f32x4*)(g1 + c), gb = *(const f32x4*)(g1 + c + 4);
            const float g[8] = {ga[0], ga[1], ga[2], ga[3], gb[0], gb[1], gb[2], gb[3]};
            float xn[RB][8];
#pragma unroll
            for (int rr = 0; rr < RB; ++rr) {
#pragma unroll
                for (int k = 0; k < 8; ++k) xn[rr][k] = v[rr][j][k] * rstd[rr] * g[k];
                u32x4 w; w.x = pk2(xn[rr][0], xn[rr][1]); w.y = pk2(xn[rr][2], xn[rr][3]); w.z = pk2(xn[rr][4], xn[rr][5]); w.w = pk2(xn[rr][6], xn[rr][7]);
                *(u32x4*)(XN + (size_t)(r0 + rr) * D + c) = w;
            }
#pragma unroll
            for (int q = 0; q < 8; ++q) {
                const f32x4 wa = *(const f32x4*)(WG + q * D + c), wb = *(const f32x4*)(WG + q * D + c + 4);
#pragma unroll
                for (int rr = 0; rr < RB; ++rr)
                    gsum[rr][q] += xn[rr][0] * wa[0] + xn[rr][1] * wa[1] + xn[rr][2] * wa[2] + xn[rr][3] * wa[3] + xn[rr][4] * wb[0] + xn[rr][5] * wb[1] + xn[rr][6] * wb[2] + xn[rr][7] * wb[3];
            }
        }
#pragma unroll
        for (int rr = 0; rr < RB; ++rr) {
#pragma unroll
            for (int q = 0; q < 8; ++q) gsum[rr][q] = wave_sum(gsum[rr][q]);
            if (lane < 8) {
                const float gsel = lane == 0 ? gsum[rr][0] : lane == 1 ? gsum[rr][1] : lane == 2 ? gsum[rr][2] : lane == 3 ? gsum[rr][3] : lane == 4 ? gsum[rr][4] : lane == 5 ? gsum[rr][5] : lane == 6 ? gsum[rr][6] : gsum[rr][7];
                const float x = gsel + bg[lane];
                if (lane < 4) LOGI[(size_t)(r0 + rr) * 4 + lane] = x;
                else LOGF[(size_t)(r0 + rr) * 4 + (lane - 4)] = -softplus_f(-x);
            }
        }
    }
}

DI void p4_scan(const Params& p, const Frame& F) {
    const float* LOGI = (const float*)(p.ws + WS_LOGI); const float* LOGF = (const float*)(p.ws + WS_LOGF);
    float* SA = (float*)(p.ws + WS_SA); float* SM = (float*)(p.ws + WS_SM); float* SBt = (float*)(p.ws + WS_SB);
    float* MPREV = (float*)(p.ws + WS_MPREV); float* MTOP = (float*)(p.ws + WS_MTOP);
    const int gw = F.bid * 8 + F.wave, nw = F.G * 8, lane = F.lane;
    const int soff = (F.G >= 128) ? 64 * 8 : 0;
    for (int seq = gw - soff; seq >= 0 && seq < BP * HC; seq += nw) {
        const int b = seq >> 2, h = seq & 3;
        float m = 0.f;
        for (int c = 0; c < NCH; ++c) {
            const int t0 = (c == 0) ? 0 : NMETA + 128 * (c - 1), len = (c == 0) ? NMETA : 128;
            const size_t r0 = (size_t)b * LP + t0;
            const int tA = 2 * lane, tB = 2 * lane + 1;
            const bool vA = tA < len, vB = tB < len;
            const float lfA = vA ? LOGF[(r0 + tA) * 4 + h] : 0.f, lfB = vB ? LOGF[(r0 + tB) * 4 + h] : 0.f;
            const float liA = vA ? LOGI[(r0 + tA) * 4 + h] : 0.f, liB = vB ? LOGI[(r0 + tB) * 4 + h] : 0.f;
            const float pB = lfA + lfB;
            const float inc = wave_scan_add(pB);
            const float exc = inc - pB;
            const float bA = exc + lfA, bB = exc + pB;
            const float aA = vA ? liA - bA : -INFINITY, aB = vB ? liB - bB : -INFINITY;
            const float mB = fmaxf(aA, aB);
            const float minc = wave_scan_max(mB);
            float mexc = __shfl_up(minc, 1); if (lane == 0) mexc = -INFINITY;
            const float MA = fmaxf(m, fmaxf(mexc, aA)), MB = fmaxf(m, fmaxf(mexc, mB));
            if (vA) { SA[(r0 + tA) * 4 + h] = aA; SM[(r0 + tA) * 4 + h] = MA; SBt[(r0 + tA) * 4 + h] = bA; }
            if (vB) { SA[(r0 + tB) * 4 + h] = aB; SM[(r0 + tB) * 4 + h] = MB; SBt[(r0 + tB) * 4 + h] = bB; }
            const int ll = (len - 1) >> 1;
            const float bT = __shfl(bB, ll), MT_ = __shfl(MB, ll);
            if (lane == 0) { MPREV[seq * NCH + c] = m; MTOP[seq * NCH + c] = MT_; }
            m = bT + MT_;
        }
        if (lane == 0) p.out[O_MP + seq] = m;
    }
    const int gt = F.bid * NTHREADS + F.tid, nt = F.G * NTHREADS;
    for (int sq = gt; sq < BS * HC; sq += nt) {
        const int sb = sq >> 2, h = sq & 3;
        const float m = p.in[8][sq];
        float bsum = 0.f, pm = -INFINITY, MT_ = 0.f;
        for (int i = 0; i < 4; ++i) {
            const size_t r = (size_t)MP + sb * 4 + i;
            bsum += LOGF[r * 4 + h];
            const float a = LOGI[r * 4 + h] - bsum;
            pm = fmaxf(pm, a);
            MT_ = fmaxf(m, pm);
            SA[r * 4 + h] = a; SM[r * 4 + h] = MT_; SBt[r * 4 + h] = bsum;
        }
        MPREV[32 * NCH + sq] = m; MTOP[32 * NCH + sq] = MT_;
        p.out[O_MS + sq] = bsum + MT_;
    }
}

DI void p4b_conv(const Params& p, const Frame& F) {
    const bf16_t* XMZ = (const bf16_t*)(p.ws + WS_XMZ); bf16_t* CA = (bf16_t*)(p.ws + WS_CA);
    const float* cw = p.in[20]; const float* cb = p.in[21]; const float* sconv = p.in[9];
    const int gt = F.bid * NTHREADS + F.tid, nt = F.G * NTHREADS;
    for (int idx = gt; idx < (MT / 4) * (INNER / 8); idx += nt) {
        const int rg = idx >> 8, c = (idx & 255) * 8, r = rg * 4;
        const bool samp = r >= MP;
        const int tpos = samp ? 0 : (r % LP), sb = samp ? ((r - MP) >> 2) : 0;
        float x[7][8];
#pragma unroll
        for (int k = 0; k < 4; ++k) {
            const u32x4 w = *(const u32x4*)(XMZ + (size_t)(r + k) * 4096 + c);
            x[3 + k][0] = bflo(w.x); x[3 + k][1] = bfhi(w.x); x[3 + k][2] = bflo(w.y); x[3 + k][3] = bfhi(w.y); x[3 + k][4] = bflo(w.z); x[3 + k][5] = bfhi(w.z); x[3 + k][6] = bflo(w.w); x[3 + k][7] = bfhi(w.w);
        }
        if (samp) {
#pragma unroll
            for (int k = 0; k < 3; ++k) {
                const float* src = sconv + ((size_t)sb * 3 + k) * INNER + c;
                const f32x4 a = *(const f32x4*)src, b2 = *(const f32x4*)(src + 4);
                x[k][0] = a[0]; x[k][1] = a[1]; x[k][2] = a[2]; x[k][3] = a[3]; x[k][4] = b2[0]; x[k][5] = b2[1]; x[k][6] = b2[2]; x[k][7] = b2[3];
            }
        } else if (tpos >= 4) {
#pragma unroll
            for (int k = 0; k < 3; ++k) {
                const u32x4 w = *(const u32x4*)(XMZ + (size_t)(r - 3 + k) * 4096 + c);
                x[k][0] = bflo(w.x); x[k][1] = bfhi(w.x); x[k][2] = bflo(w.y); x[k][3] = bfhi(w.y); x[k][4] = bflo(w.z); x[k][5] = bfhi(w.z); x[k][6] = bflo(w.w); x[k][7] = bfhi(w.w);
            }
        } else {
#pragma unroll
            for (int k = 0; k < 3; ++k)
#pragma unroll
                for (int e = 0; e < 8; ++e) x[k][e] = 0.f;
        }
        float wt[4][8], bias[8];
#pragma unroll
        for (int j = 0; j < 4; ++j) { const f32x4 w0 = *(const f32x4*)(cw + (size_t)j * INNER + c), w1 = *(const f32x4*)(cw + (size_t)j * INNER + c + 4);
            wt[j][0] = w0[0]; wt[j][1] = w0[1]; wt[j][2] = w0[2]; wt[j][3] = w0[3]; wt[j][4] = w1[0]; wt[j][5] = w1[1]; wt[j][6] = w1[2]; wt[j][7] = w1[3]; }
        { const f32x4 b0 = *(const f32x4*)(cb + c), b1 = *(const f32x4*)(cb + c + 4);
          bias[0] = b0[0]; bias[1] = b0[1]; bias[2] = b0[2]; bias[3] = b0[3]; bias[4] = b1[0]; bias[5] = b1[1]; bias[6] = b1[2]; bias[7] = b1[3]; }
#pragma unroll
        for (int k = 0; k < 4; ++k) {
            float acc[8];
#pragma unroll
            for (int e = 0; e < 8; ++e) acc[e] = bias[e] + x[k][e] * wt[0][e] + x[k + 1][e] * wt[1][e] + x[k + 2][e] * wt[2][e] + x[k + 3][e] * wt[3][e];
            u32x4 o;
            o.x = pk2(silu_f(acc[0]), silu_f(acc[1])); o.y = pk2(silu_f(acc[2]), silu_f(acc[3])); o.z = pk2(silu_f(acc[4]), silu_f(acc[5])); o.w = pk2(silu_f(acc[6]), silu_f(acc[7]));
            *(u32x4*)(CA + (size_t)(r + k) * INNER + c) = o;
        }
    }
    for (int idx = gt; idx < (MPAD - MT) * (INNER / 8); idx += nt) *(u32x4*)(CA + (size_t)MT * INNER + (size_t)idx * 8) = (u32x4){0u, 0u, 0u, 0u};
}

DI void p5b_chunk_scores(const Params& p, const Frame& F) {
    const bf16_t* QF = (const bf16_t*)(p.ws + WS_QF); const bf16_t* KC = (const bf16_t*)(p.ws + WS_KC); const bf16_t* KTC = (const bf16_t*)(p.ws + WS_KTC);
    const float* SA = (const float*)(p.ws + WS_SA); const float* SM = (const float*)(p.ws + WS_SM); const float* MTOP = (const float*)(p.ws + WS_MTOP);
    bf16_t* SD = (bf16_t*)(p.ws + WS_SD); float* RS = (float*)(p.ws + WS_RS); float* DN = (float*)(p.ws + WS_DN);
    float* la = (float*)F.lds;
    float* lm = la + 128;
    float* lw = lm + 128;
    float* lrs = lw + 128;
    float* ldn = lrs + 128;
    const int tid = F.tid, lane = F.lane, r31 = lane & 31, hh = lane >> 5;
    for (int ui = F.bid; ui < 32 * NCH; ui += F.G) {
        const int seq = (ui < 512) ? (ui >> 4) : (ui - 512), c = (ui < 512) ? 1 + (ui & 15) : 0, unit = seq * NCH + c, b = seq >> 2, h = seq & 3;
        const int t0 = (c == 0) ? 0 : NMETA + 128 * (c - 1), len = (c == 0) ? NMETA : 128;
        const size_t r0 = (size_t)b * LP + t0;
        if (tid < 128) {
            const bool v = tid < len;
            const float a = v ? SA[(r0 + tid) * 4 + h] : 0.f, M = v ? SM[(r0 + tid) * 4 + h] : 0.f;
            la[tid] = a; lm[tid] = M; lw[tid] = v ? __expf(a - MTOP[unit]) : 0.f; lrs[tid] = 0.f;
        }
        __syncthreads();
        {
            const int tt = F.wave & 3, sp = F.wave >> 2;
            const int t = 32 * tt + r31;
            const float Mt = lm[t];
            const float gT = __expf(MTOP[unit] - Mt);
            float rsum = 0.f;
#pragma unroll
            for (int q = 0; q < 2; ++q) {
                const int st = 2 * sp + q;
                f32x16 acc = zero16();
                if (st <= tt && 32 * st < len) {
                    const bf16_t* kp = KC + (r0 + 32 * st + r31) * INNER + h * DHC + 8 * hh;
                    const bf16_t* qp = QF + ((size_t)(unit * 8 + 2 * tt + (r31 >> 4)) * 16) * 512 + (hh * 16 + (r31 & 15)) * 8;
#pragma unroll 16
                    for (int ks = 0; ks < 32; ++ks) { const bf16x8 a = *(const bf16x8*)(kp + 16 * ks); const bf16x8 bq = *(const bf16x8*)(qp + 256 * ks); acc = MFMA32(a, bq, acc); }
                }
                bf16_t* dst = SD + ((size_t)unit * 128 + t) * 128 + 32 * st + 4 * hh;
#pragma unroll
                for (int g = 0; g < 4; ++g) {
                    float v[4];
#pragma unroll
                    for (int j = 0; j < 4; ++j) {
                        const int s = 32 * st + 8 * g + 4 * hh + j;
                        const bool ok = (s <= t) && (t < len) && (s < len);
                        rsum += ok ? acc[4 * g + j] * __expf(la[s] - Mt) : 0.f;
                        v[j] = ok ? acc[4 * g + j] * gT : 0.f;
                    }
                    u32x2 w; w.x = pk2(v[0], v[1]); w.y = pk2(v[2], v[3]);
                    *(u32x2*)(dst + 8 * g) = w;
                }
            }
            atomicAdd(&lrs[t], rsum);
        }
        float dacc0 = 0.f, dacc1 = 0.f;
        {
            const int dp = tid & 255, sh = tid >> 8;
            const bf16_t* kp = KC + (r0 + 64 * sh) * INNER + h * DHC + 2 * dp;
#pragma unroll 8
            for (int s8 = 0; s8 < 64; ++s8) {
                const unsigned w = *(const unsigned*)(kp + (size_t)s8 * INNER);
                const float ws_ = lw[64 * sh + s8];
                dacc0 += ws_ * bflo(w); dacc1 += ws_ * bfhi(w);
            }
            if (sh == 1) { ldn[2 * dp] = dacc0; ldn[2 * dp + 1] = dacc1; }
        }
        __syncthreads();
        if (tid < 256) { DN[(size_t)unit * DHC + 2 * tid] = dacc0 + ldn[2 * tid]; DN[(size_t)unit * DHC + 2 * tid + 1] = dacc1 + ldn[2 * tid + 1]; }
        if (tid < 128) RS[(size_t)unit * 128 + tid] = lrs[tid];
        __syncthreads();
    }
}

DI void p6_mlstm_prompt(const Params& p, const Frame& F) {
    const bf16_t* QF = (const bf16_t*)(p.ws + WS_QF); const bf16_t* KTC = (const bf16_t*)(p.ws + WS_KTC); const bf16_t* VTC = (const bf16_t*)(p.ws + WS_VTC);
    const bf16_t* SD = (const bf16_t*)(p.ws + WS_SD); const float* RS = (const float*)(p.ws + WS_RS); const float* DN = (const float*)(p.ws + WS_DN);
    const float* SA = (const float*)(p.ws + WS_SA); const float* SM = (const float*)(p.ws + WS_SM); const float* SBt = (const float*)(p.ws + WS_SB);
    const float* MPREV = (const float*)(p.ws + WS_MPREV); const float* MTOP = (const float*)(p.ws + WS_MTOP);
    bf16_t* HH = (bf16_t*)(p.ws + WS_HH);
    constexpr int CTS = 520, VTS = 136, SDS = 136;
    bf16_t* CT = (bf16_t*)F.lds;
    bf16_t* VT = (bf16_t*)(F.lds + 66560);
    bf16_t* SDl = (bf16_t*)(F.lds + 66560 + 17408);
    float* nvec = (float*)(F.lds + 118784);
    float* lwi = nvec + 512;
    float* lws = lwi + 128;
    float* lrs = lws + 128;
    float* lel = lrs + 128;
    bf16_t* nb16 = (bf16_t*)(lel + 128);
    bf16_t* hbuf = nb16 + 512;
    const int tid = F.tid, lane = F.lane, wave = F.wave, r31 = lane & 31, hh = lane >> 5;
    const int et2 = wave >> 2, tt = wave & 3;
    for (int unit = F.bid; unit < 256; unit += F.G) {
        const int xcd = unit & 7, jj = unit >> 3, seq = xcd * 4 + (jj >> 3), sl = jj & 7;
        const int b = seq >> 2, h = seq & 3, e0 = sl * 64;
        const size_t rb = (size_t)b * LP;
        f32x16 accC[2][2];
#pragma unroll
        for (int a2 = 0; a2 < 2; ++a2)
#pragma unroll
            for (int c2 = 0; c2 < 2; ++c2) accC[a2][c2] = zero16();
        nvec[tid] = 0.f;
#define P6_QLANE(tz) (QF + ((size_t)(seq * NCH) * 8 + ((tz) >> 6)) * 8192 + ((tz) & 63) * 8)
#define P6_KLANE(tz) (KTC + ((size_t)(seq * NCH) * 8 + ((tz) >> 6)) * 8192 + ((tz) & 63) * 8)
#define P6_VSRC(tz) (VTC + ((size_t)h * DHC + e0 + ((tz) >> 3)) * MPAD + rb + ((tz) & 7) * 16)
#define P6_SSRC(tz) (SD + ((size_t)seq * NCH * 128 + ((tz) >> 2)) * 128 + ((tz) & 3) * 32)
        int tu = tid; asm volatile("" : "+v"(tu));
        const bf16_t* qlane = P6_QLANE(tu); const bf16_t* vsrc = P6_VSRC(tu); const bf16_t* ssrc = P6_SSRC(tu);
        bf16x8 win[16];
#pragma unroll
        for (int u = 0; u < 16; ++u) win[u] = *(const bf16x8*)(qlane + 512 * u);
        u32x4 sv[2], ss[4];
        sv[0] = *(const u32x4*)(vsrc); sv[1] = *(const u32x4*)(vsrc + 8);
#pragma unroll
        for (int q = 0; q < 4; ++q) ss[q] = *(const u32x4*)(ssrc + 8 * q);
        float sa = 0.f, sm = 0.f, sb = 0.f, rs = 0.f, dn = 0.f, decay_prev = 0.f;
        if (tid < 128) { const size_t r = rb + tid; sa = SA[r * 4 + h]; sm = SM[r * 4 + h]; sb = SBt[r * 4 + h]; rs = RS[(size_t)(seq * NCH) * 128 + tid]; }
        float mprev = MPREV[seq * NCH], mtop = MTOP[seq * NCH];
        unsigned pf = 0u;
        for (int c = 0; c < NCH; ++c) {
            const int cu = seq * NCH + c;
            const int t0 = (c == 0) ? 0 : NMETA + 128 * (c - 1), len = (c == 0) ? NMETA : 128;
            const size_t r0 = rb + t0;
            const float decay = __expf(mprev - mtop);
#pragma unroll
            for (int dt = 0; dt < 2; ++dt)
#pragma unroll
                for (int et = 0; et < 2; ++et)
#pragma unroll
                    for (int g = 0; g < 4; ++g) {
                        u32x2 w; w.x = pk2(accC[dt][et][4 * g], accC[dt][et][4 * g + 1]); w.y = pk2(accC[dt][et][4 * g + 2], accC[dt][et][4 * g + 3]);
                        *(u32x2*)(CT + (32 * et + r31) * CTS + 64 * wave + 32 * dt + 8 * g + 4 * hh) = w;
                    }
            if (c == 0 && (tid & 7) != 0) { sv[0] = (u32x4){0u, 0u, 0u, 0u}; sv[1] = (u32x4){0u, 0u, 0u, 0u}; }
            *(u32x4*)(VT + (tid >> 3) * VTS + (tid & 7) * 16) = sv[0]; *(u32x4*)(VT + (tid >> 3) * VTS + (tid & 7) * 16 + 8) = sv[1];
#pragma unroll
            for (int q = 0; q < 4; ++q) *(u32x4*)(SDl + (tid >> 2) * SDS + (tid & 3) * 32 + 8 * q) = ss[q];
            asm volatile("" :: "v"(pf));
            { const float nv = (c > 0) ? decay_prev * nvec[tid] + dn : 0.f; nvec[tid] = nv; nb16[tid] = f2bf(nv); }
            if (tid < 128) {
                const bool v = tid < len;
                lwi[tid] = __expf(mprev - sm); lws[tid] = v ? __expf(sa - mtop) : 0.f; lrs[tid] = rs; lel[tid] = __expf(-(sb + sm));
            }
            __syncthreads();
            {
                const int l15 = lane & 15, kq = lane >> 4;
                const int t = 16 * wave + l15;
                f32x4 acc[4];
#pragma unroll
                for (int q4 = 0; q4 < 4; ++q4) acc[q4] = (f32x4){0.f, 0.f, 0.f, 0.f};
                float qn = 0.f;
                const bf16_t* ap = CT + l15 * CTS + 8 * kq;
                const bf16_t* np_ = nb16 + 8 * kq;
                int tz = tid; asm volatile("" : "+v"(tz));
                const bf16_t* kc0 = P6_KLANE(tz) + (size_t)c * 65536;
#pragma unroll
                for (int ks = 0; ks < 16; ++ks) {
                    const bf16x8 f = win[ks];
#pragma unroll
                    for (int q4 = 0; q4 < 4; ++q4) { const bf16x8 a_ = *(const bf16x8*)(ap + 16 * q4 * CTS + 32 * ks); acc[q4] = __builtin_amdgcn_mfma_f32_16x16x32_bf16(a_, f, acc[q4], 0, 0, 0); }
                    const u32x4 w_ = __builtin_bit_cast(u32x4, f); const u32x4 n_ = *(const u32x4*)(np_ + 32 * ks);
                    qn = __builtin_amdgcn_fdot2_f32_bf16(__builtin_bit_cast(bf16v2, w_.x), __builtin_bit_cast(bf16v2, n_.x), qn, false);
                    qn = __builtin_amdgcn_fdot2_f32_bf16(__builtin_bit_cast(bf16v2, w_.y), __builtin_bit_cast(bf16v2, n_.y), qn, false);
                    qn = __builtin_amdgcn_fdot2_f32_bf16(__builtin_bit_cast(bf16v2, w_.z), __builtin_bit_cast(bf16v2, n_.z), qn, false);
                    qn = __builtin_amdgcn_fdot2_f32_bf16(__builtin_bit_cast(bf16v2, w_.w), __builtin_bit_cast(bf16v2, n_.w), qn, false);
                    win[ks] = *(const bf16x8*)(kc0 + 512 * ks);
                }
                const float wi = lwi[t];
#pragma unroll
                for (int q4 = 0; q4 < 4; ++q4) acc[q4] *= wi;
                const bf16_t* vp = VT + l15 * VTS + 8 * kq;
                const bf16_t* sp = SDl + t * SDS + 8 * kq;
#pragma unroll
                for (int ks = 0; ks < 4; ++ks) {
                    const bf16x8 bq = *(const bf16x8*)(sp + 32 * ks);
#pragma unroll
                    for (int q4 = 0; q4 < 4; ++q4) { const bf16x8 a_ = *(const bf16x8*)(vp + 16 * q4 * VTS + 32 * ks); acc[q4] = __builtin_amdgcn_mfma_f32_16x16x32_bf16(a_, bq, acc[q4], 0, 0, 0); }
                }
                qn += __shfl_xor(qn, 16); qn += __shfl_xor(qn, 32);
                const float den = wi * qn + lrs[t];
                const float inv = 1.f / fmaxf(fabsf(den), lel[t]);
#pragma unroll
                for (int q4 = 0; q4 < 4; ++q4) { u32x2 w; w.x = pk2(acc[q4][0] * inv, acc[q4][1] * inv); w.y = pk2(acc[q4][2] * inv, acc[q4][3] * inv);
                    *(u32x2*)(hbuf + wave * 1024 + l15 * 64 + 16 * q4 + 4 * kq) = w; }
            }
            const int cn = (c + 1 < NCH) ? c + 1 : c;
            const int t0n = (cn == 0) ? 0 : NMETA + 128 * (cn - 1);
            { int tz = tid; asm volatile("" : "+v"(tz)); const bf16_t* vs_ = P6_VSRC(tz) + t0n; const bf16_t* ss_ = P6_SSRC(tz) + (size_t)cn * 16384;
              sv[0] = *(const u32x4*)(vs_); sv[1] = *(const u32x4*)(vs_ + 8);
#pragma unroll
              for (int q = 0; q < 4; ++q) ss[q] = *(const u32x4*)(ss_ + 8 * q); }
            if (tid < 128) { const size_t r = rb + t0n + tid; sa = SA[r * 4 + h]; sm = SM[r * 4 + h]; sb = SBt[r * 4 + h]; rs = RS[(size_t)(seq * NCH + cn) * 128 + tid]; }
            const float mprev_n = MPREV[seq * NCH + cn], mtop_n = MTOP[seq * NCH + cn];
            dn = DN[(size_t)cu * DHC + tid]; decay_prev = decay;
            if (tid < 256) {
                int tz = tid; asm volatile("" : "+v"(tz));
                const int li = sl * 256 + tz;
                const int cq = (c + 2 < NCH) ? c + 2 : NCH - 1, ck = (c + 1 < NCH) ? c + 1 : NCH - 1;
                const bf16_t* a_ = (li < 1024) ? QF + (size_t)(seq * NCH + cq) * 65536 + li * 64 : KTC + (size_t)(seq * NCH + ck) * 65536 + (li - 1024) * 64;
                pf = *(const unsigned*)a_;
            }
            {
#pragma unroll
                for (int dt = 0; dt < 2; ++dt)
#pragma unroll
                    for (int et = 0; et < 2; ++et)
#pragma unroll
                        for (int reg = 0; reg < 16; ++reg) accC[dt][et][reg] *= decay;
                int tz = tid; asm volatile("" : "+v"(tz));
                const bf16_t* qn0 = P6_QLANE(tz) + (size_t)cn * 65536;
                const bf16_t* vp0 = VT + r31 * VTS + 32 * hh;
                const bf16_t* vp1 = vp0 + 32 * VTS;
#pragma unroll
                for (int GP = 0; GP < 4; ++GP) {
                    const int G = GP >> 1, sb0 = 2 * (GP & 1);
                    bf16x8 vs0[2], vs1[2];
#pragma unroll
                    for (int sq = 0; sq < 2; ++sq) { vs0[sq] = *(const bf16x8*)(vp0 + 64 * G + 8 * (sb0 + sq)); vs1[sq] = *(const bf16x8*)(vp1 + 64 * G + 8 * (sb0 + sq)); }
#pragma unroll
                    for (int q = 0; q < 4; ++q) {
                        const int dt = q >> 1, sq = q & 1, i = 8 * G + 4 * dt + sb0 + sq;
                        const bf16x8 f = win[i];
                        if (dt == 0) { accC[0][0] = MFMA32(f, vs0[sq], accC[0][0]); accC[0][1] = MFMA32(f, vs1[sq], accC[0][1]); }
                        else { accC[1][0] = MFMA32(f, vs0[sq], accC[1][0]); accC[1][1] = MFMA32(f, vs1[sq], accC[1][1]); }
                        win[i] = *(const bf16x8*)(qn0 + 512 * i);
                        __builtin_amdgcn_sched_barrier(0);
                    }
                }
            }
            {
                const int tl = lane >> 2, ec = (lane & 3) * 16, t = 16 * wave + tl;
                const u32x4 h0 = *(const u32x4*)(hbuf + wave * 1024 + tl * 64 + ec), h1 = *(const u32x4*)(hbuf + wave * 1024 + tl * 64 + ec + 8);
                if (t < len) { bf16_t* dst = HH + (r0 + t) * INNER + h * DHC + e0 + ec; *(u32x4*)dst = h0; *(u32x4*)(dst + 8) = h1; }
            }
            __syncthreads();
            mprev = mprev_n; mtop = mtop_n;
        }
        {
            nvec[tid] = decay_prev * nvec[tid] + dn;
            float* cb = p.out + O_CP + ((size_t)seq * DHC) * DHC + (size_t)(64 * wave + 4 * hh) * DHC + e0 + r31;
            asm volatile("" : "+v"(cb));
#pragma unroll
            for (int dt = 0; dt < 2; ++dt)
#pragma unroll
                for (int et = 0; et < 2; ++et)
#pragma unroll
                    for (int reg = 0; reg < 16; ++reg) cb[(size_t)(32 * dt + (reg & 3) + 8 * (reg >> 2)) * DHC + 32 * et] = accC[dt][et][reg];
            if (sl == 0) p.out[O_NP + (size_t)seq * DHC + tid] = nvec[tid];
        }
        __syncthreads();
    }
}

DI void p6_mlstm_sample(const Params& p, const Frame& F) {
    const bf16_t* QC = (const bf16_t*)(p.ws + WS_QC); const bf16_t* KC = (const bf16_t*)(p.ws + WS_KC); const bf16_t* VTC = (const bf16_t*)(p.ws + WS_VTC);
    const float* SA = (const float*)(p.ws + WS_SA); const float* SM = (const float*)(p.ws + WS_SM); const float* SBt = (const float*)(p.ws + WS_SB);
    const float* MTOP = (const float*)(p.ws + WS_MTOP);
    bf16_t* HH = (bf16_t*)(p.ws + WS_HH);
    const float* stC = p.in[6]; const float* stn = p.in[7]; const float* stm = p.in[8];
    float* qk = (float*)F.lds;
    float* kraw = qk + 4096;
    float* nl = kraw + 2048;
    float* red = nl + 512;
    float* dots = red + 8192;
    float* sc = dots + 32;
    const int tid = F.tid, lane = F.lane, wave = F.wave;
    f32x4 cA[8], cB[8];
    if (F.bid < BS * HC) {
        const float* C0 = stC + ((size_t)F.bid * DHC + (tid >> 7) * 128) * DHC + (tid & 127) * 4;
#pragma unroll
        for (int u = 0; u < 8; ++u) cA[u] = __builtin_nontemporal_load((const f32x4*)(C0 + (size_t)u * DHC));
    }
    for (int item = F.bid; item < BS * HC; item += F.G) {
        const int sb = item >> 2, h = item & 3;
        const size_t rb = (size_t)MP + sb * 4;
        const float mprev = stm[item], MTc = MTOP[32 * NCH + item];
        const float decay = __expf(mprev - MTc);
        float wsr[4];
#pragma unroll
        for (int s = 0; s < 4; ++s) wsr[s] = __expf(SA[(rb + s) * 4 + h] - MTc);
        {
            const int d = tid;
#pragma unroll
            for (int t = 0; t < 4; ++t) qk[d * 8 + t] = bf2f(QC[(rb + t) * INNER + h * DHC + d]);
#pragma unroll
            for (int s = 0; s < 4; ++s) { const float kv = bf2f(KC[(rb + s) * INNER + h * DHC + d]); kraw[s * 512 + d] = kv; qk[d * 8 + 4 + s] = kv * wsr[s]; }
            nl[d] = stn[(size_t)item * DHC + d];
        }
        const int e4 = tid & 127, dg = tid >> 7;
        f32x4 vr[4];
        {
#pragma unroll
            for (int j = 0; j < 4; ++j) {
                const u32x2 w = *(const u32x2*)(VTC + ((size_t)h * DHC + e4 * 4 + j) * MPAD + rb);
                vr[0][j] = bflo(w.x); vr[1][j] = bfhi(w.x); vr[2][j] = bflo(w.y); vr[3][j] = bfhi(w.y);
            }
        }
        __syncthreads();
#pragma unroll
        for (int rep = 0; rep < 3; ++rep) {
            const int di = wave + 8 * rep;
            if (di < 20) {
                const int t = (di < 16) ? (di >> 2) : (di - 16);
                const float* other = (di < 16) ? (kraw + (di & 3) * 512) : nl;
                float acc = 0.f;
#pragma unroll
                for (int k = 0; k < 8; ++k) { const int d = lane + 64 * k; acc += qk[d * 8 + t] * other[d]; }
                acc = wave_sum(acc);
                if (lane == 0) dots[di] = acc;
            }
        }
        __syncthreads();
        if (tid < 4) {
            const int t = tid;
            const float M = SM[(rb + t) * 4 + h], bt = SBt[(rb + t) * 4 + h];
            const float wi = __expf(mprev - M);
            float rs = 0.f;
#pragma unroll
            for (int s = 0; s < 4; ++s) {
                const float v = (s <= t) ? dots[t * 4 + s] * __expf(SA[(rb + s) * 4 + h] - M) : 0.f;
                sc[16 + t * 4 + s] = v; rs += v;
            }
            const float den = wi * dots[16 + t] + rs;
            sc[t] = wi; sc[8 + t] = 1.f / fmaxf(fabsf(den), __expf(-(bt + M)));
        }
        f32x4 it[4];
#pragma unroll
        for (int t = 0; t < 4; ++t) it[t] = (f32x4){0.f, 0.f, 0.f, 0.f};
        {
            const float* Cin = stC + ((size_t)item * DHC + dg * 128) * DHC + e4 * 4;
            float* Cout = p.out + O_CS + ((size_t)item * DHC + dg * 128) * DHC + e4 * 4;
            const int nitem = (item + F.G < BS * HC) ? item + F.G : item;
            const float* Cnx = stC + ((size_t)nitem * DHC + dg * 128) * DHC + e4 * 4;
#define MS_LOAD(buf, base, bt) do { _Pragma("unroll") for (int u_ = 0; u_ < 8; ++u_) buf[u_] = __builtin_nontemporal_load((const f32x4*)((base) + (size_t)((bt) * 8 + u_) * DHC)); } while (0)
#define MS_USE(buf, bt) do { _Pragma("unroll") for (int u_ = 0; u_ < 8; ++u_) { const int d_ = dg * 128 + (bt) * 8 + u_; \
                const f32x4 qv_ = *(const f32x4*)(qk + d_ * 8), kw_ = *(const f32x4*)(qk + d_ * 8 + 4); \
                _Pragma("unroll") for (int t_ = 0; t_ < 4; ++t_) it[t_] += buf[u_] * qv_[t_]; \
                f32x4 cn_ = buf[u_] * decay; \
                _Pragma("unroll") for (int s_ = 0; s_ < 4; ++s_) cn_ += vr[s_] * kw_[s_]; \
                __builtin_nontemporal_store(cn_, (f32x4*)(Cout + (size_t)((bt) * 8 + u_) * DHC)); } } while (0)
            for (int bt = 0; bt < 16; bt += 2) {
                MS_LOAD(cB, Cin, bt + 1); MS_USE(cA, bt);
                if (bt + 2 < 16) MS_LOAD(cA, Cin, bt + 2); else MS_LOAD(cA, Cnx, 0);
                MS_USE(cB, bt + 1);
            }
#undef MS_LOAD
#undef MS_USE
        }
#pragma unroll
        for (int t = 0; t < 4; ++t) *(f32x4*)(red + (dg * 4 + t) * 512 + e4 * 4) = it[t];
        __syncthreads();
        {
            const int e = tid;
            float vcol[4];
            { const u32x2 w = *(const u32x2*)(VTC + ((size_t)h * DHC + e) * MPAD + rb); vcol[0] = bflo(w.x); vcol[1] = bfhi(w.x); vcol[2] = bflo(w.y); vcol[3] = bfhi(w.y); }
#pragma unroll
            for (int t = 0; t < 4; ++t) {
                const float inter = (red[(0 * 4 + t) * 512 + e] + red[(1 * 4 + t) * 512 + e]) + (red[(2 * 4 + t) * 512 + e] + red[(3 * 4 + t) * 512 + e]);
                float num = sc[t] * inter;
#pragma unroll
                for (int s = 0; s < 4; ++s) num += sc[16 + t * 4 + s] * vcol[s];
                HH[(rb + t) * INNER + h * DHC + e] = f2bf(num * sc[8 + t]);
            }
            float nn = decay * nl[tid];
#pragma unroll
            for (int s = 0; s < 4; ++s) nn += qk[tid * 8 + 4 + s];
            p.out[O_NS + (size_t)item * DHC + tid] = nn;
        }
        __syncthreads();
    }
}

DI void p6c_prep_out(const Params& p, const Frame& F) {
    const bf16_t* HH = (const bf16_t*)(p.ws + WS_HH); const bf16_t* CA = (const bf16_t*)(p.ws + WS_CA); const bf16_t* XMZ = (const bf16_t*)(p.ws + WS_XMZ);
    bf16_t* A2 = (bf16_t*)(p.ws + WS_A2);
    const float* skip = p.in[25]; const float* ong = p.in[26];
    const int gw = F.bid * 8 + F.wave, nw = F.G * 8, lane = F.lane;
    for (int task = gw; task < MT * 2; task += nw) {
        const int r = task >> 1, hbase = (task & 1) * 2;
        const float* ong_ = ong; const float* skip_ = skip; asm volatile("" : "+s"(ong_), "+s"(skip_));
        u32x4 hw[2], cw4[2], zw[2];
#pragma unroll
        for (int h = 0; h < 2; ++h) {
            const int c = (hbase + h) * DHC + lane * 8;
            hw[h] = *(const u32x4*)(HH + (size_t)r * INNER + c); cw4[h] = *(const u32x4*)(CA + (size_t)r * INNER + c); zw[h] = *(const u32x4*)(XMZ + (size_t)r * 4096 + INNER + c);
        }
#pragma unroll
        for (int h = 0; h < 2; ++h) {
            const int c = (hbase + h) * DHC + lane * 8;
            float x[8] = {bflo(hw[h].x), bfhi(hw[h].x), bflo(hw[h].y), bfhi(hw[h].y), bflo(hw[h].z), bfhi(hw[h].z), bflo(hw[h].w), bfhi(hw[h].w)};
            float sm_ = 0.f;
#pragma unroll
            for (int k = 0; k < 8; ++k) sm_ += x[k];
            const float mu = wave_sum(sm_) * (1.f / DHC);
            float q = 0.f;
#pragma unroll
            for (int k = 0; k < 8; ++k) { x[k] -= mu; q += x[k] * x[k]; }
            const float rstd = rsqrtf(wave_sum(q) * (1.f / DHC) + EPS);
            const float cav[8] = {bflo(cw4[h].x), bfhi(cw4[h].x), bflo(cw4[h].y), bfhi(cw4[h].y), bflo(cw4[h].z), bfhi(cw4[h].z), bflo(cw4[h].w), bfhi(cw4[h].w)};
            const float zv[8] = {bflo(zw[h].x), bfhi(zw[h].x), bflo(zw[h].y), bfhi(zw[h].y), bflo(zw[h].z), bfhi(zw[h].z), bflo(zw[h].w), bfhi(zw[h].w)};
            const f32x4 g0 = *(const f32x4*)(ong_ + c), g1 = *(const f32x4*)(ong_ + c + 4), s0 = *(const f32x4*)(skip_ + c), s1 = *(const f32x4*)(skip_ + c + 4);
            const float gv[8] = {g0[0], g0[1], g0[2], g0[3], g1[0], g1[1], g1[2], g1[3]};
            const float sv[8] = {s0[0], s0[1], s0[2], s0[3], s1[0], s1[1], s1[2], s1[3]};
            float o[8];
#pragma unroll
            for (int k = 0; k < 8; ++k) o[k] = (x[k] * rstd * gv[k] + sv[k] * cav[k]) * silu_f(zv[k]);
            u32x4 w; w.x = pk2(o[0], o[1]); w.y = pk2(o[2], o[3]); w.z = pk2(o[4], o[5]); w.w = pk2(o[6], o[7]);
            *(u32x4*)(A2 + (size_t)r * INNER + c) = w;
        }
    }
    const int gt = F.bid * NTHREADS + F.tid, nt = F.G * NTHREADS;
    for (int idx = gt; idx < (MPAD - MT) * (INNER / 8); idx += nt) *(u32x4*)(A2 + (size_t)MT * INNER + (size_t)idx * 8) = (u32x4){0u, 0u, 0u, 0u};
}

DI void p8_final_norm(const Params& p, const Frame& F) {
    const bf16_t* HB = (const bf16_t*)(p.ws + WS_H); const float* gf = p.in[12]; const float* PART = (const float*)(p.ws + WS_PART);
    const int gw = F.bid * 8 + F.wave, nw = F.G * 8, lane = F.lane;
    constexpr int RB = 4;
    for (int r0 = gw * RB; r0 < MT; r0 += nw * RB) {
        float* dst;
        if (r0 < MP) { const int b = r0 / LP, t = r0 - b * LP; if (t < NMETA) continue; dst = p.out + O_YP + ((size_t)b * SEQ + (t - NMETA)) * D; }
        else dst = p.out + O_YS + (size_t)(r0 - MP) * D;
        u32x4 hw[RB][2];
#pragma unroll
        for (int rr = 0; rr < RB; ++rr)
#pragma unroll
            for (int j = 0; j < 2; ++j) hw[rr][j] = *(const u32x4*)(HB + (size_t)(r0 + rr) * D + j * 512 + lane * 8);
#pragma unroll
        for (int rr = 0; rr < RB; ++rr) {
            float v[2][8]; float ss = 0.f;
#pragma unroll
            for (int j = 0; j < 2; ++j) {
                const u32x4 w = hw[rr][j];
                v[j][0] = bflo(w.x); v[j][1] = bfhi(w.x); v[j][2] = bflo(w.y); v[j][3] = bfhi(w.y); v[j][4] = bflo(w.z); v[j][5] = bfhi(w.z); v[j][6] = bflo(w.w); v[j][7] = bfhi(w.w);
                if (r0 >= MMAIN) {
#pragma unroll
                    for (int ks = 0; ks < 8; ++ks) {
                        const float* pp = PART + ((size_t)ks * 768 + (r0 + rr - MMAIN)) * D + j * 512 + lane * 8;
                        const f32x4 a0 = *(const f32x4*)pp, a1 = *(const f32x4*)(pp + 4);
                        v[j][0] += a0[0]; v[j][1] += a0[1]; v[j][2] += a0[2]; v[j][3] += a0[3]; v[j][4] += a1[0]; v[j][5] += a1[1]; v[j][6] += a1[2]; v[j][7] += a1[3];
                    }
                }
#pragma unroll
                for (int k = 0; k < 8; ++k) ss += v[j][k] * v[j][k];
            }
            const float rstd = rsqrtf(wave_sum(ss) * (1.f / D) + EPS);
#pragma unroll
            for (int j = 0; j < 2; ++j) {
                const int c = j * 512 + lane * 8;
                const f32x4 ga = *(const f32x4*)(gf + c), gb = *(const f32x4*)(gf + c + 4);
                *(f32x4*)(dst + (size_t)rr * D + c) = (f32x4){v[j][0] * rstd * ga[0], v[j][1] * rstd * ga[1], v[j][2] * rstd * ga[2], v[j][3] * rstd * ga[3]};
                *(f32x4*)(dst + (size_t)rr * D + c + 4) = (f32x4){v[j][4] * rstd * gb[0], v[j][5] * rstd * gb[1], v[j][6] * rstd * gb[2], v[j][7] * rstd * gb[3]};
            }
        }
    }
}

DI Params fresh_params() {
    Params q;
#if defined(__HIP_DEVICE_COMPILE__)
    const __attribute__((address_space(4))) unsigned long long* k = (const __attribute__((address_space(4))) unsigned long long*)__builtin_amdgcn_kernarg_segment_ptr();
    asm volatile("" : "+s"(k));
#pragma unroll
    for (int i = 0; i < 28; ++i) q.in[i] = (const float*)(const __attribute__((address_space(1))) float*)k[i];
    q.out = (float*)(__attribute__((address_space(1))) float*)k[28]; q.ws = (unsigned char*)(__attribute__((address_space(1))) unsigned char*)k[29];
    const unsigned long long w = k[30]; q.ph_lo = (int)(unsigned)w; q.ph_hi = (int)(unsigned)(w >> 32);
#else
    q = Params{};
#endif
    return q;
}

constexpr int NPHASE = 14;
__global__ void __launch_bounds__(NTHREADS, 2) fwd_kernel(Params p_unused) {
    extern __shared__ __attribute__((aligned(16))) unsigned char lds_raw[];
    LAS unsigned char* ldsl = (LAS unsigned char*)lds_raw;
    volatile LAS unsigned* ctl = (volatile LAS unsigned*)(ldsl + LDS_CTL_OFF);
    if (threadIdx.x < 4) ctl[threadIdx.x] = 0u;
    __syncthreads();
    int lo, hi; unsigned* barw; { const Params q = fresh_params(); lo = q.ph_lo; hi = q.ph_hi; barw = (unsigned*)(q.ws + WS_CTL); }
    XcdBarrier bar; bar.bar = barw; bar.x = 0; bar.st = ctl;
    if (hi - lo > 1) bar = xcd_barrier_post(barw, ctl);
#ifndef PHMASK
#define PHMASK 0xFFFFFFFFu
#endif
#define IN(k) ((((PHMASK) >> (k)) & 1u) && lo <= (k) && (k) < hi)
#define SEAM(k) do { if (IN(k) && IN((k) + 1)) xcd_barrier(bar); } while (0)

    if (IN(0)) { const Params p = fresh_params(); const Frame F = make_frame(lds_raw); p0_prologue(p, F); }
    SEAM(0);
    if (IN(1)) {
        const Params p = fresh_params(); const Frame F = make_frame(lds_raw); unsigned char* ws = p.ws;
        pg8::Gemm g{(const bf16_t*)(ws + WS_XN), (const bf16_t*)(ws + WS_WTINA), D, D, D};
        pg8::StaticOrder<0> S; S.init(MPAD, NA, F.G, F.bid);
        EpiInA E{(bf16_t*)(ws + WS_PROJA), (float*)(ws + WS_U32), p.out, (bf16_t*)(ws + WS_VTA)};
        pg8::gemm_phase(ldsl, g, S, E);
    }
    SEAM(1);
    if (IN(2)) {
        const bool sample_first = ((blockIdx.x >> 3) & 1) == 0;
        if (sample_first) { const Params p = fresh_params(); const Frame F = make_frame(lds_raw); p2_attn_sample(p, F); }
        { const Params p = fresh_params(); const Frame F = make_frame(lds_raw); p2_attn_prompt(p, F); }
        { const Params p = fresh_params(); const Frame F = make_frame(lds_raw); p2_pool(p, F); }
        if (!sample_first) { const Params p = fresh_params(); const Frame F = make_frame(lds_raw); p2_attn_sample(p, F); }
    }
    SEAM(2);
    if (IN(3)) { const Params p = fresh_params(); const Frame F = make_frame(lds_raw); p2d_combine(p, F); }
    SEAM(3);
    if (IN(4)) {
        const Params p = fresh_params(); const Frame F = make_frame(lds_raw); unsigned char* ws = p.ws;
        {
            pg8::Gemm g{(const bf16_t*)(ws + WS_MIXED), (const bf16_t*)(ws + WS_WTOUTA), D, D, D};
            pg8::StaticOrder<0> S; S.init(MMAIN, D, F.G, F.bid);
            EpiResX E{(bf16_t*)(ws + WS_H), p.in[0], p.in[1], p.in[10]};
            pg8::gemm_phase(ldsl, g, S, E);
        }
        {
            pg8::Gemm g{(const bf16_t*)(ws + WS_MIXED), (const bf16_t*)(ws + WS_WTOUTA), D, D, 256};
            pg8::TailOrder S; S.init(4, 256, F.G, (F.bid + 128) % F.G);
            EpiPart E{(float*)(ws + WS_PART), 256};
            pg8::gemm_phase(ldsl, g, S, E);
        }
    }
    SEAM(4);
    if (IN(5)) { const Params p = fresh_params(); const Frame F = make_frame(lds_raw); p3b_norm_gates(p, F); }
    SEAM(5);
    if (IN(6)) {
        const Params p = fresh_params(); const Frame F = make_frame(lds_raw); unsigned char* ws = p.ws;
        p4_scan(p, F);
        pg8::Gemm g{(const bf16_t*)(ws + WS_XN), (const bf16_t*)(ws + WS_WTINC), D, D, D};
        pg8::InCMainOrder S{F.G, F.bid};
        EpiInC E{(bf16_t*)(ws + WS_XMZ), p.out};
        pg8::gemm_phase(ldsl, g, S, E);
    }
    SEAM(6);
    if (IN(7)) {
        { const Params p = fresh_params(); const Frame F = make_frame(lds_raw); p4b_conv(p, F); }
        {
            const Params p = fresh_params(); const Frame F = make_frame(lds_raw);
            bf16_t* KTC = (bf16_t*)(p.ws + WS_KTC);
            for (int idx = F.bid * NTHREADS + F.tid; idx < 32 * 8192; idx += F.G * NTHREADS)
                *(u32x4*)(KTC + (size_t)(idx >> 13) * NCH * 65536 + (size_t)(idx & 8191) * 8) = (u32x4){0u, 0u, 0u, 0u};
        }
    }
    SEAM(7);
    if (IN(8)) {
        const Params p = fresh_params(); const Frame F = make_frame(lds_raw); unsigned char* ws = p.ws;
        {
            pg8::Gemm g{(const bf16_t*)(ws + WS_CA), (const bf16_t*)(ws + WS_WTQ), INNER, DHC, DHC};
            pg8::StaticOrder<1> S; S.init(MPAD, 4096, F.G, F.bid);
            EpiQK E{(bf16_t*)(ws + WS_QC), (bf16_t*)(ws + WS_KC), (bf16_t*)(ws + WS_KTC), (bf16_t*)(ws + WS_QF)};
            pg8::gemm_phase(ldsl, g, S, E);
        }
        {
            pg8::Gemm g{(const bf16_t*)(ws + WS_XN), (const bf16_t*)(ws + WS_WTINC), D, D, D};
            pg8::InCTailOrder S{F.G, F.bid};
            EpiInC E{(bf16_t*)(ws + WS_XMZ), p.out};
            pg8::gemm_phase(ldsl, g, S, E);
        }
        {
            pg8::Gemm g{(const bf16_t*)(ws + WS_WTV), (const bf16_t*)(ws + WS_XMZ), DHC, 4096, DHC};
            pg8::VtOrder S{F.G, F.bid};
            EpiVTs E{(bf16_t*)(ws + WS_VTC), (const float*)(ws + WS_SA), (const float*)(ws + WS_MTOP)};
            pg8::gemm_phase(ldsl, g, S, E);
        }
    }
    SEAM(8);
    if (IN(9)) { const Params p = fresh_params(); const Frame F = make_frame(lds_raw); p5b_chunk_scores(p, F); }
    SEAM(9);
    if (IN(10)) {
        const bool sample_first = ((blockIdx.x >> 6) & 1) == 0;
        if (sample_first) { const Params p = fresh_params(); const Frame F = make_frame(lds_raw); p6_mlstm_sample(p, F); }
        { const Params p = fresh_params(); const Frame F = make_frame(lds_raw); p6_mlstm_prompt(p, F); }
        if (!sample_first) { const Params p = fresh_params(); const Frame F = make_frame(lds_raw); p6_mlstm_sample(p, F); }
    }
    SEAM(10);
    if (IN(11)) { const Params p = fresh_params(); const Frame F = make_frame(lds_raw); p6c_prep_out(p, F); }
    SEAM(11);
    if (IN(12)) {
        const Params p = fresh_params(); const Frame F = make_frame(lds_raw); unsigned char* ws = p.ws;
        {
            pg8::Gemm g{(const bf16_t*)(ws + WS_A2), (const bf16_t*)(ws + WS_WTOUTC), INNER, INNER, INNER};
            pg8::StaticOrder<0> S; S.init(MMAIN, D, F.G, F.bid);
            EpiAddHB E{(bf16_t*)(ws + WS_H)};
            pg8::gemm_phase(ldsl, g, S, E);
        }
        {
            pg8::Gemm g{(const bf16_t*)(ws + WS_A2), (const bf16_t*)(ws + WS_WTOUTC), INNER, INNER, 256};
            pg8::TailOrder S; S.init(8, 256, F.G, (F.bid + 128) % F.G);
            EpiPart E{(float*)(ws + WS_PART), 256};
            pg8::gemm_phase(ldsl, g, S, E);
        }
    }
    SEAM(12);
    if (IN(13)) { const Params p = fresh_params(); const Frame F = make_frame(lds_raw); p8_final_norm(p, F); }
#undef IN
#undef SEAM
}

#ifndef MK_ONE_LAUNCH
#define MK_ONE_LAUNCH 1
#endif

extern "C" void kernel_launch(void* const* d_in, const int* in_sizes, int n_in, void* d_out, int out_size, void* d_ws, size_t ws_size, hipStream_t stream) {
    static int grid = 0;
    if (grid == 0) {
        if (n_in != 28 || (size_t)out_size != O_END || ws_size < WS_END) {
            fprintf(stderr, "kernel_launch: unexpected shapes: n_in %d out %d (want %zu) ws %zu (want >= %zu)\n", n_in, out_size, (size_t)O_END, ws_size, (size_t)WS_END);
            grid = -1; return;
        }
        int dev = 0, cus = 0, per_cu = 0;
        if (hipGetDevice(&dev) != hipSuccess || hipDeviceGetAttribute(&cus, hipDeviceAttributeMultiprocessorCount, dev) != hipSuccess) { grid = -1; return; }
        if (hipFuncSetAttribute((const void*)fwd_kernel, hipFuncAttributeMaxDynamicSharedMemorySize, LDS_BYTES) != hipSuccess) { fprintf(stderr, "kernel_launch: hipFuncSetAttribute failed\n"); grid = -1; return; }
        if (hipOccupancyMaxActiveBlocksPerMultiprocessor(&per_cu, (const void*)fwd_kernel, NTHREADS, LDS_BYTES) != hipSuccess || per_cu < 1)
            fprintf(stderr, "kernel_launch: occupancy query reports %d workgroups per CU\n", per_cu);
        (void)hipGetLastError();
        grid = cus;
    }
    if (grid < 0) return;
    (void)hipMemsetAsync((char*)d_ws + WS_CTL, 0, 65536, stream);
    Params p{};
    for (int i = 0; i < 28; ++i) p.in[i] = (const float*)d_in[i];
    p.out = (float*)d_out; p.ws = (unsigned char*)d_ws;
#if MK_ONE_LAUNCH
    p.ph_lo = 0; p.ph_hi = NPHASE;
    hipLaunchKernelGGL(fwd_kernel, dim3(grid), dim3(NTHREADS), LDS_BYTES, stream, p);
#else
    for (int k = 0; k < NPHASE; ++k) { p.ph_lo = k; p.ph_hi = k + 1; hipLaunchKernelGGL(fwd_kernel, dim3(grid), dim3(NTHREADS), LDS_BYTES, stream, p); }
#endif
}
```

```cpp
#include <hip/hip_runtime.h>
#include <cstdio>
#include <cstdint>

#define LAS __attribute__((address_space(3)))
#define DI __device__ __forceinline__

typedef unsigned short bf16_t;
typedef short bf16x8 __attribute__((ext_vector_type(8)));
typedef short bf16x4 __attribute__((ext_vector_type(4)));
typedef float f32x4 __attribute__((ext_vector_type(4)));
typedef float f32x2 __attribute__((ext_vector_type(2)));
typedef float f32x16 __attribute__((ext_vector_type(16)));
typedef unsigned u32x4 __attribute__((ext_vector_type(4)));
typedef unsigned u32x2 __attribute__((ext_vector_type(2)));
typedef __bf16 bf16v2 __attribute__((ext_vector_type(2)));

constexpr int D = 1024, BP = 8, SEQ = 2048, NMETA = 16, LP = NMETA + SEQ  , MP = BP * LP  ;
constexpr int BS = 128, TS = 4, MS = BS * TS  , MT = MP + MS  , MPAD = 17152  ;
constexpr int WA = 512, HA = 8, DHA = 64, WB = 512, NG = 4, GC = 128, PMAX = 16;
constexpr int INNER = 2048, HC = 4, DHC = 512, NCH = 17;
constexpr int NPAGES = 16, PAGE = 128, NPOOL = 2560;
constexpr int LPV = 2112;
constexpr int NA = 3072, NC = 4104;
constexpr float EPS = 1e-6f;
constexpr int NSEQ = BP * HC + BS * HC;

constexpr size_t O_YP = 0;
constexpr size_t O_YS = O_YP + (size_t)BP * SEQ * D;
constexpr size_t O_KP = O_YS + (size_t)MS * D;
constexpr size_t O_VP = O_KP + (size_t)MP * WA;
constexpr size_t O_KS = O_VP + (size_t)MP * WA;
constexpr size_t O_VS = O_KS + (size_t)MS * WA;
constexpr size_t O_POOLP = O_VS + (size_t)MS * WA;
constexpr size_t O_POOLS = O_POOLP + (size_t)BP * 15 * WB;
constexpr size_t O_CP = O_POOLS + (size_t)BS * 15 * WB;
constexpr size_t O_CS = O_CP + (size_t)BP * HC * DHC * DHC;
constexpr size_t O_NP = O_CS + (size_t)BS * HC * DHC * DHC;
constexpr size_t O_NS = O_NP + (size_t)BP * HC * DHC;
constexpr size_t O_MP = O_NS + (size_t)BS * HC * DHC;
constexpr size_t O_MS = O_MP + (size_t)BP * HC;
constexpr size_t O_CVP = O_MS + (size_t)BS * HC;
constexpr size_t O_CVS = O_CVP + (size_t)BP * 3 * INNER;
constexpr size_t O_END = O_CVS + (size_t)BS * 3 * INNER;

constexpr size_t al256(size_t x) { return (x + 255) & ~(size_t)255; }
constexpr size_t WS_CTL = 0;
constexpr size_t WS_H = 65536;
constexpr size_t WS_XN = al256(WS_H + (size_t)MPAD * D * 2);
constexpr size_t WS_WTINA = al256(WS_XN + (size_t)MPAD * D * 2);
constexpr size_t WS_WTOUTA = al256(WS_WTINA + (size_t)NA * D * 2);
constexpr size_t WS_WTPOOL = al256(WS_WTOUTA + (size_t)D * D * 2);
constexpr size_t WS_WTINC = al256(WS_WTPOOL + (size_t)NG * GC * GC * 2);
constexpr size_t WS_WG = al256(WS_WTINC + (size_t)4096 * D * 2);
constexpr size_t WS_WTQ = al256(WS_WG + (size_t)8 * D * 4);
constexpr size_t WS_WTK = WS_WTQ + (size_t)HC * DHC * DHC * 2;
constexpr size_t WS_WTV = al256(WS_WTK + (size_t)HC * DHC * DHC * 2);
constexpr size_t WS_WTOUTC = al256(WS_WTV + (size_t)HC * DHC * DHC * 2);
constexpr size_t WS_PROJA = al256(WS_WTOUTC + (size_t)D * INNER * 2);
constexpr size_t WS_U32 = al256(WS_PROJA + (size_t)MPAD * NA * 2);
constexpr size_t WS_VTA = al256(WS_U32 + (size_t)MPAD * WB * 4);
constexpr size_t WS_MIXED = al256(WS_VTA + (size_t)BP * WA * LPV * 2);
constexpr size_t WS_SPART = al256(WS_MIXED + (size_t)MPAD * D * 2);
constexpr size_t WS_ST = al256(WS_SPART + (size_t)BS * NPAGES * HA * TS * DHA * 4);
constexpr size_t WS_LOGI = al256(WS_ST + (size_t)BS * NPAGES * 32 * 4);
constexpr size_t WS_LOGF = al256(WS_LOGI + (size_t)MPAD * 4 * 4);
constexpr size_t WS_SA = al256(WS_LOGF + (size_t)MPAD * 4 * 4);
constexpr size_t WS_SM = al256(WS_SA + (size_t)MPAD * 4 * 4);
constexpr size_t WS_SB = al256(WS_SM + (size_t)MPAD * 4 * 4);
constexpr size_t WS_MPREV = al256(WS_SB + (size_t)MPAD * 4 * 4);
constexpr size_t WS_MTOP = al256(WS_MPREV + (size_t)(32 * NCH + 512) * 4);
constexpr size_t WS_XMZ = al256(WS_MTOP + (size_t)(32 * NCH + 512) * 4);
constexpr size_t WS_CA = al256(WS_XMZ + (size_t)MPAD * 4096 * 2);
constexpr size_t WS_QC = al256(WS_CA + (size_t)MPAD * INNER * 2);
constexpr size_t WS_KC = al256(WS_QC + (size_t)MPAD * INNER * 2);
constexpr size_t WS_KTC = al256(WS_KC + (size_t)MPAD * INNER * 2);
constexpr size_t WS_VTC = al256(WS_KTC + (size_t)32 * 17 * 65536 * 2);
constexpr size_t WS_SD = al256(WS_VTC + (size_t)MPAD * INNER * 2);
constexpr size_t WS_RS = al256(WS_SD + (size_t)32 * NCH * 128 * 128 * 2);
constexpr size_t WS_DN = al256(WS_RS + (size_t)32 * NCH * 128 * 4);
constexpr size_t WS_HH = al256(WS_DN + (size_t)32 * NCH * 512 * 4);
constexpr size_t WS_A2 = al256(WS_HH + (size_t)MPAD * INNER * 2);
constexpr size_t WS_PART = al256(WS_A2 + (size_t)MPAD * INNER * 2);
constexpr size_t WS_QF = al256(WS_PART + (size_t)8 * 768 * D * 4);
constexpr size_t WS_END = al256(WS_QF + (size_t)32 * 17 * 65536 * 2);

constexpr int MMAIN = 16384;
constexpr int LDS_BYTES = 147456;
constexpr int LDS_CTL_OFF = 147456 - 256;
constexpr int NTHREADS = 512;

struct Params {
    const float* in[28];
    float* out;
    unsigned char* ws;
    int ph_lo, ph_hi;
};

DI unsigned pk2(float a, float b) { bf16v2 v = __builtin_convertvector((f32x2){a, b}, bf16v2); return __builtin_bit_cast(unsigned, v); }
DI bf16_t f2bf(float a) { return (bf16_t)(pk2(a, 0.f) & 0xffffu); }
DI float bf2f(bf16_t v) { return __uint_as_float(((unsigned)v) << 16); }
DI float bflo(unsigned w) { return __uint_as_float(w << 16); }
DI float bfhi(unsigned w) { return __uint_as_float(w & 0xffff0000u); }
DI float wave_sum_bperm(float v) {
#pragma unroll
    for (int o = 32; o > 0; o >>= 1) v += __shfl_xor(v, o);
    return v;
}
template <int CTRL> DI float dpp_mov_f(float v) { return __builtin_bit_cast(float, __builtin_amdgcn_update_dpp(0, __builtin_bit_cast(int, v), CTRL, 0xF, 0xF, false)); }
template <int CTRL> DI float dpp_shl_zero(float v) { return __builtin_bit_cast(float, __builtin_amdgcn_update_dpp(0, __builtin_bit_cast(int, v), CTRL, 0xF, 0xF, true)); }
DI float row16_sum(float v) { v += dpp_mov_f<0x128>(v); v += dpp_mov_f<0x124>(v); v += dpp_mov_f<0x122>(v); v += dpp_mov_f<0x121>(v); return v; }
template <int CTRL, int RMASK> DI float dpp_old_f(float old, float v) { return __builtin_bit_cast(float, __builtin_amdgcn_update_dpp(__builtin_bit_cast(int, old), __builtin_bit_cast(int, v), CTRL, RMASK, 0xF, false)); }
DI float wave_scan_add(float v) {
    v += dpp_old_f<0x111, 0xF>(0.f, v); v += dpp_old_f<0x112, 0xF>(0.f, v); v += dpp_old_f<0x114, 0xF>(0.f, v); v += dpp_old_f<0x118, 0xF>(0.f, v);
    v += dpp_old_f<0x142, 0xA>(0.f, v); v += dpp_old_f<0x143, 0xC>(0.f, v);
    return v;
}
DI float wave_scan_max(float v) {
    const float ninf = -INFINITY;
    v = fmaxf(v, dpp_old_f<0x111, 0xF>(ninf, v)); v = fmaxf(v, dpp_old_f<0x112, 0xF>(ninf, v)); v = fmaxf(v, dpp_old_f<0x114, 0xF>(ninf, v)); v = fmaxf(v, dpp_old_f<0x118, 0xF>(ninf, v));
    v = fmaxf(v, dpp_old_f<0x142, 0xA>(ninf, v)); v = fmaxf(v, dpp_old_f<0x143, 0xC>(ninf, v));
    return v;
}
DI float wave_sum(float v) { v = row16_sum(v); v += __shfl_xor(v, 16); v += __shfl_xor(v, 32); return v; }
DI float softplus_f(float z) {
    const float t = __expf(-fabsf(z));
    const float l = (t < 0.02f) ? t * (1.f - t * (0.5f - t * (0.33333333f - 0.25f * t))) : __logf(1.f + t);
    return fmaxf(z, 0.f) + l;
}
DI float silu_f(float x) { return x / (1.f + __expf(-x)); }
DI bf16x8 pack8(const f32x16& x, int s) {
    u32x4 p;
    p.x = pk2(x[8 * s + 0], x[8 * s + 1]); p.y = pk2(x[8 * s + 2], x[8 * s + 3]); p.z = pk2(x[8 * s + 4], x[8 * s + 5]); p.w = pk2(x[8 * s + 6], x[8 * s + 7]);
    return __builtin_bit_cast(bf16x8, p);
}
DI bf16x8 cat4(bf16x4 a, bf16x4 b) { return __builtin_shufflevector(a, b, 0, 1, 2, 3, 4, 5, 6, 7); }
#define MFMA32(a, b, c) __builtin_amdgcn_mfma_f32_32x32x16_bf16((a), (b), (c), 0, 0, 0)
DI f32x16 zero16() { f32x16 z;
#pragma unroll
    for (int i = 0; i < 16; ++i) z[i] = 0.f;
    return z; }
DI int crow(int reg, int h) { return (reg & 3) + 8 * (reg >> 2) + 4 * h; }

#define XB_TMO      128
#define XB_XCNT(j)  (256  + 64 * (j))
#define XB_XSUB(j)  (1280 + 64 * (j))
#define XB_XGEN(j)  (2304 + 64 * (j))
#define XB_TOP      3328
#define XB_TOPGEN   3392
#define XCD_BAR_WORDS 3456
#define XB_SPIN_CAP (1u << 18)

__device__ __forceinline__ unsigned xb_ld(unsigned* p)              { return __hip_atomic_load(p, __ATOMIC_RELAXED, __HIP_MEMORY_SCOPE_AGENT); }
__device__ __forceinline__ unsigned xb_add(unsigned* p, unsigned v) { return __hip_atomic_fetch_add(p, v, __ATOMIC_RELAXED, __HIP_MEMORY_SCOPE_AGENT); }
__device__ __forceinline__ unsigned xb_xcc_id() { return (unsigned)__builtin_amdgcn_s_getreg((3 << 11) | 20) & 0xFu; }
#define XB_SPIN(cond, bar) do { unsigned _sp = 0; while (cond) { __builtin_amdgcn_s_sleep(1); \
    if ((++_sp & 255u) == 0u) { if (xb_ld(&(bar)[XB_TMO])) break; if (_sp > XB_SPIN_CAP) { atomicAdd(&(bar)[XB_TMO], 1u); break; } } } } while (0)

struct XcdBarrier { unsigned* bar; unsigned x; volatile LAS unsigned* st; };

__device__ __forceinline__ XcdBarrier xcd_barrier_post(unsigned* bar, volatile LAS unsigned* st) {
    XcdBarrier b; b.bar = bar; b.x = xb_xcc_id(); b.st = st;
    if (threadIdx.x == 0) (void)xb_add(&bar[XB_XCNT(b.x)], 1u);
    return b;
}
__device__ __forceinline__ void xcd_barrier_complete(unsigned* bar, unsigned x, unsigned& nloc, unsigned& nx) {
    const unsigned G = gridDim.x * gridDim.y * gridDim.z;
    unsigned sum, cnt, mine, sp = 0u;
    for (;;) {
        sum = 0u; cnt = 0u; mine = 0u;
#pragma unroll
        for (unsigned j = 0; j < 16; ++j) { const unsigned c = xb_ld(&bar[XB_XCNT(j)]); sum += c; cnt += (c > 0u) ? 1u : 0u; mine = (j == x) ? c : mine; }
        if (sum == G) break;
        __builtin_amdgcn_s_sleep(1);
        if ((++sp & 255u) == 0u) { if (xb_ld(&bar[XB_TMO])) break; if (sp > XB_SPIN_CAP) { atomicAdd(&bar[XB_TMO], 1u); break; } }
    }
    nloc = mine > 0u ? mine : 1u; nx = cnt > 0u ? cnt : 1u;
}
__device__ __forceinline__ void xcd_barrier(const XcdBarrier& b) {
    asm volatile("s_waitcnt vmcnt(0)" ::: "memory");
    __syncthreads();
    if (threadIdx.x == 0) {
        unsigned* bar = b.bar;
        __builtin_amdgcn_s_waitcnt(0);
        unsigned nloc = b.st[0], nx = b.st[1];
        if (nloc == 0u) { xcd_barrier_complete(bar, b.x, nloc, nx); b.st[0] = nloc; b.st[1] = nx; }
        const unsigned old = xb_add(&bar[XB_XSUB(b.x)], 1u);
        const unsigned gen = old / nloc;
        if (old + 1u == (gen + 1u) * nloc) {
            __builtin_amdgcn_fence(__ATOMIC_RELEASE, "agent");
            asm volatile("s_waitcnt vmcnt(0)" ::: "memory");
            const unsigned og = xb_add(&bar[XB_TOP], 1u);
            const unsigned tg = og / nx;
            if (og + 1u == (tg + 1u) * nx) xb_add(&bar[XB_TOPGEN], 1u);
            else XB_SPIN(xb_ld(&bar[XB_TOPGEN]) == tg, bar);
            __builtin_amdgcn_fence(__ATOMIC_ACQUIRE, "agent");
            xb_add(&bar[XB_XGEN(b.x)], 1u);
            asm volatile("s_waitcnt vmcnt(0)" ::: "memory");
        } else {
            XB_SPIN(xb_ld(&bar[XB_XGEN(b.x)]) == gen, bar);
            __builtin_amdgcn_fence(__ATOMIC_ACQUIRE, "agent");
            asm volatile("s_waitcnt vmcnt(0)" ::: "memory");
        }
    }
    __syncthreads();
}

namespace pg8 {
constexpr int BM = 256, BK = 64, HALF = 128, HTB = HALF * BK * 2, STAGE_BYTES = 8 * HTB, NXCD = 8, WGM = 8;
__host__ __device__ __forceinline__ int lds_byte(int r, int c) { const int st = (r >> 4) * 2 + (c >> 5), rr = r & 15, cc = c & 31, ob = rr * 64 + cc * 2; return st * 1024 + (ob ^ (((ob >> 9) & 1) << 5)); }
__host__ __device__ __forceinline__ void stage_rc(int b, int& R, int& C) { const int st = b / 1024, sb = b % 1024, swz = sb ^ (((sb >> 9) & 1) << 5); R = (st >> 1) * 16 + swz / 64; C = (st & 1) * 32 + (swz % 64) / 2; }
__host__ __device__ __forceinline__ int perm32(int rho) { const int n = rho >> 4, i = rho & 15; return 8 * (i >> 2) + 4 * n + (i & 3); }

struct Unit { int pm, pn, aoff, boff; };
struct Gemm { const bf16_t* A; const bf16_t* Bt; int lda, ldb, K; };

template <int OFFK> struct StaticOrder {
    int nM, nN, nwg, G, c;
    __device__ void init(int M, int N, int G_, int c_) { nM = M / BM; nN = N / BM; nwg = nM * nN; G = G_; c = c_; }
    __device__ bool next(int i, Unit& u) const {
        const long L = (long)i * G + c; if (L >= nwg) return false;
        int wgid = (int)L; { const int q = nwg / NXCD, r = nwg % NXCD, xcd = wgid % NXCD, off = wgid / NXCD; wgid = (xcd < r ? xcd * (q + 1) : r * (q + 1) + (xcd - r) * q) + off; }
        const int nig = WGM * nN, gid = wgid / nig, fm = gid * WGM, gsz = (nM - fm) < WGM ? (nM - fm) : WGM;
        u.pm = fm + ((wgid % nig) % gsz); u.pn = (wgid % nig) / gsz;
        u.aoff = (OFFK == 1) ? ((u.pn >> 1) & 3) * 512 : 0; u.boff = (OFFK == 2) ? (u.pm >> 1) * 512 : 0;
        return true;
    }
};

__device__ __forceinline__ void so_map(int L, int nM, int nN, Unit& u) {
    const int nwg = nM * nN;
    int wgid = L; { const int q = nwg / NXCD, r = nwg % NXCD, xcd = wgid % NXCD, off = wgid / NXCD; wgid = (xcd < r ? xcd * (q + 1) : r * (q + 1) + (xcd - r) * q) + off; }
    const int nig = WGM * nN, gid = wgid / nig, fm = gid * WGM, gsz = (nM - fm) < WGM ? (nM - fm) : WGM;
    u.pm = fm + ((wgid % nig) % gsz); u.pn = (wgid % nig) / gsz;
}
struct InAOrder {
    int G, b;
    __device__ static void light(int idx, Unit& u) { so_map(idx, 67, 8, u); u.pn = (u.pn < 2) ? u.pn : u.pn + 4; }
    __device__ static void heavy(int idx, Unit& u) { so_map(idx, 67, 4, u); u.pn += 2; }
    __device__ bool next(int i, Unit& u) const {
        u.aoff = 0; u.boff = 0;
        if (G != 256) { const long LL = (long)i * G + b; if (LL >= 804) return false; so_map((int)LL, 67, 12, u); return true; }
        if (i == 0) { if (b < 36) light(b, u); else heavy(b - 36, u); return true; }
        if (i == 1) { if (b < 36) light(36 + b, u); else if (b < 84) heavy(220 + (b - 36), u); else light(72 + (b - 84), u); return true; }
        if (i == 2) { if (b < 36) light(244 + b, u); else light(280 + (b - 36), u); return true; }
        if (i == 3 && b < 36) { light(500 + b, u); return true; }
        return false;
    }
};
struct InCMainOrder {
    int G, b;
    __device__ bool next(int i, Unit& u) const {
        int L;
        if (G == 256) { if (i < 3) L = i * 256 + b; else if (i == 3 && !(b >= 64 && b < 68)) L = 768 + (b < 64 ? b : b - 4); else return false; }
        else { const long LL = (long)i * G + b; if (LL >= 1020) return false; L = (int)LL; }
        if (L < 960) so_map(L, 60, 16, u);
        else if (L < 972) { u.pm = 60; u.pn = L - 960; }
        else { const int j = L - 972; u.pm = 61 + j % 6; u.pn = j / 6; }
        u.aoff = 0; u.boff = 0;
        return true;
    }
};
struct InCTailOrder {
    int G, b;
    __device__ bool next(int i, Unit& u) const {
        const long LL = (long)i * G + (b + 52) % G; if (LL >= 52) return false;
        const int j = (int)LL;
        if (j < 48) { u.pm = 61 + j % 6; u.pn = 8 + j / 6; } else { u.pm = 60; u.pn = 12 + (j - 48); }
        u.aoff = 0; u.boff = 0;
        return true;
    }
};
struct VtOrder {
    int G, b;
    __device__ bool next(int i, Unit& u) const {
        int L;
        if (G == 256) { if (i == 0) L = b; else if (i == 1 && b < 204) L = 256 + b; else if (i == 2 && b >= 48 && b < 124) L = 460 + (b - 48); else return false; }
        else { const long LL = (long)i * G + (b + 48) % G; if (LL >= 536) return false; L = (int)LL; }
        so_map(L, 8, 67, u);
        u.aoff = 0; u.boff = (u.pm >> 1) * 512;
        return true;
    }
};

struct TailOrder {
    int nks, ksl, G, c;
    __device__ void init(int nks_, int ksl_, int G_, int c_) { nks = nks_; ksl = ksl_; G = G_; c = c_; }
    __device__ bool next(int i, Unit& u) const {
        const int L = i * G + c; if (L >= 12 * nks) return false;
        const int ks = L % nks, t = L / nks;
        u.pm = 64 + (t >> 2); u.pn = t & 3; u.aoff = ks * ksl; u.boff = ks * ksl;
        return true;
    }
};

template <class Epi, class Sched>
__device__ __forceinline__ void gemm_phase(LAS unsigned char* lds, const Gemm g, const Sched& S, const Epi& E) {
    const int tid = threadIdx.x, wid = __builtin_amdgcn_readfirstlane(tid >> 6), lane = tid & 63, wr = wid >> 2, wc = wid & 3, fr = lane & 15, fq = lane >> 4;
    const int K = g.K, nt = K / BK;
    unsigned voffA[2], voffB[2];
#pragma unroll
    for (int i = 0; i < 2; ++i) { int R, C; stage_rc(tid * 16 + i * 8192, R, C); const int Rb = Epi::PERM ? ((R & ~31) + perm32(R & 31)) : R;
        voffA[i] = (unsigned)(R * g.lda + C) * 2u; voffB[i] = (unsigned)(Rb * g.ldb + C) * 2u; }
    const size_t kstep = (size_t)(BK * 2);
    const size_t hsA = (size_t)HALF * g.lda * 2, hsB = (size_t)HALF * g.ldb * 2;
    const size_t tsA = 2 * hsA, tsB = 2 * hsB;
    const unsigned ldsw = (unsigned)wid * 1024u;
    const int aoff = lds_byte(wr * 64 + fr, fq * 8), boff = lds_byte(wc * 32 + fr, fq * 8);
#define PG8_SA(b, h) (((b) * 2 + (h)) * HTB)
#define PG8_SB(b, h) ((4 + (b) * 2 + (h)) * HTB)
#define PG8_STAGE(bufoff, gbase, voff) do { _Pragma("unroll") for (int _i = 0; _i < 2; ++_i) \
        __builtin_amdgcn_global_load_lds((const unsigned*)((const char*)(gbase) + (voff)[_i]), (LAS unsigned*)(lds + (bufoff) + ldsw + _i * 8192), 16, 0, 0); } while (0)
#define PG8_LDA(dst, b, h) do { _Pragma("unroll") for (int m = 0; m < 4; ++m) _Pragma("unroll") for (int k = 0; k < 2; ++k) dst[m][k] = *(const LAS bf16x8*)(lds + PG8_SA(b, h) + aoff + m * 2048 + k * 1024); } while (0)
#define PG8_LDB(dst, b, h) do { _Pragma("unroll") for (int n = 0; n < 2; ++n) _Pragma("unroll") for (int k = 0; k < 2; ++k) dst[n][k] = *(const LAS bf16x8*)(lds + PG8_SB(b, h) + boff + n * 2048 + k * 1024); } while (0)
#define PG8_MMA(ai, bj, At, Bt) do { __builtin_amdgcn_s_setprio(1); _Pragma("unroll") for (int m = 0; m < 4; ++m) _Pragma("unroll") for (int n = 0; n < 2; ++n) _Pragma("unroll") for (int k = 0; k < 2; ++k) \
        acc[ai][bj][m][n] = __builtin_amdgcn_mfma_f32_16x16x32_bf16(Bt[n][k], At[m][k], acc[ai][bj][m][n], 0, 0, 0); __builtin_amdgcn_s_setprio(0); } while (0)
#define PG8_WAIT_V(n) asm volatile("s_waitcnt vmcnt(" #n ")" ::: "memory")
#define PG8_WAIT_L(n) asm volatile("s_waitcnt lgkmcnt(" #n ")" ::: "memory")
#define PG8_BAR __builtin_amdgcn_s_barrier()
#define PG8_SCHED __builtin_amdgcn_sched_barrier(0)
    Unit cur, nxt; int ui = 0;
    if (!S.next(0, cur)) return;
    f32x4 acc[2][2][4][2];
#pragma unroll
    for (int a = 0; a < 2; ++a)
#pragma unroll
        for (int b = 0; b < 2; ++b)
#pragma unroll
            for (int m = 0; m < 4; ++m)
#pragma unroll
                for (int n = 0; n < 2; ++n) acc[a][b][m][n] = (f32x4){0.f, 0.f, 0.f, 0.f};
    bf16x8 At[4][2], B0[2][2], B1[2][2];
    const char* cA = (const char*)g.A + (size_t)cur.pm * tsA + (size_t)cur.aoff * 2; const char* cB = (const char*)g.Bt + (size_t)cur.pn * tsB + (size_t)cur.boff * 2;
    PG8_STAGE(PG8_SB(0, 0), cB, voffB); PG8_STAGE(PG8_SA(0, 0), cA, voffA); PG8_STAGE(PG8_SB(0, 1), cB + hsB, voffB); PG8_STAGE(PG8_SA(0, 1), cA + hsA, voffA);
    if (wr == 1) PG8_BAR;
    PG8_WAIT_V(4); PG8_BAR;
    PG8_STAGE(PG8_SB(1, 0), cB + kstep, voffB); PG8_STAGE(PG8_SA(1, 0), cA + kstep, voffA); PG8_STAGE(PG8_SB(1, 1), cB + hsB + kstep, voffB);
    PG8_WAIT_V(6); PG8_BAR;
    for (;;) {
        const bool has_next = S.next(ui + 1, nxt);
        const char* nA = has_next ? (const char*)g.A + (size_t)nxt.pm * tsA + (size_t)nxt.aoff * 2 : cA; const char* nB = has_next ? (const char*)g.Bt + (size_t)nxt.pn * tsB + (size_t)nxt.boff * 2 : cB;
        for (int t = 0; t < nt; t += 2) {
            const bool last = (t == nt - 2);
            const char* a1 = cA + (size_t)(t + 1) * kstep;
            const char* a2 = last ? nA : cA + (size_t)(t + 2) * kstep; const char* b2 = last ? nB : cB + (size_t)(t + 2) * kstep;
            const char* a3 = a2 + kstep; const char* b3 = b2 + kstep;
            PG8_LDB(B0, 0, 0); PG8_SCHED; PG8_LDA(At, 0, 0); PG8_STAGE(PG8_SA(1, 1), a1 + hsA, voffA);
            PG8_WAIT_L(8); PG8_BAR; PG8_WAIT_L(0); PG8_MMA(0, 0, At, B0); PG8_BAR; PG8_SCHED;
            PG8_LDB(B1, 0, 1); PG8_STAGE(PG8_SB(0, 0), b2, voffB);
            PG8_BAR; PG8_WAIT_L(0); PG8_MMA(0, 1, At, B1); PG8_BAR;
            PG8_LDA(At, 0, 1); PG8_STAGE(PG8_SA(0, 0), a2, voffA);
            PG8_BAR; PG8_WAIT_L(0); PG8_MMA(1, 0, At, B0); PG8_BAR; PG8_SCHED;
            PG8_STAGE(PG8_SB(0, 1), b2 + hsB, voffB);
            PG8_WAIT_V(6); PG8_BAR; PG8_MMA(1, 1, At, B1); PG8_BAR;
            PG8_LDB(B0, 1, 0); PG8_SCHED; PG8_LDA(At, 1, 0); PG8_STAGE(PG8_SA(0, 1), a2 + hsA, voffA);
            PG8_WAIT_L(8); PG8_BAR; PG8_WAIT_L(0); PG8_MMA(0, 0, At, B0); PG8_BAR; PG8_SCHED;
            PG8_LDB(B1, 1, 1); PG8_STAGE(PG8_SB(1, 0), b3, voffB);
            PG8_BAR; PG8_WAIT_L(0); PG8_MMA(0, 1, At, B1); PG8_BAR;
            PG8_LDA(At, 1, 1); PG8_STAGE(PG8_SA(1, 0), a3, voffA);
            PG8_BAR; PG8_WAIT_L(0); PG8_MMA(1, 0, At, B0); PG8_BAR; PG8_SCHED;
            PG8_STAGE(PG8_SB(1, 1), b3 + hsB, voffB);
            PG8_WAIT_V(6); PG8_BAR; PG8_MMA(1, 1, At, B1); PG8_BAR;
        }
        E(acc, cur, wr, wc, fr, fq);
        if (!has_next) break;
#pragma unroll
        for (int a = 0; a < 2; ++a)
#pragma unroll
            for (int b = 0; b < 2; ++b)
#pragma unroll
                for (int m = 0; m < 4; ++m)
#pragma unroll
                    for (int n = 0; n < 2; ++n) acc[a][b][m][n] = (f32x4){0.f, 0.f, 0.f, 0.f};
        cur = nxt; cA = nA; cB = nB; ++ui;
    }
    PG8_WAIT_V(0);
    if (wr == 0) PG8_BAR;
    PG8_BAR;
#undef PG8_SA
#undef PG8_SB
#undef PG8_STAGE
#undef PG8_LDA
#undef PG8_LDB
#undef PG8_MMA
#undef PG8_WAIT_V
#undef PG8_WAIT_L
#undef PG8_BAR
#undef PG8_SCHED
}
}

using pg8::Unit;
typedef f32x4 AccT[2][2][4][2];

DI u32x4 pack_row8(const f32x4& v0, const f32x4& v1) { u32x4 w; w.x = pk2(v0[0], v0[1]); w.y = pk2(v0[2], v0[3]); w.z = pk2(v1[0], v1[1]); w.w = pk2(v1[2], v1[3]); return w; }

struct EpiInA {
    static constexpr bool PERM = true;
    bf16_t* proja; float* u32; float* out; bf16_t* vta;
    DI void operator()(const AccT& acc, const Unit& u, int wr, int wc, int fr, int fq) const {
        const int region = u.pn >> 1;
#pragma unroll
        for (int ai = 0; ai < 2; ++ai)
#pragma unroll
            for (int m = 0; m < 4; ++m) {
                const int row = u.pm * 256 + ai * 128 + wr * 64 + m * 16 + fr;
#pragma unroll
                for (int bj = 0; bj < 2; ++bj) {
                    const int col = u.pn * 256 + bj * 128 + wc * 32 + 8 * fq;
                    const f32x4 v0 = acc[ai][bj][m][0], v1 = acc[ai][bj][m][1];
                    *(u32x4*)(proja + (size_t)row * NA + col) = pack_row8(v0, v1);
                    if (region == 1 || region == 2) {
                        const int cc = col - region * 512;
                        float* dst = nullptr;
                        if (row < MP) dst = out + (region == 1 ? O_KP : O_VP) + (size_t)row * WA + cc;
                        else if (row < MT) dst = out + (region == 1 ? O_KS : O_VS) + (size_t)(row - MP) * WA + cc;
                        if (dst) { *(f32x4*)dst = v0; *(f32x4*)(dst + 4) = v1; }
                    }
                }
            }
    }
};

struct EpiPart {
    static constexpr bool PERM = false;
    float* part; int ksl;
    DI void operator()(const AccT& acc, const Unit& u, int wr, int wc, int fr, int fq) const {
        float* base = part + (size_t)(u.aoff / ksl) * 768 * D;
#pragma unroll
        for (int ai = 0; ai < 2; ++ai)
#pragma unroll
            for (int m = 0; m < 4; ++m) {
                const int row = u.pm * 256 + ai * 128 + wr * 64 + m * 16 + fr - MMAIN;
                float* rowp = base + (size_t)row * D + u.pn * 256 + wc * 32 + 4 * fq;
#pragma unroll
                for (int bj = 0; bj < 2; ++bj)
#pragma unroll
                    for (int n = 0; n < 2; ++n) *(f32x4*)(rowp + bj * 128 + n * 16) = acc[ai][bj][m][n];
            }
    }
};
struct EpiResX {
    static constexpr bool PERM = true;
    bf16_t* hb; const float* xp; const float* xs; const float* meta;
    DI void operator()(const AccT& acc, const Unit& u, int wr, int wc, int fr, int fq) const {
#pragma unroll
        for (int ai = 0; ai < 2; ++ai)
#pragma unroll
            for (int m = 0; m < 4; ++m) {
                const int row = u.pm * 256 + ai * 128 + wr * 64 + m * 16 + fr;
                const float* src = nullptr;
                if (row < MP) { const int b = row / LP, t = row - b * LP; src = (t < NMETA) ? meta + (size_t)t * D : xp + ((size_t)b * SEQ + (t - NMETA)) * D; }
                else if (row < MT) src = xs + (size_t)(row - MP) * D;
#pragma unroll
                for (int bj = 0; bj < 2; ++bj) {
                    const int col = u.pn * 256 + bj * 128 + wc * 32 + 8 * fq;
                    f32x4 v0 = acc[ai][bj][m][0], v1 = acc[ai][bj][m][1];
                    if (src) { v0 += *(const f32x4*)(src + col); v1 += *(const f32x4*)(src + col + 4); }
                    *(u32x4*)(hb + (size_t)row * D + col) = pack_row8(v0, v1);
                }
            }
    }
};
struct EpiAddHB {
    static constexpr bool PERM = true;
    bf16_t* hb;
    DI void operator()(const AccT& acc, const Unit& u, int wr, int wc, int fr, int fq) const {
#pragma unroll
        for (int ai = 0; ai < 2; ++ai)
#pragma unroll
            for (int m = 0; m < 4; ++m) {
                const int row = u.pm * 256 + ai * 128 + wr * 64 + m * 16 + fr;
#pragma unroll
                for (int bj = 0; bj < 2; ++bj) {
                    const int col = u.pn * 256 + bj * 128 + wc * 32 + 8 * fq;
                    u32x4* pp = (u32x4*)(hb + (size_t)row * D + col);
                    const u32x4 w = *pp;
                    const f32x4 v0 = acc[ai][bj][m][0] + (f32x4){bflo(w.x), bfhi(w.x), bflo(w.y), bfhi(w.y)};
                    const f32x4 v1 = acc[ai][bj][m][1] + (f32x4){bflo(w.z), bfhi(w.z), bflo(w.w), bfhi(w.w)};
                    *pp = pack_row8(v0, v1);
                }
            }
    }
};

struct EpiInC {
    static constexpr bool PERM = true;
    bf16_t* xmz; float* out;
    DI void operator()(const AccT& acc, const Unit& u, int wr, int wc, int fr, int fq) const {
#pragma unroll
        for (int ai = 0; ai < 2; ++ai)
#pragma unroll
            for (int m = 0; m < 4; ++m) {
                const int row = u.pm * 256 + ai * 128 + wr * 64 + m * 16 + fr;
                float* cdst = nullptr;
                if (u.pn < 8) {
                    if (row < MP) { const int b = row / LP, t = row - b * LP; if (t >= LP - 3) cdst = out + O_CVP + ((size_t)b * 3 + (t - (LP - 3))) * INNER; }
                    else if (row < MT) { const int sb = (row - MP) >> 2, i = (row - MP) & 3; if (i >= 1) cdst = out + O_CVS + ((size_t)sb * 3 + (i - 1)) * INNER; }
                }
#pragma unroll
                for (int bj = 0; bj < 2; ++bj) {
                    const int col = u.pn * 256 + bj * 128 + wc * 32 + 8 * fq;
                    const f32x4 v0 = acc[ai][bj][m][0], v1 = acc[ai][bj][m][1];
                    *(u32x4*)(xmz + (size_t)row * 4096 + col) = pack_row8(v0, v1);
                    if (cdst) { *(f32x4*)(cdst + col) = v0; *(f32x4*)(cdst + col + 4) = v1; }
                }
            }
    }
};

struct EpiQK {
    static constexpr bool PERM = true;
    bf16_t* qc; bf16_t* kc; bf16_t* ktc; bf16_t* qf;
    DI void operator()(const AccT& acc, const Unit& u, int wr, int wc, int fr, int fq) const {
        const bool isk = u.pn >= 8;
        bf16_t* base = isk ? kc : qc;
        const int colt = (u.pn & 7) * 256;
#pragma unroll
        for (int ai = 0; ai < 2; ++ai)
#pragma unroll
            for (int m = 0; m < 4; ++m) {
                const int row = u.pm * 256 + ai * 128 + wr * 64 + m * 16 + fr;
#pragma unroll
                for (int bj = 0; bj < 2; ++bj) {
                    const int col = colt + bj * 128 + wc * 32 + 8 * fq;
                    const u32x4 w = pack_row8(acc[ai][bj][m][0], acc[ai][bj][m][1]);
                    if (!isk && row < MP) {
                        const int b_ = row / LP, tl = row - b_ * LP;
                        const int c_ = (tl < NMETA) ? 0 : 1 + ((tl - NMETA) >> 7), pos = (tl < NMETA) ? tl : ((tl - NMETA) & 127);
                        const int hd = col >> 9, d_ = col & 511;
                        *(u32x4*)(qf + ((size_t)(((b_ * 4 + hd) * NCH + c_) * 8 + (pos >> 4)) * 16 + (d_ >> 5)) * 512 + (((d_ >> 3) & 3) * 16 + (pos & 15)) * 8) = w;
                    } else
                        *(u32x4*)(base + (size_t)row * INNER + col) = w;
                    if (isk && row < MP) {
                        const int b_ = row / LP, tl = row - b_ * LP;
                        const int c_ = (tl < NMETA) ? 0 : 1 + ((tl - NMETA) >> 7), pos = (tl < NMETA) ? tl : ((tl - NMETA) & 127);
                        const int hd = col >> 9, d_ = col & 511;
                        const int i_ = 8 * (pos >> 6) + 4 * ((d_ >> 5) & 1) + ((pos >> 3) & 3);
                        bf16_t* kt = ktc + ((size_t)(((b_ * 4 + hd) * NCH + c_) * 8 + (d_ >> 6)) * 16 + i_) * 512 + (32 * ((pos >> 5) & 1) + (d_ & 31)) * 8 + (pos & 7);
                        asm volatile("" : "+v"(kt));
                        kt[0] = (bf16_t)(w.x & 0xffffu); kt[8] = (bf16_t)(w.x >> 16); kt[16] = (bf16_t)(w.y & 0xffffu); kt[24] = (bf16_t)(w.y >> 16);
                        kt[32] = (bf16_t)(w.z & 0xffffu); kt[40] = (bf16_t)(w.z >> 16); kt[48] = (bf16_t)(w.w & 0xffffu); kt[56] = (bf16_t)(w.w >> 16);
                    }
                }
            }
    }
};

struct EpiPlain {
    static constexpr bool PERM = true;
    bf16_t* o; int ldc;
    DI void operator()(const AccT& acc, const Unit& u, int wr, int wc, int fr, int fq) const {
#pragma unroll
        for (int ai = 0; ai < 2; ++ai)
#pragma unroll
            for (int m = 0; m < 4; ++m) {
                const int row = u.pm * 256 + ai * 128 + wr * 64 + m * 16 + fr;
#pragma unroll
                for (int bj = 0; bj < 2; ++bj) {
                    const int col = u.pn * 256 + bj * 128 + wc * 32 + 8 * fq;
                    *(u32x4*)(o + (size_t)row * ldc + col) = pack_row8(acc[ai][bj][m][0], acc[ai][bj][m][1]);
                }
            }
    }
};

struct EpiVTs {
    static constexpr bool PERM = true;
    bf16_t* o; const float* sa; const float* mtop;
    DI void operator()(const AccT& acc, const Unit& u, int wr, int wc, int fr, int fq) const {
        const int h = u.pm >> 1;
        float w[2][8];
#pragma unroll
        for (int bj = 0; bj < 2; ++bj)
#pragma unroll
            for (int j = 0; j < 8; ++j) {
                const int r = u.pn * 256 + bj * 128 + wc * 32 + 8 * fq + j;
                float wv = 1.f;
                if (r < MP) { const int b = r / LP, t = r - b * LP; const int c = (t < NMETA) ? 0 : 1 + ((t - NMETA) >> 7); wv = __expf(sa[(size_t)r * 4 + h] - mtop[(b * 4 + h) * NCH + c]); }
                w[bj][j] = wv;
            }
#pragma unroll
        for (int ai = 0; ai < 2; ++ai)
#pragma unroll
            for (int m = 0; m < 4; ++m) {
                const int row = u.pm * 256 + ai * 128 + wr * 64 + m * 16 + fr;
#pragma unroll
                for (int bj = 0; bj < 2; ++bj) {
                    const int col = u.pn * 256 + bj * 128 + wc * 32 + 8 * fq;
                    const f32x4 a0 = acc[ai][bj][m][0], a1 = acc[ai][bj][m][1];
                    const f32x4 v0 = (f32x4){a0[0] * w[bj][0], a0[1] * w[bj][1], a0[2] * w[bj][2], a0[3] * w[bj][3]};
                    const f32x4 v1 = (f32x4){a1[0] * w[bj][4], a1[1] * w[bj][5], a1[2] * w[bj][6], a1[3] * w[bj][7]};
                    *(u32x4*)(o + (size_t)row * MPAD + col) = pack_row8(v0, v1);
                }
            }
    }
};

struct Frame {
    unsigned char* lds;
    int tid, lane, wave, G, bid;
};
DI Frame make_frame(unsigned char* lds) {
    Frame F; int t = threadIdx.x; asm volatile("" : "+v"(t));
    F.lds = lds; F.tid = t; F.lane = t & 63; F.wave = __builtin_amdgcn_readfirstlane(t >> 6); F.G = gridDim.x; F.bid = blockIdx.x;
    return F;
}

DI void tr_tile_wave(const float* src, int sld, bf16_t* dst, int dld, int k0, int n0, float scale, float* tile, int lane) {
    f32x4 v[16];
#pragma unroll
    for (int p = 0; p < 16; ++p) v[p] = *(const f32x4*)(src + (size_t)(k0 + p * 4 + (lane >> 4)) * sld + n0 + (lane & 15) * 4);
#pragma unroll
    for (int p = 0; p < 16; ++p) { float* t = tile + (p * 4 + (lane >> 4)) * 65 + (lane & 15) * 4; t[0] = v[p][0]; t[1] = v[p][1]; t[2] = v[p][2]; t[3] = v[p][3]; }
    __builtin_amdgcn_fence(__ATOMIC_RELEASE, "wavefront"); __builtin_amdgcn_wave_barrier(); __builtin_amdgcn_fence(__ATOMIC_ACQUIRE, "wavefront");
#pragma unroll
    for (int kc = 0; kc < 8; ++kc) {
        const float* t = tile + (kc * 8) * 65 + lane;
        u32x4 w;
        w.x = pk2(t[0] * scale, t[65] * scale); w.y = pk2(t[2 * 65] * scale, t[3 * 65] * scale); w.z = pk2(t[4 * 65] * scale, t[5 * 65] * scale); w.w = pk2(t[6 * 65] * scale, t[7 * 65] * scale);
        *(u32x4*)(dst + (size_t)(n0 + lane) * dld + k0 + kc * 8) = w;
    }
    __builtin_amdgcn_fence(__ATOMIC_RELEASE, "wavefront"); __builtin_amdgcn_wave_barrier(); __builtin_amdgcn_fence(__ATOMIC_ACQUIRE, "wavefront");
}

DI void p0_prologue(const Params& p, const Frame& F) {
    unsigned char* ws = p.ws;
    float* tile = (float*)F.lds + F.wave * (64 * 65);
    const float* wq_ = p.in[22]; const float* wk_ = p.in[23]; const float* wv_ = p.in[24];
    asm volatile("" : "+s"(wq_), "+s"(wk_), "+s"(wv_));
    const int gw = F.bid * 8 + F.wave, nw = F.G * 8, lane = F.lane;
    constexpr int T0 = 768, T1 = T0 + 256, T2 = T1 + 1024, T3 = T2 + 768, T4 = T3 + 512, T5 = T4 + 16;
    for (int ti = gw; ti < T5; ti += nw) {
        const float* src; int sld, dld, k0, n0; bf16_t* dst; float scale = 1.f;
        if (ti < T0) { const int j = ti; src = p.in[13]; sld = NA; dst = (bf16_t*)(ws + WS_WTINA); dld = D; k0 = (j / 48) * 64; n0 = (j % 48) * 64; }
        else if (ti < T1) { const int j = ti - T0; src = p.in[14]; sld = D; dst = (bf16_t*)(ws + WS_WTOUTA); dld = D; k0 = (j / 16) * 64; n0 = (j % 16) * 64; }
        else if (ti < T2) { const int j = ti - T1; src = p.in[18]; sld = NC; dst = (bf16_t*)(ws + WS_WTINC); dld = D; k0 = (j / 64) * 64; n0 = (j % 64) * 64; }
        else if (ti < T3) { const int j = ti - T2; const int mat = j / 64, t = j % 64, which = mat / 4, hd = mat % 4;
            src = (which == 0 ? wq_ : which == 1 ? wk_ : wv_) + (size_t)hd * DHC * DHC; sld = DHC;
            dst = (bf16_t*)(ws + (which == 0 ? WS_WTQ : which == 1 ? WS_WTK : WS_WTV)) + (size_t)hd * DHC * DHC; dld = DHC; k0 = (t / 8) * 64; n0 = (t % 8) * 64;
            if (which == 1) scale = 0.044194173824159216f; }
        else if (ti < T4) { const int j = ti - T3; src = p.in[27]; sld = D; dst = (bf16_t*)(ws + WS_WTOUTC); dld = INNER; k0 = (j / 16) * 64; n0 = (j % 16) * 64; }
        else { const int j = ti - T4; const int g = j / 4, t = j % 4; src = p.in[16] + (size_t)g * GC * GC; sld = GC; dst = (bf16_t*)(ws + WS_WTPOOL) + (size_t)g * GC * GC; dld = GC; k0 = (t / 2) * 64; n0 = (t % 2) * 64; }
        tr_tile_wave(src, sld, dst, dld, k0, n0, scale, tile, lane);
    }
    {
        float* wg = (float*)(ws + WS_WG);
        for (int i = F.bid * NTHREADS + F.tid; i < 8 * D; i += F.G * NTHREADS) { const int j = i / D, k = i % D; wg[i] = p.in[18][(size_t)k * NC + 4096 + j]; }
    }
    {
        bf16_t* XN = (bf16_t*)(ws + WS_XN);
        const float* g0 = p.in[11];
        constexpr int RB = 2;
        for (int r0 = gw * RB; r0 < MPAD; r0 += nw * RB) {
            f32x4 v[RB][4];
#pragma unroll
            for (int rr = 0; rr < RB; ++rr) {
                const int r = r0 + rr;
                if (r < MT) {
                    const float* src;
                    if (r < MP) { const int b = r / LP, t = r - b * LP; src = (t < NMETA) ? p.in[10] + (size_t)t * D : p.in[0] + ((size_t)b * SEQ + (t - NMETA)) * D; }
                    else src = p.in[1] + (size_t)(r - MP) * D;
#pragma unroll
                    for (int j = 0; j < 4; ++j) v[rr][j] = *(const f32x4*)(src + j * 256 + lane * 4);
                } else {
#pragma unroll
                    for (int j = 0; j < 4; ++j) v[rr][j] = (f32x4){0.f, 0.f, 0.f, 0.f};
                }
            }
#pragma unroll
            for (int rr = 0; rr < RB; ++rr) {
                const int r = r0 + rr;
                float ss = 0.f;
#pragma unroll
                for (int j = 0; j < 4; ++j) ss += v[rr][j][0] * v[rr][j][0] + v[rr][j][1] * v[rr][j][1] + v[rr][j][2] * v[rr][j][2] + v[rr][j][3] * v[rr][j][3];
                ss = wave_sum(ss);
                const float rstd = rsqrtf(ss * (1.f / D) + EPS);
#pragma unroll
                for (int j = 0; j < 4; ++j) {
                    const int c = j * 256 + lane * 4;
                    const f32x4 g = *(const f32x4*)(g0 + c);
                    u32x2 w; w.x = pk2(v[rr][j][0] * rstd * g[0], v[rr][j][1] * rstd * g[1]); w.y = pk2(v[rr][j][2] * rstd * g[2], v[rr][j][3] * rstd * g[3]);
                    *(u32x2*)(XN + (size_t)r * D + c) = w;
                }
            }
        }
    }
}

DI void attn_prompt_tile(const bf16_t* __restrict__ PA, const bf16_t* __restrict__ VTA, bf16_t* __restrict__ MIX, const float* __restrict__ sb_bias, int bh, int qt, int lane, int tmax) {
    const int b = bh >> 3, h = bh & 7, r31 = lane & 31, hh = lane >> 5;
    const size_t rowbase = (size_t)b * LP;
    const int t0 = qt * 32, tq = t0 + r31;
    bf16x8 qf[4];
#pragma unroll
    for (int i = 0; i < 4; ++i) qf[i] = *(const bf16x8*)(PA + (rowbase + tq) * NA + h * 64 + 16 * i + 8 * hh);
    const float bias = sb_bias[h];
    bf16x8 tm[2];
#pragma unroll
    for (int s = 0; s < 2; ++s)
#pragma unroll
        for (int j = 0; j < 8; ++j) { const int sin = 16 * s + 8 * (j >> 2) + 4 * hh + (j & 3); tm[s][j] = (sin >= r31) ? (short)0x3F80 : (short)0; }
    f32x16 o0 = zero16(), o1 = zero16();
    float R = 0.f;
    const bf16_t* vnat = PA + rowbase * NA + 1024 + h * 64 + r31;
#define VGATH(s_, e_off) ((bf16x4){(short)vnat[(size_t)((s_) + 4 * hh + 0) * NA + (e_off)], (short)vnat[(size_t)((s_) + 4 * hh + 1) * NA + (e_off)], (short)vnat[(size_t)((s_) + 4 * hh + 2) * NA + (e_off)], (short)vnat[(size_t)((s_) + 4 * hh + 3) * NA + (e_off)]})
    const bf16_t* kbase = PA + (rowbase + r31) * NA + 512 + h * 64 + 8 * hh;
    bf16x8 kc[4]; bf16x4 vc[8];
    {
        const int s0 = qt * 32;
        const bf16_t* kp = kbase + (size_t)s0 * NA;
#pragma unroll
        for (int i = 0; i < 4; ++i) kc[i] = *(const bf16x8*)(kp + 16 * i);
#pragma unroll
        for (int i = 0; i < 4; ++i) { vc[i] = VGATH(s0 + 8 * i, 0); vc[4 + i] = VGATH(s0 + 8 * i, 32); }
    }
    const float c1 = 0.125f * 1.4426950408889634f, bias2 = bias * 1.4426950408889634f;
    for (int kb = qt; kb >= 0; --kb) {
        const int s0 = kb * 32;
        bf16x8 kn[4]; bf16x4 vn[8];
        {
            const int sn = (kb > 0 ? kb - 1 : 0) * 32;
            const bf16_t* kp = kbase + (size_t)sn * NA;
#pragma unroll
            for (int i = 0; i < 4; ++i) kn[i] = *(const bf16x8*)(kp + 16 * i);
#pragma unroll
            for (int i = 0; i < 4; ++i) { vn[i] = VGATH(sn + 8 * i, 0); vn[4 + i] = VGATH(sn + 8 * i, 32); }
        }
        f32x16 S = zero16();
#pragma unroll
        for (int i = 0; i < 4; ++i) S = MFMA32(kc[i], qf[i], S);
        f32x16 L, Z;
        const int lim = tq - s0 - 4 * hh;
        if (kb == qt) {
#pragma unroll
            for (int reg = 0; reg < 16; ++reg) {
                const float z2 = fminf(__builtin_fmaf(S[reg], c1, bias2), 100.f);
                const float l2 = -__builtin_amdgcn_logf(1.f + __builtin_amdgcn_exp2f(z2));
                L[reg] = (crow(reg, 0) < lim) ? l2 : 0.f;
                Z[reg] = z2;
            }
        } else {
#pragma unroll
            for (int reg = 0; reg < 16; ++reg) {
                const float z2 = fminf(__builtin_fmaf(S[reg], c1, bias2), 100.f);
                L[reg] = -__builtin_amdgcn_logf(1.f + __builtin_amdgcn_exp2f(z2));
                Z[reg] = z2;
            }
        }
        const bf16x8 lb0 = pack8(L, 0), lb1 = pack8(L, 1);
        f32x16 Y = MFMA32(tm[0], lb0, zero16());
        Y = MFMA32(tm[1], lb1, Y);
        f32x16 Aw;
        if (kb == qt) {
#pragma unroll
            for (int reg = 0; reg < 16; ++reg) { const float a = __builtin_amdgcn_exp2f(Z[reg] + R + Y[reg]); Aw[reg] = (crow(reg, 0) < lim) ? a : 0.f; }
        } else {
#pragma unroll
            for (int reg = 0; reg < 16; ++reg) Aw[reg] = __builtin_amdgcn_exp2f(Z[reg] + R + Y[reg]);
        }
        const bf16x8 ab0 = pack8(Aw, 0), ab1 = pack8(Aw, 1);
        o0 = MFMA32(cat4(vc[0], vc[1]), ab0, o0); o1 = MFMA32(cat4(vc[4], vc[5]), ab0, o1);
        o0 = MFMA32(cat4(vc[2], vc[3]), ab1, o0); o1 = MFMA32(cat4(vc[6], vc[7]), ab1, o1);
        R += __shfl(Y[0], r31);
#pragma unroll
        for (int i = 0; i < 4; ++i) kc[i] = kn[i];
#pragma unroll
        for (int i = 0; i < 8; ++i) vc[i] = vn[i];
    }
    if (tq < tmax) {
        const size_t row = rowbase + tq;
        const bf16_t* gap = PA + row * NA + 1536 + h * 64;
        bf16_t* mp = MIX + row * D + h * 64;
#pragma unroll
        for (int et = 0; et < 2; ++et)
#pragma unroll
            for (int g = 0; g < 4; ++g) {
                const int e0 = 32 * et + 8 * g + 4 * hh;
                const u32x2 gw = *(const u32x2*)(gap + e0);
                const f32x16& o = et ? o1 : o0;
                u32x2 w;
                w.x = pk2(o[4 * g + 0] * silu_f(bflo(gw.x)), o[4 * g + 1] * silu_f(bfhi(gw.x)));
                w.y = pk2(o[4 * g + 2] * silu_f(bflo(gw.y)), o[4 * g + 3] * silu_f(bfhi(gw.y)));
                *(u32x2*)(mp + e0) = w;
            }
    }
}

#undef VGATH
DI void att_block(const unsigned char* kb_, int j, int it, int r31, int hh, const bf16x8 (&qf)[4], const bf16x8 (&tm)[2], float c1, float bias2, f32x16& o0, f32x16& o1, float& R) {
    constexpr int KROW = 144, VROW = 72, KBYTES = 32 * KROW;
    const unsigned char* vb_ = kb_ + KBYTES;
    f32x16 S = zero16();
#pragma unroll
    for (int i = 0; i < 4; ++i) { const bf16x8 kf = *(const bf16x8*)(kb_ + r31 * KROW + 32 * i + 16 * hh); S = MFMA32(kf, qf[i], S); }
    bf16x4 vc[8];
#pragma unroll
    for (int i = 0; i < 4; ++i) { vc[i] = *(const bf16x4*)(vb_ + r31 * VROW + 8 * hh + 16 * i); vc[4 + i] = *(const bf16x4*)(vb_ + (32 + r31) * VROW + 8 * hh + 16 * i); }
    f32x16 L, Z;
    const bool diag = (j == it + 1), first = (j == 0);
    if (diag || first) {
#pragma unroll
        for (int reg = 0; reg < 16; ++reg) {
            const float z2 = fminf(__builtin_fmaf(S[reg], c1, bias2), 100.f);
            const float l2 = -__builtin_amdgcn_logf(1.f + __builtin_amdgcn_exp2f(z2));
            const int cr = crow(reg, 0) + 4 * hh;
            const bool valid = diag ? (cr < r31) : (cr >= 16);
            L[reg] = valid ? l2 : 0.f;
            Z[reg] = z2;
        }
    } else {
#pragma unroll
        for (int reg = 0; reg < 16; ++reg) {
            const float z2 = fminf(__builtin_fmaf(S[reg], c1, bias2), 100.f);
            L[reg] = -__builtin_amdgcn_logf(1.f + __builtin_amdgcn_exp2f(z2));
            Z[reg] = z2;
        }
    }
    const bf16x8 lb0 = pack8(L, 0), lb1 = pack8(L, 1);
    f32x16 Y = MFMA32(tm[0], lb0, zero16());
    Y = MFMA32(tm[1], lb1, Y);
    f32x16 Aw;
    if (diag || first) {
#pragma unroll
        for (int reg = 0; reg < 16; ++reg) {
            const float a = __builtin_amdgcn_exp2f(Z[reg] + R + Y[reg]);
            const int cr = crow(reg, 0) + 4 * hh;
            const bool valid = diag ? (cr < r31) : (cr >= 16);
            Aw[reg] = valid ? a : 0.f;
        }
    } else {
#pragma unroll
        for (int reg = 0; reg < 16; ++reg) Aw[reg] = __builtin_amdgcn_exp2f(Z[reg] + R + Y[reg]);
    }
    const bf16x8 ab0 = pack8(Aw, 0), ab1 = pack8(Aw, 1);
    o0 = MFMA32(cat4(vc[0], vc[1]), ab0, o0); o1 = MFMA32(cat4(vc[4], vc[5]), ab0, o1);
    o0 = MFMA32(cat4(vc[2], vc[3]), ab1, o0); o1 = MFMA32(cat4(vc[6], vc[7]), ab1, o1);
    R += __shfl(Y[0], r31);
}

DI void attn_prompt_unit(const bf16_t* __restrict__ PA, bf16_t* __restrict__ MIX, const float* __restrict__ sb_bias, unsigned char* lds, int bh, int g, int tid, int wave, int lane) {
    constexpr int KROW = 144, VROW = 72, KBYTES = 32 * KROW  , BUF = KBYTES + 64 * VROW  ;
    const int b = bh >> 3, h = bh & 7, r31 = lane & 31, hh = lane >> 5;
    const size_t rowbase = (size_t)b * LP;
    const int it = 8 * g + wave;
    const int tq = 16 + 32 * it + r31;
    bf16x8 qf[4];
#pragma unroll
    for (int i = 0; i < 4; ++i) qf[i] = *(const bf16x8*)(PA + (rowbase + tq) * NA + h * 64 + 16 * i + 8 * hh);
    const float bias = sb_bias[h];
    bf16x8 tm[2];
#pragma unroll
    for (int s = 0; s < 2; ++s)
#pragma unroll
        for (int j = 0; j < 8; ++j) { const int sin = 16 * s + 8 * (j >> 2) + 4 * hh + (j & 3); tm[s][j] = (sin >= r31) ? (short)0x3F80 : (short)0; }
    f32x16 o0 = zero16(), o1 = zero16();
    float R = 0.f;
    const float c1 = 0.125f * 1.4426950408889634f, bias2 = bias * 1.4426950408889634f;
    const bool isk = tid < 256;
    const int sr = (tid & 255) >> 3, sc = tid & 7;
    const int scol = (isk ? 512 : 1024) + h * 64 + 8 * sc;
#define ATT_STAGE_LOAD(j_) (*(const u32x4*)(PA + (rowbase + ((32 * (j_) - 16 + sr) > 0 ? (32 * (j_) - 16 + sr) : 0)) * NA + scol))
#define ATT_STAGE_WRITE(base_, stg_) do { if (isk) *(u32x4*)((base_) + sr * KROW + 16 * sc) = stg_; \
        else { bf16_t* vt_ = (bf16_t*)((base_) + KBYTES + (8 * sc) * VROW + 2 * sr); \
            vt_[0 * (VROW / 2)] = (bf16_t)(stg_.x & 0xffffu); vt_[1 * (VROW / 2)] = (bf16_t)(stg_.x >> 16); vt_[2 * (VROW / 2)] = (bf16_t)(stg_.y & 0xffffu); vt_[3 * (VROW / 2)] = (bf16_t)(stg_.y >> 16); \
            vt_[4 * (VROW / 2)] = (bf16_t)(stg_.z & 0xffffu); vt_[5 * (VROW / 2)] = (bf16_t)(stg_.z >> 16); vt_[6 * (VROW / 2)] = (bf16_t)(stg_.w & 0xffffu); vt_[7 * (VROW / 2)] = (bf16_t)(stg_.w >> 16); } } while (0)
    const int jmax = 8 * g + 8;
    u32x4 stgA = ATT_STAGE_LOAD(jmax), stgB = ATT_STAGE_LOAD(jmax - 1);
    ATT_STAGE_WRITE(lds, stgA); ATT_STAGE_WRITE(lds + BUF, stgB);
    __syncthreads();
    int cur = 0;
    for (int jp = jmax; jp >= 0; jp -= 2) {
        const int na = jp - 2, nb2 = jp - 3;
        if (na >= 0) { stgA = ATT_STAGE_LOAD(na); stgB = ATT_STAGE_LOAD(nb2 >= 0 ? nb2 : 0); }
        const unsigned char* cb = lds + cur * 2 * BUF;
        if (jp <= it + 1) att_block(cb, jp, it, r31, hh, qf, tm, c1, bias2, o0, o1, R);
        if (jp >= 1 && jp - 1 <= it + 1) att_block(cb + BUF, jp - 1, it, r31, hh, qf, tm, c1, bias2, o0, o1, R);
        if (na >= 0) { unsigned char* nb = lds + (cur ^ 1) * 2 * BUF; ATT_STAGE_WRITE(nb, stgA); ATT_STAGE_WRITE(nb + BUF, stgB); }
        __syncthreads();
        cur ^= 1;
    }
    {
        const size_t row = rowbase + tq;
        const bf16_t* gap = PA + row * NA + 1536 + h * 64;
        bf16_t* mp = MIX + row * D + h * 64;
#pragma unroll
        for (int et = 0; et < 2; ++et)
#pragma unroll
            for (int gq = 0; gq < 4; ++gq) {
                const int e0 = 32 * et + 8 * gq + 4 * hh;
                const u32x2 gw = *(const u32x2*)(gap + e0);
                const f32x16& o = et ? o1 : o0;
                u32x2 w;
                w.x = pk2(o[4 * gq + 0] * silu_f(bflo(gw.x)), o[4 * gq + 1] * silu_f(bfhi(gw.x)));
                w.y = pk2(o[4 * gq + 2] * silu_f(bflo(gw.y)), o[4 * gq + 3] * silu_f(bfhi(gw.y)));
                *(u32x2*)(mp + e0) = w;
            }
    }
}
#undef ATT_STAGE_LOAD
#undef ATT_STAGE_WRITE
DI void p2_attn_prompt(const Params& p, const Frame& F) {
    const bf16_t* PA = (const bf16_t*)(p.ws + WS_PROJA); const bf16_t* VTA = (const bf16_t*)(p.ws + WS_VTA); bf16_t* MIX = (bf16_t*)(p.ws + WS_MIXED);
    const float* bias = p.in[15];
    {
        const int gw = F.bid * 8 + F.wave, nw = F.G * 8;
        for (int task = gw; task < 64; task += nw) attn_prompt_tile(PA, VTA, MIX, bias, task, 0, F.lane, NMETA);
    }
    for (int u = F.bid; u < 256; u += F.G) {
        const int bh = (u & 7) * 8 + ((u >> 3) & 7), g = u >> 6;
        attn_prompt_unit(PA, MIX, bias, F.lds, bh, g, F.tid, F.wave, F.lane);
        attn_prompt_unit(PA, MIX, bias, F.lds, bh, 7 - g, F.tid, F.wave, F.lane);
    }
}

DI void p2_attn_sample(const Params& p, const Frame& F) {
    const bf16_t* PA = (const bf16_t*)(p.ws + WS_PROJA);
    float* SPART = (float*)(p.ws + WS_SPART); float* ST = (float*)(p.ws + WS_ST);
    const float* cache_k = p.in[2]; const float* cache_v = p.in[3]; const int* ptab = (const int*)p.in[4];
    const float* sbb = p.in[15];
    float* zl = (float*)F.lds;
    float* red = (float*)(F.lds + 16384);
    float* res = (float*)(F.lds + 86016);
    float* pw = red + F.wave * 2176;
    const int tid = F.tid, lane = F.lane, wave = F.wave;
    const int hh = (tid >> 4) & 7, dch = tid & 15, sg = tid >> 7;
    f32x4 b0[8], b1[8], b2[8], b3[8];
#define SA_LOAD(buf, base, bt) do { _Pragma("unroll") for (int u_ = 0; u_ < 8; ++u_) buf[u_] = __builtin_nontemporal_load((const f32x4*)((base) + (size_t)((bt) * 8 + u_) * 2048 + tid * 4)); } while (0)
#define SA_QK(buf, bt) do { _Pragma("unroll") for (int u_ = 0; u_ < 8; ++u_) { \
        f32x4 pq_; \
        pq_[0] = buf[u_][0] * qr[0][0] + buf[u_][1] * qr[0][1] + buf[u_][2] * qr[0][2] + buf[u_][3] * qr[0][3]; \
        pq_[1] = buf[u_][0] * qr[1][0] + buf[u_][1] * qr[1][1] + buf[u_][2] * qr[1][2] + buf[u_][3] * qr[1][3]; \
        pq_[2] = buf[u_][0] * qr[2][0] + buf[u_][1] * qr[2][1] + buf[u_][2] * qr[2][2] + buf[u_][3] * qr[2][3]; \
        pq_[3] = buf[u_][0] * qr[3][0] + buf[u_][1] * qr[3][1] + buf[u_][2] * qr[3][2] + buf[u_][3] * qr[3][3]; \
        *(f32x4*)(pw + (u_ * 4 + (lane >> 4)) * 68 + (lane & 15) * 4) = pq_; } \
        __builtin_amdgcn_fence(__ATOMIC_RELEASE, "wavefront"); __builtin_amdgcn_wave_barrier(); __builtin_amdgcn_fence(__ATOMIC_ACQUIRE, "wavefront"); \
        { const int u2_ = lane >> 3, r_ = (lane >> 1) & 3, ip_ = lane & 1; const float* src_ = pw + (u2_ * 4 + r_) * 68 + 2 * ip_; \
          f32x2 za_ = *(const f32x2*)src_; \
          _Pragma("unroll") for (int j_ = 1; j_ < 16; ++j_) za_ += *(const f32x2*)(src_ + 4 * j_); \
          const int row_ = wave * 4 + r_; \
          *(f32x2*)(zl + ((row_ & 7) * 128 + ((bt) * 8 + u2_) * 4 + (row_ >> 3)) * 4 + 2 * ip_) = za_; } \
        __builtin_amdgcn_fence(__ATOMIC_RELEASE, "wavefront"); __builtin_amdgcn_wave_barrier(); __builtin_amdgcn_fence(__ATOMIC_ACQUIRE, "wavefront"); } while (0)
#define SA_PV(buf, bt) do { _Pragma("unroll") for (int u_ = 0; u_ < 8; ++u_) { const int s_ = ((bt) * 8 + u_) * 4 + sg; const f32x4 a_ = *(const f32x4*)(zl + (hh * 128 + s_) * 4); \
        _Pragma("unroll") for (int i_ = 0; i_ < 4; ++i_) oa[i_] += buf[u_] * a_[i_]; } } while (0)
    int item = F.bid, cnt = 0, first_item = F.bid;
    const float* Kp = nullptr; const float* Vp = nullptr;
    if (item < BS * NPAGES) { const int phys = ptab[item]; Kp = cache_k + (size_t)phys * PAGE * WA; Vp = cache_v + (size_t)phys * PAGE * WA; SA_LOAD(b0, Kp, 0); SA_LOAD(b1, Kp, 1); SA_LOAD(b2, Kp, 2); }
    for (; item < BS * NPAGES; item += F.G) {
        const int sb = item >> 4;
        const int nitem = item + F.G;
        const float* Kn = Kp; const float* Vn = Vp;
        if (nitem < BS * NPAGES) { const int phys = ptab[nitem]; Kn = cache_k + (size_t)phys * PAGE * WA; Vn = cache_v + (size_t)phys * PAGE * WA; }
        f32x4 qr[4];
#pragma unroll
        for (int i = 0; i < 4; ++i) {
            const u32x2 w = *(const u32x2*)(PA + (size_t)(MP + sb * 4 + i) * NA + hh * 64 + dch * 4);
            qr[i] = (f32x4){bflo(w.x) * 0.125f, bfhi(w.x) * 0.125f, bflo(w.y) * 0.125f, bfhi(w.y) * 0.125f};
        }
        SA_LOAD(b3, Kp, 3); SA_QK(b0, 0);
        SA_LOAD(b0, Vp, 0); SA_QK(b1, 1);
        SA_LOAD(b1, Vp, 1); SA_QK(b2, 2);
        SA_LOAD(b2, Vp, 2); SA_QK(b3, 3);
        __syncthreads();
        {
            const int row = tid >> 4, seg = tid & 15, h = row >> 2, i = row & 3;
            const float bias = sbb[h];
            float zz[8], suf[8];
            float run = 0.f;
#pragma unroll
            for (int k = 7; k >= 0; --k) { zz[k] = zl[(h * 128 + seg * 8 + k) * 4 + i] + bias; run += -softplus_f(zz[k]); suf[k] = run; }
            float inc = run;
            inc += dpp_shl_zero<0x101>(inc); inc += dpp_shl_zero<0x102>(inc); inc += dpp_shl_zero<0x104>(inc); inc += dpp_shl_zero<0x108>(inc);
            const float off = inc - run;
#pragma unroll
            for (int k = 0; k < 8; ++k) zl[(h * 128 + seg * 8 + k) * 4 + i] = __expf(zz[k] + suf[k] + off);
            if (seg == 0) res[cnt * 2080 + 2048 + row] = inc;
        }
        __syncthreads();
        f32x4 oa[4];
#pragma unroll
        for (int i = 0; i < 4; ++i) oa[i] = (f32x4){0.f, 0.f, 0.f, 0.f};
        SA_LOAD(b3, Vp, 3); SA_PV(b0, 0);
        SA_LOAD(b0, Kn, 0); SA_PV(b1, 1);
        SA_LOAD(b1, Kn, 1); SA_PV(b2, 2);
        SA_LOAD(b2, Kn, 2); SA_PV(b3, 3);
#pragma unroll
        for (int i = 0; i < 4; ++i) *(f32x4*)(red + ((sg * 8 + hh) * 4 + i) * 64 + dch * 4) = oa[i];
        __syncthreads();
        {
            const f32x4 r0 = *(const f32x4*)(red + tid * 4), r1 = *(const f32x4*)(red + 2048 + tid * 4), r2 = *(const f32x4*)(red + 4096 + tid * 4), r3 = *(const f32x4*)(red + 6144 + tid * 4);
            *(f32x4*)(res + cnt * 2080 + tid * 4) = (r0 + r1) + (r2 + r3);
        }
        ++cnt;
        __syncthreads();
        if (cnt == 4 || nitem >= BS * NPAGES) {
            for (int k = 0; k < cnt; ++k) {
                const size_t it = (size_t)first_item + (size_t)k * F.G;
                *(f32x4*)(SPART + it * 2048 + tid * 4) = *(const f32x4*)(res + k * 2080 + tid * 4);
                if (tid < 32) ST[it * 32 + tid] = res[k * 2080 + 2048 + tid];
            }
            first_item = nitem; cnt = 0;
            __syncthreads();
        }
        Kp = Kn; Vp = Vn;
    }
#undef SA_LOAD
#undef SA_QK
#undef SA_PV
}

DI void p2_pool(const Params& p, const Frame& F) {
    const bf16_t* PA = (const bf16_t*)(p.ws + WS_PROJA); bf16_t* MIX = (bf16_t*)(p.ws + WS_MIXED);
    const bf16_t* WTP = (const bf16_t*)(p.ws + WS_WTPOOL);
    const float* spool = p.in[5]; const float* scale = p.in[17];
    bf16_t* dl = (bf16_t*)F.lds;
    bf16_t* wl = (bf16_t*)(F.lds + 17408);
    const int tid = F.tid, lane = F.lane, r31 = lane & 31, hh = lane >> 5;
    constexpr int NT = MT / 64;
    for (int unit = F.bid; unit < NT * NG; unit += F.G) {
        const int g = unit & 3, tile = unit >> 2;
        const int w = 2 << g;
        for (int i = tid; i < 128 * 16; i += NTHREADS) { const int e = i >> 4, c8 = (i & 15) * 8; *(u32x4*)(wl + e * 136 + c8) = *(const u32x4*)(WTP + ((size_t)g * GC + e) * GC + c8); }
        {
            const int tl = tid >> 3, cc = (tid & 7) * 16;
            const int r = tile * 64 + tl;
            const int col = g * GC + cc;
            float sum[16];
#pragma unroll
            for (int k = 0; k < 16; ++k) sum[k] = 0.f;
            float cnt;
            const bf16_t* ur = PA + (size_t)r * NA + 2048 + col;
            const u32x4 ua = *(const u32x4*)ur, ub = *(const u32x4*)(ur + 8);
            const float u0[16] = {bflo(ua.x), bfhi(ua.x), bflo(ua.y), bfhi(ua.y), bflo(ua.z), bfhi(ua.z), bflo(ua.w), bfhi(ua.w), bflo(ub.x), bfhi(ub.x), bflo(ub.y), bfhi(ub.y), bflo(ub.z), bfhi(ub.z), bflo(ub.w), bfhi(ub.w)};
#define POOL_ADD_BF(src_) do { const u32x4 a_ = *(const u32x4*)(src_), b_ = *(const u32x4*)((src_) + 8); \
                sum[0] += bflo(a_.x); sum[1] += bfhi(a_.x); sum[2] += bflo(a_.y); sum[3] += bfhi(a_.y); sum[4] += bflo(a_.z); sum[5] += bfhi(a_.z); sum[6] += bflo(a_.w); sum[7] += bfhi(a_.w); \
                sum[8] += bflo(b_.x); sum[9] += bfhi(b_.x); sum[10] += bflo(b_.y); sum[11] += bfhi(b_.y); sum[12] += bflo(b_.z); sum[13] += bfhi(b_.z); sum[14] += bflo(b_.w); sum[15] += bfhi(b_.w); } while (0)
#define POOL_WINDOW(W) do { \
                if (r < MP) { const int t = r % LP; cnt = (float)((W) < t + 1 ? (W) : t + 1); \
                    _Pragma("unroll") for (int j = 0; j < (W); ++j) { if (j <= t) { const bf16_t* src = ur - (size_t)j * NA; POOL_ADD_BF(src); } } } \
                else { const int sb = (r - MP) >> 2, i = (r - MP) & 3; cnt = (float)(W); \
                    _Pragma("unroll") for (int j = 0; j < (W); ++j) { \
                        if (j <= i) { const bf16_t* src = ur - (size_t)j * NA; POOL_ADD_BF(src); } \
                        else { const float* src = spool + ((size_t)sb * 15 + (15 + i - j)) * WB + col; \
                            _Pragma("unroll") for (int q = 0; q < 4; ++q) { const f32x4 v = *(const f32x4*)(src + 4 * q); sum[4 * q] += v[0]; sum[4 * q + 1] += v[1]; sum[4 * q + 2] += v[2]; sum[4 * q + 3] += v[3]; } } } } } while (0)
            if (g == 0) POOL_WINDOW(2); else if (g == 1) POOL_WINDOW(4); else if (g == 2) POOL_WINDOW(8); else POOL_WINDOW(16);
#undef POOL_WINDOW
#undef POOL_ADD_BF
            const float inv = 1.f / cnt;
            u32x4 w0, w1;
            w0.x = pk2(sum[0] * inv - u0[0], sum[1] * inv - u0[1]); w0.y = pk2(sum[2] * inv - u0[2], sum[3] * inv - u0[3]);
            w0.z = pk2(sum[4] * inv - u0[4], sum[5] * inv - u0[5]); w0.w = pk2(sum[6] * inv - u0[6], sum[7] * inv - u0[7]);
            w1.x = pk2(sum[8] * inv - u0[8], sum[9] * inv - u0[9]); w1.y = pk2(sum[10] * inv - u0[10], sum[11] * inv - u0[11]);
            w1.z = pk2(sum[12] * inv - u0[12], sum[13] * inv - u0[13]); w1.w = pk2(sum[14] * inv - u0[14], sum[15] * inv - u0[15]);
            *(u32x4*)(dl + tl * 136 + cc) = w0; *(u32x4*)(dl + tl * 136 + cc + 8) = w1;
        }
        __syncthreads();
        {
            const int tt = F.wave >> 2, et = F.wave & 3;
            f32x16 acc = zero16();
#pragma unroll
            for (int ks = 0; ks < 8; ++ks) {
                const bf16x8 a = *(const bf16x8*)(wl + (32 * et + r31) * 136 + 16 * ks + 8 * hh);
                const bf16x8 bq = *(const bf16x8*)(dl + (32 * tt + r31) * 136 + 16 * ks + 8 * hh);
                acc = MFMA32(a, bq, acc);
            }
            const int r = tile * 64 + 32 * tt + r31;
#pragma unroll
            for (int gq = 0; gq < 4; ++gq) {
                const int e = g * GC + 32 * et + 8 * gq + 4 * hh;
                const f32x4 sc = *(const f32x4*)(scale + e);
                const u32x2 gw = *(const u32x2*)(PA + (size_t)r * NA + 2560 + e);
                u32x2 w2;
                w2.x = pk2(acc[4 * gq + 0] * sc[0] * silu_f(bflo(gw.x)), acc[4 * gq + 1] * sc[1] * silu_f(bfhi(gw.x)));
                w2.y = pk2(acc[4 * gq + 2] * sc[2] * silu_f(bflo(gw.y)), acc[4 * gq + 3] * sc[3] * silu_f(bfhi(gw.y)));
                *(u32x2*)(MIX + (size_t)r * D + 512 + e) = w2;
            }
        }
        __syncthreads();
    }
    {
        float* outp = p.out + O_POOLP; float* outs = p.out + O_POOLS;
        const int gt = F.bid * NTHREADS + tid, nt = F.G * NTHREADS;
        for (int i = gt; i < BP * 15 * (WB / 4); i += nt) { const int c4 = i % (WB / 4), j = (i / (WB / 4)) % 15, b = i / (15 * (WB / 4));
            const u32x2 w = *(const u32x2*)(PA + ((size_t)b * LP + (LP - 15) + j) * NA + 2048 + c4 * 4);
            *(f32x4*)(outp + ((size_t)b * 15 + j) * WB + c4 * 4) = (f32x4){bflo(w.x), bfhi(w.x), bflo(w.y), bfhi(w.y)}; }
        for (int i = gt; i < BS * 15 * (WB / 4); i += nt) { const int c4 = i % (WB / 4), j = (i / (WB / 4)) % 15, sb = i / (15 * (WB / 4));
            f32x4 v;
            if (j < 11) v = *(const f32x4*)(spool + ((size_t)sb * 15 + j + 4) * WB + c4 * 4);
            else { const u32x2 w = *(const u32x2*)(PA + ((size_t)(MP + sb * 4 + (j - 11))) * NA + 2048 + c4 * 4); v = (f32x4){bflo(w.x), bfhi(w.x), bflo(w.y), bfhi(w.y)}; }
            *(f32x4*)(outs + ((size_t)sb * 15 + j) * WB + c4 * 4) = v; }
    }
}

DI void p2d_combine(const Params& p, const Frame& F) {
    const bf16_t* PA = (const bf16_t*)(p.ws + WS_PROJA); bf16_t* MIX = (bf16_t*)(p.ws + WS_MIXED);
    const float* SPART = (const float*)(p.ws + WS_SPART); const float* ST = (const float*)(p.ws + WS_ST);
    const float* sbb = p.in[15];
    const int gt = F.bid * NTHREADS + F.tid, nt = F.G * NTHREADS;
    for (int idx = gt; idx < BS * HA * TS * 16; idx += nt) {
        const int e4 = idx & 15, i = (idx >> 4) & 3, h = (idx >> 6) & 7, sb = idx >> 9;
        const size_t rq = (size_t)(MP + sb * 4 + i);
        const float bias = sbb[h];
        f32x4 o = (f32x4){0.f, 0.f, 0.f, 0.f};
        float R = 0.f;
        for (int ip = i - 1; ip >= 0; --ip) {
            const size_t rk = (size_t)(MP + sb * 4 + ip);
            float dot = 0.f;
            for (int d = 0; d < 64; d += 8) {
                const u32x4 qa = *(const u32x4*)(PA + rq * NA + h * 64 + d), ka = *(const u32x4*)(PA + rk * NA + 512 + h * 64 + d);
                dot += bflo(qa.x) * bflo(ka.x) + bfhi(qa.x) * bfhi(ka.x) + bflo(qa.y) * bflo(ka.y) + bfhi(qa.y) * bfhi(ka.y)
                     + bflo(qa.z) * bflo(ka.z) + bfhi(qa.z) * bfhi(ka.z) + bflo(qa.w) * bflo(ka.w) + bfhi(qa.w) * bfhi(ka.w);
            }
            const float z = dot * 0.125f + bias;
            const float ln = -softplus_f(z);
            const float a = __expf(z + R + ln);
            const u32x2 vw = *(const u32x2*)(PA + rk * NA + 1024 + h * 64 + e4 * 4);
            o[0] += a * bflo(vw.x); o[1] += a * bfhi(vw.x); o[2] += a * bflo(vw.y); o[3] += a * bfhi(vw.y);
            R += ln;
        }
        for (int pg = NPAGES - 1; pg >= 0; --pg) {
            const size_t it = (size_t)sb * NPAGES + pg;
            const f32x4 po = *(const f32x4*)(SPART + it * 2048 + (h * 4 + i) * 64 + e4 * 4);
            const float w = __expf(R);
            o += po * w;
            R += ST[it * 32 + h * 4 + i];
        }
        const u32x2 gw = *(const u32x2*)(PA + rq * NA + 1536 + h * 64 + e4 * 4);
        u32x2 w;
        w.x = pk2(o[0] * silu_f(bflo(gw.x)), o[1] * silu_f(bfhi(gw.x)));
        w.y = pk2(o[2] * silu_f(bflo(gw.y)), o[3] * silu_f(bfhi(gw.y)));
        *(u32x2*)(MIX + rq * D + h * 64 + e4 * 4) = w;
    }
}

DI void p3b_norm_gates(const Params& p, const Frame& F) {
    const bf16_t* HB = (const bf16_t*)(p.ws + WS_H); bf16_t* HBw = (bf16_t*)(p.ws + WS_H); bf16_t* XN = (bf16_t*)(p.ws + WS_XN);
    const float* PART = (const float*)(p.ws + WS_PART);
    const float* WG = (const float*)(p.ws + WS_WG);
    float* LOGI = (float*)(p.ws + WS_LOGI); float* LOGF = (float*)(p.ws + WS_LOGF);
    const float* g1 = p.in[11] + D; const float* bg = p.in[19];
    const int gw = F.bid * 8 + F.wave, nw = F.G * 8, lane = F.lane;
    constexpr int RB = 2;
    for (int r0 = gw * RB; r0 < MT; r0 += nw * RB) {
        float v[RB][2][8]; float rstd[RB];
        if (r0 < MMAIN) {
            u32x4 hw[RB][2];
#pragma unroll
            for (int rr = 0; rr < RB; ++rr)
#pragma unroll
                for (int j = 0; j < 2; ++j) hw[rr][j] = *(const u32x4*)(HB + (size_t)(r0 + rr) * D + j * 512 + lane * 8);
#pragma unroll
            for (int rr = 0; rr < RB; ++rr)
#pragma unroll
                for (int j = 0; j < 2; ++j) {
                    const u32x4 w = hw[rr][j];
                    v[rr][j][0] = bflo(w.x); v[rr][j][1] = bfhi(w.x); v[rr][j][2] = bflo(w.y); v[rr][j][3] = bfhi(w.y); v[rr][j][4] = bflo(w.z); v[rr][j][5] = bfhi(w.z); v[rr][j][6] = bflo(w.w); v[rr][j][7] = bfhi(w.w);
                }
        } else {
#pragma unroll
            for (int rr = 0; rr < RB; ++rr) {
                const int r = r0 + rr;
                const float* src;
                if (r < MP) { const int b = r / LP, t = r - b * LP; src = (t < NMETA) ? p.in[10] + (size_t)t * D : p.in[0] + ((size_t)b * SEQ + (t - NMETA)) * D; }
                else src = p.in[1] + (size_t)(r - MP) * D;
#pragma unroll
                for (int j = 0; j < 2; ++j) {
                    const int c = j * 512 + lane * 8;
                    f32x4 a0 = *(const f32x4*)(src + c), a1 = *(const f32x4*)(src + c + 4);
#pragma unroll
                    for (int ks = 0; ks < 4; ++ks) { const float* pp = PART + ((size_t)ks * 768 + (r - MMAIN)) * D + c; a0 += *(const f32x4*)pp; a1 += *(const f32x4*)(pp + 4); }
                    v[rr][j][0] = a0[0]; v[rr][j][1] = a0[1]; v[rr][j][2] = a0[2]; v[rr][j][3] = a0[3]; v[rr][j][4] = a1[0]; v[rr][j][5] = a1[1]; v[rr][j][6] = a1[2]; v[rr][j][7] = a1[3];
                    *(u32x4*)(HBw + (size_t)r * D + c) = pack_row8(a0, a1);
                }
            }
        }
#pragma unroll
        for (int rr = 0; rr < RB; ++rr) {
            float ss = 0.f;
#pragma unroll
            for (int j = 0; j < 2; ++j)
#pragma unroll
                for (int k = 0; k < 8; ++k) ss += v[rr][j][k] * v[rr][j][k];
            rstd[rr] = rsqrtf(wave_sum(ss) * (1.f / D) + EPS);
        }
        float gsum[RB][8];
#pragma unroll
        for (int rr = 0; rr < RB; ++rr)
#pragma unroll
            for (int q = 0; q < 8; ++q) gsum[rr][q] = 0.f;
#pragma unroll
        for (int j = 0; j < 2; ++j) {
            const int c = j * 512 + lane * 8;
            const f32x4 ga = *(const f32x4*)(g1 + c), gb = *(const f32x4*)(g1 + c + 4);
            const float g[8] = {ga[0], ga[1], ga[2], ga[3], gb[0], gb[1], gb[2], gb[3]};
            float xn[RB][8];
#pragma unroll
            for (int rr = 0; rr < RB; ++rr) {
#pragma unroll
                for (int k = 0; k < 8; ++k) xn[rr][k] = v[rr][j][k] * rstd[rr] * g[k];
                u32x4 w; w.x = pk2(xn[rr][0], xn[rr][1]); w.y = pk2(xn[rr][2], xn[rr][3]); w.z = pk2(xn[rr][4], xn[rr][5]); w.w = pk2(xn[rr][6], xn[rr][7]);
                *(u32x4*)(XN + (size_t)(r0 + rr) * D + c) = w;
            }
#pragma unroll
            for (int q = 0; q < 8; ++q) {
                const f32x4 wa = *(const f32x4*)(WG + q * D + c), wb = *(const f32x4*)(WG + q * D + c + 4);
#pragma unroll
                for (int rr = 0; rr < RB; ++rr)
                    gsum[rr][q] += xn[rr][0] * wa[0] + xn[rr][1] * wa[1] + xn[rr][2] * wa[2] + xn[rr][3] * wa[3] + xn[rr][4] * wb[0] + xn[rr][5] * wb[1] + xn[rr][6] * wb[2] + xn[rr][7] * wb[3];
            }
        }
#pragma unroll
        for (int rr = 0; rr < RB; ++rr) {
#pragma unroll
            for (int q = 0; q < 8; ++q) gsum[rr][q] = wave_sum(gsum[rr][q]);
            if (lane < 8) {
                const float gsel = lane == 0 ? gsum[rr][0] : lane == 1 ? gsum[rr][1] : lane == 2 ? gsum[rr][2] : lane == 3 ? gsum[rr][3] : lane == 4 ? gsum[rr][4] : lane == 5 ? gsum[rr][5] : lane == 6 ? gsum[rr][6] : gsum[rr][7];
                const float x = gsel + bg[lane];
                if (lane < 4) LOGI[(size_t)(r0 + rr) * 4 + lane] = x;
                else LOGF[(size_t)(r0 + rr) * 4 + (lane - 4)] = -softplus_f(-x);
            }
        }
    }
}

DI void p4_scan(const Params& p, const Frame& F) {
    const float* LOGI = (const float*)(p.ws + WS_LOGI); const float* LOGF = (const float*)(p.ws + WS_LOGF);
    float* SA = (float*)(p.ws + WS_SA); float* SM = (float*)(p.ws + WS_SM); float* SBt = (float*)(p.ws + WS_SB);
    float* MPREV = (float*)(p.ws + WS_MPREV); float* MTOP = (float*)(p.ws + WS_MTOP);
    const int gw = F.bid * 8 + F.wave, nw = F.G * 8, lane = F.lane;
    const int soff = (F.G >= 128) ? 64 * 8 : 0;
    for (int seq = gw - soff; seq >= 0 && seq < BP * HC; seq += nw) {
        const int b = seq >> 2, h = seq & 3;
        float m = 0.f;
        for (int c = 0; c < NCH; ++c) {
            const int t0 = (c == 0) ? 0 : NMETA + 128 * (c - 1), len = (c == 0) ? NMETA : 128;
            const size_t r0 = (size_t)b * LP + t0;
            const int tA = 2 * lane, tB = 2 * lane + 1;
            const bool vA = tA < len, vB = tB < len;
            const float lfA = vA ? LOGF[(r0 + tA) * 4 + h] : 0.f, lfB = vB ? LOGF[(r0 + tB) * 4 + h] : 0.f;
            const float liA = vA ? LOGI[(r0 + tA) * 4 + h] : 0.f, liB = vB ? LOGI[(r0 + tB) * 4 + h] : 0.f;
            const float pB = lfA + lfB;
            const float inc = wave_scan_add(pB);
            const float exc = inc - pB;
            const float bA = exc + lfA, bB = exc + pB;
            const float aA = vA ? liA - bA : -INFINITY, aB = vB ? liB - bB : -INFINITY;
            const float mB = fmaxf(aA, aB);
            const float minc = wave_scan_max(mB);
            float mexc = __shfl_up(minc, 1); if (lane == 0) mexc = -INFINITY;
            const float MA = fmaxf(m, fmaxf(mexc, aA)), MB = fmaxf(m, fmaxf(mexc, mB));
            if (vA) { SA[(r0 + tA) * 4 + h] = aA; SM[(r0 + tA) * 4 + h] = MA; SBt[(r0 + tA) * 4 + h] = bA; }
            if (vB) { SA[(r0 + tB) * 4 + h] = aB; SM[(r0 + tB) * 4 + h] = MB; SBt[(r0 + tB) * 4 + h] = bB; }
            const int ll = (len - 1) >> 1;
            const float bT = __shfl(bB, ll), MT_ = __shfl(MB, ll);
            if (lane == 0) { MPREV[seq * NCH + c] = m; MTOP[seq * NCH + c] = MT_; }
            m = bT + MT_;
        }
        if (lane == 0) p.out[O_MP + seq] = m;
    }
    const int gt = F.bid * NTHREADS + F.tid, nt = F.G * NTHREADS;
    for (int sq = gt; sq < BS * HC; sq += nt) {
        const int sb = sq >> 2, h = sq & 3;
        const float m = p.in[8][sq];
        float bsum = 0.f, pm = -INFINITY, MT_ = 0.f;
        for (int i = 0; i < 4; ++i) {
            const size_t r = (size_t)MP + sb * 4 + i;
            bsum += LOGF[r * 4 + h];
            const float a = LOGI[r * 4 + h] - bsum;
            pm = fmaxf(pm, a);
            MT_ = fmaxf(m, pm);
            SA[r * 4 + h] = a; SM[r * 4 + h] = MT_; SBt[r * 4 + h] = bsum;
        }
        MPREV[32 * NCH + sq] = m; MTOP[32 * NCH + sq] = MT_;
        p.out[O_MS + sq] = bsum + MT_;
    }
}

DI void p4b_conv(const Params& p, const Frame& F) {
    const bf16_t* XMZ = (const bf16_t*)(p.ws + WS_XMZ); bf16_t* CA = (bf16_t*)(p.ws + WS_CA);
    const float* cw = p.in[20]; const float* cb = p.in[21]; const float* sconv = p.in[9];
    const int gt = F.bid * NTHREADS + F.tid, nt = F.G * NTHREADS;
    for (int idx = gt; idx < (MT / 4) * (INNER / 8); idx += nt) {
        const int rg = idx >> 8, c = (idx & 255) * 8, r = rg * 4;
        const bool samp = r >= MP;
        const int tpos = samp ? 0 : (r % LP), sb = samp ? ((r - MP) >> 2) : 0;
        float x[7][8];
#pragma unroll
        for (int k = 0; k < 4; ++k) {
            const u32x4 w = *(const u32x4*)(XMZ + (size_t)(r + k) * 4096 + c);
            x[3 + k][0] = bflo(w.x); x[3 + k][1] = bfhi(w.x); x[3 + k][2] = bflo(w.y); x[3 + k][3] = bfhi(w.y); x[3 + k][4] = bflo(w.z); x[3 + k][5] = bfhi(w.z); x[3 + k][6] = bflo(w.w); x[3 + k][7] = bfhi(w.w);
        }
        if (samp) {
#pragma unroll
            for (int k = 0; k < 3; ++k) {
                const float* src = sconv + ((size_t)sb * 3 + k) * INNER + c;
                const f32x4 a = *(const f32x4*)src, b2 = *(const f32x4*)(src + 4);
                x[k][0] = a[0]; x[k][1] = a[1]; x[k][2] = a[2]; x[k][3] = a[3]; x[k][4] = b2[0]; x[k][5] = b2[1]; x[k][6] = b2[2]; x[k][7] = b2[3];
            }
        } else if (tpos >= 4) {
#pragma unroll
            for (int k = 0; k < 3; ++k) {
                const u32x4 w = *(const u32x4*)(XMZ + (size_t)(r - 3 + k) * 4096 + c);
                x[k][0] = bflo(w.x); x[k][1] = bfhi(w.x); x[k][2] = bflo(w.y); x[k][3] = bfhi(w.y); x[k][4] = bflo(w.z); x[k][5] = bfhi(w.z); x[k][6] = bflo(w.w); x[k][7] = bfhi(w.w);
            }
        } else {
#pragma unroll
            for (int k = 0; k < 3; ++k)
#pragma unroll
                for (int e = 0; e < 8; ++e) x[k][e] = 0.f;
        }
        float wt[4][8], bias[8];
#pragma unroll
        for (int j = 0; j < 4; ++j) { const f32x4 w0 = *(const f32x4*)(cw + (size_t)j * INNER + c), w1 = *(const f32x4*)(cw + (size_t)j * INNER + c + 4);
            wt[j][0] = w0[0]; wt[j][1] = w0[1]; wt[j][2] = w0[2]; wt[j][3] = w0[3]; wt[j][4] = w1[0]; wt[j][5] = w1[1]; wt[j][6] = w1[2]; wt[j][7] = w1[3]; }
        { const f32x4 b0 = *(const f32x4*)(cb + c), b1 = *(const f32x4*)(cb + c + 4);
          bias[0] = b0[0]; bias[1] = b0[1]; bias[2] = b0[2]; bias[3] = b0[3]; bias[4] = b1[0]; bias[5] = b1[1]; bias[6] = b1[2]; bias[7] = b1[3]; }
#pragma unroll
        for (int k = 0; k < 4; ++k) {
            float acc[8];
#pragma unroll
            for (int e = 0; e < 8; ++e) acc[e] = bias[e] + x[k][e] * wt[0][e] + x[k + 1][e] * wt[1][e] + x[k + 2][e] * wt[2][e] + x[k + 3][e] * wt[3][e];
            u32x4 o;
            o.x = pk2(silu_f(acc[0]), silu_f(acc[1])); o.y = pk2(silu_f(acc[2]), silu_f(acc[3])); o.z = pk2(silu_f(acc[4]), silu_f(acc[5])); o.w = pk2(silu_f(acc[6]), silu_f(acc[7]));
            *(u32x4*)(CA + (size_t)(r + k) * INNER + c) = o;
        }
    }
    for (int idx = gt; idx < (MPAD - MT) * (INNER / 8); idx += nt) *(u32x4*)(CA + (size_t)MT * INNER + (size_t)idx * 8) = (u32x4){0u, 0u, 0u, 0u};
}

DI void p5b_chunk_scores(const Params& p, const Frame& F) {
    const bf16_t* QF = (const bf16_t*)(p.ws + WS_QF); const bf16_t* KC = (const bf16_t*)(p.ws + WS_KC); const bf16_t* KTC = (const bf16_t*)(p.ws + WS_KTC);
    const float* SA = (const float*)(p.ws + WS_SA); const float* SM = (const float*)(p.ws + WS_SM); const float* MTOP = (const float*)(p.ws + WS_MTOP);
    bf16_t* SD = (bf16_t*)(p.ws + WS_SD); float* RS = (float*)(p.ws + WS_RS); float* DN = (float*)(p.ws + WS_DN);
    float* la = (float*)F.lds;
    float* lm = la + 128;
    float* lw = lm + 128;
    float* lrs = lw + 128;
    float* ldn = lrs + 128;
    const int tid = F.tid, lane = F.lane, r31 = lane & 31, hh = lane >> 5;
    for (int ui = F.bid; ui < 32 * NCH; ui += F.G) {
        const int seq = (ui < 512) ? (ui >> 4) : (ui - 512), c = (ui < 512) ? 1 + (ui & 15) : 0, unit = seq * NCH + c, b = seq >> 2, h = seq & 3;
        const int t0 = (c == 0) ? 0 : NMETA + 128 * (c - 1), len = (c == 0) ? NMETA : 128;
        const size_t r0 = (size_t)b * LP + t0;
        if (tid < 128) {
            const bool v = tid < len;
            const float a = v ? SA[(r0 + tid) * 4 + h] : 0.f, M = v ? SM[(r0 + tid) * 4 + h] : 0.f;
            la[tid] = a; lm[tid] = M; lw[tid] = v ? __expf(a - MTOP[unit]) : 0.f; lrs[tid] = 0.f;
        }
        __syncthreads();
        {
            const int tt = F.wave & 3, sp = F.wave >> 2;
            const int t = 32 * tt + r31;
            const float Mt = lm[t];
            const float gT = __expf(MTOP[unit] - Mt);
            float rsum = 0.f;
#pragma unroll
            for (int q = 0; q < 2; ++q) {
                const int st = 2 * sp + q;
                f32x16 acc = zero16();
                if (st <= tt && 32 * st < len) {
                    const bf16_t* kp = KC + (r0 + 32 * st + r31) * INNER + h * DHC + 8 * hh;
                    const bf16_t* qp = QF + ((size_t)(unit * 8 + 2 * tt + (r31 >> 4)) * 16) * 512 + (hh * 16 + (r31 & 15)) * 8;
#pragma unroll 16
                    for (int ks = 0; ks < 32; ++ks) { const bf16x8 a = *(const bf16x8*)(kp + 16 * ks); const bf16x8 bq = *(const bf16x8*)(qp + 256 * ks); acc = MFMA32(a, bq, acc); }
                }
                bf16_t* dst = SD + ((size_t)unit * 128 + t) * 128 + 32 * st + 4 * hh;
#pragma unroll
                for (int g = 0; g < 4; ++g) {
                    float v[4];
#pragma unroll
                    for (int j = 0; j < 4; ++j) {
                        const int s = 32 * st + 8 * g + 4 * hh + j;
                        const bool ok = (s <= t) && (t < len) && (s < len);
                        rsum += ok ? acc[4 * g + j] * __expf(la[s] - Mt) : 0.f;
                        v[j] = ok ? acc[4 * g + j] * gT : 0.f;
                    }
                    u32x2 w; w.x = pk2(v[0], v[1]); w.y = pk2(v[2], v[3]);
                    *(u32x2*)(dst + 8 * g) = w;
                }
            }
            atomicAdd(&lrs[t], rsum);
        }
        float dacc0 = 0.f, dacc1 = 0.f;
        {
            const int dp = tid & 255, sh = tid >> 8;
            const bf16_t* kp = KC + (r0 + 64 * sh) * INNER + h * DHC + 2 * dp;
#pragma unroll 8
            for (int s8 = 0; s8 < 64; ++s8) {
                const unsigned w = *(const unsigned*)(kp + (size_t)s8 * INNER);
                const float ws_ = lw[64 * sh + s8];
                dacc0 += ws_ * bflo(w); dacc1 += ws_ * bfhi(w);
            }
            if (sh == 1) { ldn[2 * dp] = dacc0; ldn[2 * dp + 1] = dacc1; }
        }
        __syncthreads();
        if (tid < 256) { DN[(size_t)unit * DHC + 2 * tid] = dacc0 + ldn[2 * tid]; DN[(size_t)unit * DHC + 2 * tid + 1] = dacc1 + ldn[2 * tid + 1]; }
        if (tid < 128) RS[(size_t)unit * 128 + tid] = lrs[tid];
        __syncthreads();
    }
}

DI void p6_mlstm_prompt(const Params& p, const Frame& F) {
    const bf16_t* QF = (const bf16_t*)(p.ws + WS_QF); const bf16_t* KTC = (const bf16_t*)(p.ws + WS_KTC); const bf16_t* VTC = (const bf16_t*)(p.ws + WS_VTC);
    const bf16_t* SD = (const bf16_t*)(p.ws + WS_SD); const float* RS = (const float*)(p.ws + WS_RS); const float* DN = (const float*)(p.ws + WS_DN);
    const float* SA = (const float*)(p.ws + WS_SA); const float* SM = (const float*)(p.ws + WS_SM); const float* SBt = (const float*)(p.ws + WS_SB);
    const float* MPREV = (const float*)(p.ws + WS_MPREV); const float* MTOP = (const float*)(p.ws + WS_MTOP);
    bf16_t* HH = (bf16_t*)(p.ws + WS_HH);
    constexpr int CTS = 520, VTS = 136, SDS = 136;
    bf16_t* CT = (bf16_t*)F.lds;
    bf16_t* VT = (bf16_t*)(F.lds + 66560);
    bf16_t* SDl = (bf16_t*)(F.lds + 66560 + 17408);
    float* nvec = (float*)(F.lds + 118784);
    float* lwi = nvec + 512;
    float* lws = lwi + 128;
    float* lrs = lws + 128;
    float* lel = lrs + 128;
    bf16_t* nb16 = (bf16_t*)(lel + 128);
    bf16_t* hbuf = nb16 + 512;
    const int tid = F.tid, lane = F.lane, wave = F.wave, r31 = lane & 31, hh = lane >> 5;
    const int et2 = wave >> 2, tt = wave & 3;
    for (int unit = F.bid; unit < 256; unit += F.G) {
        const int xcd = unit & 7, jj = unit >> 3, seq = xcd * 4 + (jj >> 3), sl = jj & 7;
        const int b = seq >> 2, h = seq & 3, e0 = sl * 64;
        const size_t rb = (size_t)b * LP;
        f32x16 accC[2][2];
#pragma unroll
        for (int a2 = 0; a2 < 2; ++a2)
#pragma unroll
            for (int c2 = 0; c2 < 2; ++c2) accC[a2][c2] = zero16();
        nvec[tid] = 0.f;
#define P6_QLANE(tz) (QF + ((size_t)(seq * NCH) * 8 + ((tz) >> 6)) * 8192 + ((tz) & 63) * 8)
#define P6_KLANE(tz) (KTC + ((size_t)(seq * NCH) * 8 + ((tz) >> 6)) * 8192 + ((tz) & 63) * 8)
#define P6_VSRC(tz) (VTC + ((size_t)h * DHC + e0 + ((tz) >> 3)) * MPAD + rb + ((tz) & 7) * 16)
#define P6_SSRC(tz) (SD + ((size_t)seq * NCH * 128 + ((tz) >> 2)) * 128 + ((tz) & 3) * 32)
        int tu = tid; asm volatile("" : "+v"(tu));
        const bf16_t* qlane = P6_QLANE(tu); const bf16_t* vsrc = P6_VSRC(tu); const bf16_t* ssrc = P6_SSRC(tu);
        bf16x8 win[16];
#pragma unroll
        for (int u = 0; u < 16; ++u) win[u] = *(const bf16x8*)(qlane + 512 * u);
        u32x4 sv[2], ss[4];
        sv[0] = *(const u32x4*)(vsrc); sv[1] = *(const u32x4*)(vsrc + 8);
#pragma unroll
        for (int q = 0; q < 4; ++q) ss[q] = *(const u32x4*)(ssrc + 8 * q);
        float sa = 0.f, sm = 0.f, sb = 0.f, rs = 0.f, dn = 0.f, decay_prev = 0.f;
        if (tid < 128) { const size_t r = rb + tid; sa = SA[r * 4 + h]; sm = SM[r * 4 + h]; sb = SBt[r * 4 + h]; rs = RS[(size_t)(seq * NCH) * 128 + tid]; }
        float mprev = MPREV[seq * NCH], mtop = MTOP[seq * NCH];
        unsigned pf = 0u;
        for (int c = 0; c < NCH; ++c) {
            const int cu = seq * NCH + c;
            const int t0 = (c == 0) ? 0 : NMETA + 128 * (c - 1), len = (c == 0) ? NMETA : 128;
            const size_t r0 = rb + t0;
            const float decay = __expf(mprev - mtop);
#pragma unroll
            for (int dt = 0; dt < 2; ++dt)
#pragma unroll
                for (int et = 0; et < 2; ++et)
#pragma unroll
                    for (int g = 0; g < 4; ++g) {
                        u32x2 w; w.x = pk2(accC[dt][et][4 * g], accC[dt][et][4 * g + 1]); w.y = pk2(accC[dt][et][4 * g + 2], accC[dt][et][4 * g + 3]);
                        *(u32x2*)(CT + (32 * et + r31) * CTS + 64 * wave + 32 * dt + 8 * g + 4 * hh) = w;
                    }
            if (c == 0 && (tid & 7) != 0) { sv[0] = (u32x4){0u, 0u, 0u, 0u}; sv[1] = (u32x4){0u, 0u, 0u, 0u}; }
            *(u32x4*)(VT + (tid >> 3) * VTS + (tid & 7) * 16) = sv[0]; *(u32x4*)(VT + (tid >> 3) * VTS + (tid & 7) * 16 + 8) = sv[1];
#pragma unroll
            for (int q = 0; q < 4; ++q) *(u32x4*)(SDl + (tid >> 2) * SDS + (tid & 3) * 32 + 8 * q) = ss[q];
            asm volatile("" :: "v"(pf));
            { const float nv = (c > 0) ? decay_prev * nvec[tid] + dn : 0.f; nvec[tid] = nv; nb16[tid] = f2bf(nv); }
            if (tid < 128) {
                const bool v = tid < len;
                lwi[tid] = __expf(mprev - sm); lws[tid] = v ? __expf(sa - mtop) : 0.f; lrs[tid] = rs; lel[tid] = __expf(-(sb + sm));
            }
            __syncthreads();
            {
                const int l15 = lane & 15, kq = lane >> 4;
                const int t = 16 * wave + l15;
                f32x4 acc[4];
#pragma unroll
                for (int q4 = 0; q4 < 4; ++q4) acc[q4] = (f32x4){0.f, 0.f, 0.f, 0.f};
                float qn = 0.f;
                const bf16_t* ap = CT + l15 * CTS + 8 * kq;
                const bf16_t* np_ = nb16 + 8 * kq;
                int tz = tid; asm volatile("" : "+v"(tz));
                const bf16_t* kc0 = P6_KLANE(tz) + (size_t)c * 65536;
#pragma unroll
                for (int ks = 0; ks < 16; ++ks) {
                    const bf16x8 f = win[ks];
#pragma unroll
                    for (int q4 = 0; q4 < 4; ++q4) { const bf16x8 a_ = *(const bf16x8*)(ap + 16 * q4 * CTS + 32 * ks); acc[q4] = __builtin_amdgcn_mfma_f32_16x16x32_bf16(a_, f, acc[q4], 0, 0, 0); }
                    const u32x4 w_ = __builtin_bit_cast(u32x4, f); const u32x4 n_ = *(const u32x4*)(np_ + 32 * ks);
                    qn = __builtin_amdgcn_fdot2_f32_bf16(__builtin_bit_cast(bf16v2, w_.x), __builtin_bit_cast(bf16v2, n_.x), qn, false);
                    qn = __builtin_amdgcn_fdot2_f32_bf16(__builtin_bit_cast(bf16v2, w_.y), __builtin_bit_cast(bf16v2, n_.y), qn, false);
                    qn = __builtin_amdgcn_fdot2_f32_bf16(__builtin_bit_cast(bf16v2, w_.z), __builtin_bit_cast(bf16v2, n_.z), qn, false);
                    qn = __builtin_amdgcn_fdot2_f32_bf16(__builtin_bit_cast(bf16v2, w_.w), __builtin_bit_cast(bf16v2, n_.w), qn, false);
                    win[ks] = *(const bf16x8*)(kc0 + 512 * ks);
                }
                const float wi = lwi[t];
#pragma unroll
                for (int q4 = 0; q4 < 4; ++q4) acc[q4] *= wi;
                const bf16_t* vp = VT + l15 * VTS + 8 * kq;
                const bf16_t* sp = SDl + t * SDS + 8 * kq;
#pragma unroll
                for (int ks = 0; ks < 4; ++ks) {
                    const bf16x8 bq = *(const bf16x8*)(sp + 32 * ks);
#pragma unroll
                    for (int q4 = 0; q4 < 4; ++q4) { const bf16x8 a_ = *(const bf16x8*)(vp + 16 * q4 * VTS + 32 * ks); acc[q4] = __builtin_amdgcn_mfma_f32_16x16x32_bf16(a_, bq, acc[q4], 0, 0, 0); }
                }
                qn += __shfl_xor(qn, 16); qn += __shfl_xor(qn, 32);
                const float den = wi * qn + lrs[t];
                const float inv = 1.f / fmaxf(fabsf(den), lel[t]);
#pragma unroll
                for (int q4 = 0; q4 < 4; ++q4) { u32x2 w; w.x = pk2(acc[q4][0] * inv, acc[q4][1] * inv); w.y = pk2(acc[q4][2] * inv, acc[q4][3] * inv);
                    *(u32x2*)(hbuf + wave * 1024 + l15 * 64 + 16 * q4 + 4 * kq) = w; }
            }
            const int cn = (c + 1 < NCH) ? c + 1 : c;
            const int t0n = (cn == 0) ? 0 : NMETA + 128 * (cn - 1);
            { int tz = tid; asm volatile("" : "+v"(tz)); const bf16_t* vs_ = P6_VSRC(tz) + t0n; const bf16_t* ss_ = P6_SSRC(tz) + (size_t)cn * 16384;
              sv[0] = *(const u32x4*)(vs_); sv[1] = *(const u32x4*)(vs_ + 8);
#pragma unroll
              for (int q = 0; q < 4; ++q) ss[q] = *(const u32x4*)(ss_ + 8 * q); }
            if (tid < 128) { const size_t r = rb + t0n + tid; sa = SA[r * 4 + h]; sm = SM[r * 4 + h]; sb = SBt[r * 4 + h]; rs = RS[(size_t)(seq * NCH + cn) * 128 + tid]; }
            const float mprev_n = MPREV[seq * NCH + cn], mtop_n = MTOP[seq * NCH + cn];
            dn = DN[(size_t)cu * DHC + tid]; decay_prev = decay;
            if (tid < 256) {
                int tz = tid; asm volatile("" : "+v"(tz));
                const int li = sl * 256 + tz;
                const int cq = (c + 2 < NCH) ? c + 2 : NCH - 1, ck = (c + 1 < NCH) ? c + 1 : NCH - 1;
                const bf16_t* a_ = (li < 1024) ? QF + (size_t)(seq * NCH + cq) * 65536 + li * 64 : KTC + (size_t)(seq * NCH + ck) * 65536 + (li - 1024) * 64;
                pf = *(const unsigned*)a_;
            }
            {
#pragma unroll
                for (int dt = 0; dt < 2; ++dt)
#pragma unroll
                    for (int et = 0; et < 2; ++et)
#pragma unroll
                        for (int reg = 0; reg < 16; ++reg) accC[dt][et][reg] *= decay;
                int tz = tid; asm volatile("" : "+v"(tz));
                const bf16_t* qn0 = P6_QLANE(tz) + (size_t)cn * 65536;
                const bf16_t* vp0 = VT + r31 * VTS + 32 * hh;
                const bf16_t* vp1 = vp0 + 32 * VTS;
#pragma unroll
                for (int GP = 0; GP < 4; ++GP) {
                    const int G = GP >> 1, sb0 = 2 * (GP & 1);
                    bf16x8 vs0[2], vs1[2];
#pragma unroll
                    for (int sq = 0; sq < 2; ++sq) { vs0[sq] = *(const bf16x8*)(vp0 + 64 * G + 8 * (sb0 + sq)); vs1[sq] = *(const bf16x8*)(vp1 + 64 * G + 8 * (sb0 + sq)); }
#pragma unroll
                    for (int q = 0; q < 4; ++q) {
                        const int dt = q >> 1, sq = q & 1, i = 8 * G + 4 * dt + sb0 + sq;
                        const bf16x8 f = win[i];
                        if (dt == 0) { accC[0][0] = MFMA32(f, vs0[sq], accC[0][0]); accC[0][1] = MFMA32(f, vs1[sq], accC[0][1]); }
                        else { accC[1][0] = MFMA32(f, vs0[sq], accC[1][0]); accC[1][1] = MFMA32(f, vs1[sq], accC[1][1]); }
                        win[i] = *(const bf16x8*)(qn0 + 512 * i);
                        __builtin_amdgcn_sched_barrier(0);
                    }
                }
            }
            {
                const int tl = lane >> 2, ec = (lane & 3) * 16, t = 16 * wave + tl;
                const u32x4 h0 = *(const u32x4*)(hbuf + wave * 1024 + tl * 64 + ec), h1 = *(const u32x4*)(hbuf + wave * 1024 + tl * 64 + ec + 8);
                if (t < len) { bf16_t* dst = HH + (r0 + t) * INNER + h * DHC + e0 + ec; *(u32x4*)dst = h0; *(u32x4*)(dst + 8) = h1; }
            }
            __syncthreads();
            mprev = mprev_n; mtop = mtop_n;
        }
        {
            nvec[tid] = decay_prev * nvec[tid] + dn;
            float* cb = p.out + O_CP + ((size_t)seq * DHC) * DHC + (size_t)(64 * wave + 4 * hh) * DHC + e0 + r31;
            asm volatile("" : "+v"(cb));
#pragma unroll
            for (int dt = 0; dt < 2; ++dt)
#pragma unroll
                for (int et = 0; et < 2; ++et)
#pragma unroll
                    for (int reg = 0; reg < 16; ++reg) cb[(size_t)(32 * dt + (reg & 3) + 8 * (reg >> 2)) * DHC + 32 * et] = accC[dt][et][reg];
            if (sl == 0) p.out[O_NP + (size_t)seq * DHC + tid] = nvec[tid];
        }
        __syncthreads();
    }
}

DI void p6_mlstm_sample(const Params& p, const Frame& F) {
    const bf16_t* QC = (const bf16_t*)(p.ws + WS_QC); const bf16_t* KC = (const bf16_t*)(p.ws + WS_KC); const bf16_t* VTC = (const bf16_t*)(p.ws + WS_VTC);
    const float* SA = (const float*)(p.ws + WS_SA); const float* SM = (const float*)(p.ws + WS_SM); const float* SBt = (const float*)(p.ws + WS_SB);
    const float* MTOP = (const float*)(p.ws + WS_MTOP);
    bf16_t* HH = (bf16_t*)(p.ws + WS_HH);
    const float* stC = p.in[6]; const float* stn = p.in[7]; const float* stm = p.in[8];
    float* qk = (float*)F.lds;
    float* kraw = qk + 4096;
    float* nl = kraw + 2048;
    float* red = nl + 512;
    float* dots = red + 8192;
    float* sc = dots + 32;
    const int tid = F.tid, lane = F.lane, wave = F.wave;
    f32x4 cA[8], cB[8];
    if (F.bid < BS * HC) {
        const float* C0 = stC + ((size_t)F.bid * DHC + (tid >> 7) * 128) * DHC + (tid & 127) * 4;
#pragma unroll
        for (int u = 0; u < 8; ++u) cA[u] = __builtin_nontemporal_load((const f32x4*)(C0 + (size_t)u * DHC));
    }
    for (int item = F.bid; item < BS * HC; item += F.G) {
        const int sb = item >> 2, h = item & 3;
        const size_t rb = (size_t)MP + sb * 4;
        const float mprev = stm[item], MTc = MTOP[32 * NCH + item];
        const float decay = __expf(mprev - MTc);
        float wsr[4];
#pragma unroll
        for (int s = 0; s < 4; ++s) wsr[s] = __expf(SA[(rb + s) * 4 + h] - MTc);
        {
            const int d = tid;
#pragma unroll
            for (int t = 0; t < 4; ++t) qk[d * 8 + t] = bf2f(QC[(rb + t) * INNER + h * DHC + d]);
#pragma unroll
            for (int s = 0; s < 4; ++s) { const float kv = bf2f(KC[(rb + s) * INNER + h * DHC + d]); kraw[s * 512 + d] = kv; qk[d * 8 + 4 + s] = kv * wsr[s]; }
            nl[d] = stn[(size_t)item * DHC + d];
        }
        const int e4 = tid & 127, dg = tid >> 7;
        f32x4 vr[4];
        {
#pragma unroll
            for (int j = 0; j < 4; ++j) {
                const u32x2 w = *(const u32x2*)(VTC + ((size_t)h * DHC + e4 * 4 + j) * MPAD + rb);
                vr[0][j] = bflo(w.x); vr[1][j] = bfhi(w.x); vr[2][j] = bflo(w.y); vr[3][j] = bfhi(w.y);
            }
        }
        __syncthreads();
#pragma unroll
        for (int rep = 0; rep < 3; ++rep) {
            const int di = wave + 8 * rep;
            if (di < 20) {
                const int t = (di < 16) ? (di >> 2) : (di - 16);
                const float* other = (di < 16) ? (kraw + (di & 3) * 512) : nl;
                float acc = 0.f;
#pragma unroll
                for (int k = 0; k < 8; ++k) { const int d = lane + 64 * k; acc += qk[d * 8 + t] * other[d]; }
                acc = wave_sum(acc);
                if (lane == 0) dots[di] = acc;
            }
        }
        __syncthreads();
        if (tid < 4) {
            const int t = tid;
            const float M = SM[(rb + t) * 4 + h], bt = SBt[(rb + t) * 4 + h];
            const float wi = __expf(mprev - M);
            float rs = 0.f;
#pragma unroll
            for (int s = 0; s < 4; ++s) {
                const float v = (s <= t) ? dots[t * 4 + s] * __expf(SA[(rb + s) * 4 + h] - M) : 0.f;
                sc[16 + t * 4 + s] = v; rs += v;
            }
            const float den = wi * dots[16 + t] + rs;
            sc[t] = wi; sc[8 + t] = 1.f / fmaxf(fabsf(den), __expf(-(bt + M)));
        }
        f32x4 it[4];
#pragma unroll
        for (int t = 0; t < 4; ++t) it[t] = (f32x4){0.f, 0.f, 0.f, 0.f};
        {
            const float* Cin = stC + ((size_t)item * DHC + dg * 128) * DHC + e4 * 4;
            float* Cout = p.out + O_CS + ((size_t)item * DHC + dg * 128) * DHC + e4 * 4;
            const int nitem = (item + F.G < BS * HC) ? item + F.G : item;
            const float* Cnx = stC + ((size_t)nitem * DHC + dg * 128) * DHC + e4 * 4;
#define MS_LOAD(buf, base, bt) do { _Pragma("unroll") for (int u_ = 0; u_ < 8; ++u_) buf[u_] = __builtin_nontemporal_load((const f32x4*)((base) + (size_t)((bt) * 8 + u_) * DHC)); } while (0)
#define MS_USE(buf, bt) do { _Pragma("unroll") for (int u_ = 0; u_ < 8; ++u_) { const int d_ = dg * 128 + (bt) * 8 + u_; \
                const f32x4 qv_ = *(const f32x4*)(qk + d_ * 8), kw_ = *(const f32x4*)(qk + d_ * 8 + 4); \
                _Pragma("unroll") for (int t_ = 0; t_ < 4; ++t_) it[t_] += buf[u_] * qv_[t_]; \
                f32x4 cn_ = buf[u_] * decay; \
                _Pragma("unroll") for (int s_ = 0; s_ < 4; ++s_) cn_ += vr[s_] * kw_[s_]; \
                __builtin_nontemporal_store(cn_, (f32x4*)(Cout + (size_t)((bt) * 8 + u_) * DHC)); } } while (0)
            for (int bt = 0; bt < 16; bt += 2) {
                MS_LOAD(cB, Cin, bt + 1); MS_USE(cA, bt);
                if (bt + 2 < 16) MS_LOAD(cA, Cin, bt + 2); else MS_LOAD(cA, Cnx, 0);
                MS_USE(cB, bt + 1);
            }
#undef MS_LOAD
#undef MS_USE
        }
#pragma unroll
        for (int t = 0; t < 4; ++t) *(f32x4*)(red + (dg * 4 + t) * 512 + e4 * 4) = it[t];
        __syncthreads();
        {
            const int e = tid;
            float vcol[4];
            { const u32x2 w = *(const u32x2*)(VTC + ((size_t)h * DHC + e) * MPAD + rb); vcol[0] = bflo(w.x); vcol[1] = bfhi(w.x); vcol[2] = bflo(w.y); vcol[3] = bfhi(w.y); }
#pragma unroll
            for (int t = 0; t < 4; ++t) {
                const float inter = (red[(0 * 4 + t) * 512 + e] + red[(1 * 4 + t) * 512 + e]) + (red[(2 * 4 + t) * 512 + e] + red[(3 * 4 + t) * 512 + e]);
                float num = sc[t] * inter;
#pragma unroll
                for (int s = 0; s < 4; ++s) num += sc[16 + t * 4 + s] * vcol[s];
                HH[(rb + t) * INNER + h * DHC + e] = f2bf(num * sc[8 + t]);
            }
            float nn = decay * nl[tid];
#pragma unroll
            for (int s = 0; s < 4; ++s) nn += qk[tid * 8 + 4 + s];
            p.out[O_NS + (size_t)item * DHC + tid] = nn;
        }
        __syncthreads();
    }
}

DI void p6c_prep_out(const Params& p, const Frame& F) {
    const bf16_t* HH = (const bf16_t*)(p.ws + WS_HH); const bf16_t* CA = (const bf16_t*)(p.ws + WS_CA); const bf16_t* XMZ = (const bf16_t*)(p.ws + WS_XMZ);
    bf16_t* A2 = (bf16_t*)(p.ws + WS_A2);
    const float* skip = p.in[25]; const float* ong = p.in[26];
    const int gw = F.bid * 8 + F.wave, nw = F.G * 8, lane = F.lane;
    for (int task = gw; task < MT * 2; task += nw) {
        const int r = task >> 1, hbase = (task & 1) * 2;
        const float* ong_ = ong; const float* skip_ = skip; asm volatile("" : "+s"(ong_), "+s"(skip_));
        u32x4 hw[2], cw4[2], zw[2];
#pragma unroll
        for (int h = 0; h < 2; ++h) {
            const int c = (hbase + h) * DHC + lane * 8;
            hw[h] = *(const u32x4*)(HH + (size_t)r * INNER + c); cw4[h] = *(const u32x4*)(CA + (size_t)r * INNER + c); zw[h] = *(const u32x4*)(XMZ + (size_t)r * 4096 + INNER + c);
        }
#pragma unroll
        for (int h = 0; h < 2; ++h) {
            const int c = (hbase + h) * DHC + lane * 8;
            float x[8] = {bflo(hw[h].x), bfhi(hw[h].x), bflo(hw[h].y), bfhi(hw[h].y), bflo(hw[h].z), bfhi(hw[h].z), bflo(hw[h].w), bfhi(hw[h].w)};
            float sm_ = 0.f;
#pragma unroll
            for (int k = 0; k < 8; ++k) sm_ += x[k];
            const float mu = wave_sum(sm_) * (1.f / DHC);
            float q = 0.f;
#pragma unroll
            for (int k = 0; k < 8; ++k) { x[k] -= mu; q += x[k] * x[k]; }
            const float rstd = rsqrtf(wave_sum(q) * (1.f / DHC) + EPS);
            const float cav[8] = {bflo(cw4[h].x), bfhi(cw4[h].x), bflo(cw4[h].y), bfhi(cw4[h].y), bflo(cw4[h].z), bfhi(cw4[h].z), bflo(cw4[h].w), bfhi(cw4[h].w)};
            const float zv[8] = {bflo(zw[h].x), bfhi(zw[h].x), bflo(zw[h].y), bfhi(zw[h].y), bflo(zw[h].z), bfhi(zw[h].z), bflo(zw[h].w), bfhi(zw[h].w)};
            const f32x4 g0 = *(const f32x4*)(ong_ + c), g1 = *(const f32x4*)(ong_ + c + 4), s0 = *(const f32x4*)(skip_ + c), s1 = *(const f32x4*)(skip_ + c + 4);
            const float gv[8] = {g0[0], g0[1], g0[2], g0[3], g1[0], g1[1], g1[2], g1[3]};
            const float sv[8] = {s0[0], s0[1], s0[2], s0[3], s1[0], s1[1], s1[2], s1[3]};
            float o[8];
#pragma unroll
            for (int k = 0; k < 8; ++k) o[k] = (x[k] * rstd * gv[k] + sv[k] * cav[k]) * silu_f(zv[k]);
            u32x4 w; w.x = pk2(o[0], o[1]); w.y = pk2(o[2], o[3]); w.z = pk2(o[4], o[5]); w.w = pk2(o[6], o[7]);
            *(u32x4*)(A2 + (size_t)r * INNER + c) = w;
        }
    }
    const int gt = F.bid * NTHREADS + F.tid, nt = F.G * NTHREADS;
    for (int idx = gt; idx < (MPAD - MT) * (INNER / 8); idx += nt) *(u32x4*)(A2 + (size_t)MT * INNER + (size_t)idx * 8) = (u32x4){0u, 0u, 0u, 0u};
}

DI void p8_final_norm(const Params& p, const Frame& F) {
    const bf16_t* HB = (const bf16_t*)(p.ws + WS_H); const float* gf = p.in[12]; const float* PART = (const float*)(p.ws + WS_PART);
    const int gw = F.bid * 8 + F.wave, nw = F.G * 8, lane = F.lane;
    constexpr int RB = 4;
    for (int r0 = gw * RB; r0 < MT; r0 += nw * RB) {
        float* dst;
        if (r0 < MP) { const int b = r0 / LP, t = r0 - b * LP; if (t < NMETA) continue; dst = p.out + O_YP + ((size_t)b * SEQ + (t - NMETA)) * D; }
        else dst = p.out + O_YS + (size_t)(r0 - MP) * D;
        u32x4 hw[RB][2];
#pragma unroll
        for (int rr = 0; rr < RB; ++rr)
#pragma unroll
            for (int j = 0; j < 2; ++j) hw[rr][j] = *(const u32x4*)(HB + (size_t)(r0 + rr) * D + j * 512 + lane * 8);
#pragma unroll
        for (int rr = 0; rr < RB; ++rr) {
            float v[2][8]; float ss = 0.f;
#pragma unroll
            for (int j = 0; j < 2; ++j) {
                const u32x4 w = hw[rr][j];
                v[j][0] = bflo(w.x); v[j][1] = bfhi(w.x); v[j][2] = bflo(w.y); v[j][3] = bfhi(w.y); v[j][4] = bflo(w.z); v[j][5] = bfhi(w.z); v[j][6] = bflo(w.w); v[j][7] = bfhi(w.w);
                if (r0 >= MMAIN) {
#pragma unroll
                    for (int ks = 0; ks < 8; ++ks) {
                        const float* pp = PART + ((size_t)ks * 768 + (r0 + rr - MMAIN)) * D + j * 512 + lane * 8;
                        const f32x4 a0 = *(const f32x4*)pp, a1 = *(const f32x4*)(pp + 4);
                        v[j][0] += a0[0]; v[j][1] += a0[1]; v[j][2] += a0[2]; v[j][3] += a0[3]; v[j][4] += a1[0]; v[j][5] += a1[1]; v[j][6] += a1[2]; v[j][7] += a1[3];
                    }
                }
#pragma unroll
                for (int k = 0; k < 8; ++k) ss += v[j][k] * v[j][k];
            }
            const float rstd = rsqrtf(wave_sum(ss) * (1.f / D) + EPS);
#pragma unroll
            for (int j = 0; j < 2; ++j) {
                const int c = j * 512 + lane * 8;
                const f32x4 ga = *(const f32x4*)(gf + c), gb = *(const f32x4*)(gf + c + 4);
                *(f32x4*)(dst + (size_t)rr * D + c) = (f32x4){v[j][0] * rstd * ga[0], v[j][1] * rstd * ga[1], v[j][2] * rstd * ga[2], v[j][3] * rstd * ga[3]};
                *(f32x4*)(dst + (size_t)rr * D + c + 4) = (f32x4){v[j][4] * rstd * gb[0], v[j][5] * rstd * gb[1], v[j][6] * rstd * gb[2], v[j][7] * rstd * gb[3]};
            }
        }
    }
}

DI Params fresh_params() {
    Params q;
#if defined(__HIP_DEVICE_COMPILE__)
    const __attribute__((address_space(4))) unsigned long long* k = (const __attribute__((address_space(4))) unsigned long long*)__builtin_amdgcn_kernarg_segment_ptr();
    asm volatile("" : "+s"(k));
#pragma unroll
    for (int i = 0; i < 28; ++i) q.in[i] = (const float*)(const __attribute__((address_space(1))) float*)k[i];
    q.out = (float*)(__attribute__((address_space(1))) float*)k[28]; q.ws = (unsigned char*)(__attribute__((address_space(1))) unsigned char*)k[29];
    const unsigned long long w = k[30]; q.ph_lo = (int)(unsigned)w; q.ph_hi = (int)(unsigned)(w >> 32);
#else
    q = Params{};
#endif
    return q;
}

constexpr int NPHASE = 14;
__global__ void __launch_bounds__(NTHREADS, 2) fwd_kernel(Params p_unused) {
    extern __shared__ __attribute__((aligned(16))) unsigned char lds_raw[];
    LAS unsigned char* ldsl = (LAS unsigned char*)lds_raw;
    volatile LAS unsigned* ctl = (volatile LAS unsigned*)(ldsl + LDS_CTL_OFF);
    if (threadIdx.x < 4) ctl[threadIdx.x] = 0u;
    __syncthreads();
    int lo, hi; unsigned* barw; { const Params q = fresh_params(); lo = q.ph_lo; hi = q.ph_hi; barw = (unsigned*)(q.ws + WS_CTL); }
    XcdBarrier bar; bar.bar = barw; bar.x = 0; bar.st = ctl;
    if (hi - lo > 1) bar = xcd_barrier_post(barw, ctl);
#ifndef PHMASK
#define PHMASK 0xFFFFFFFFu
#endif
#define IN(k) ((((PHMASK) >> (k)) & 1u) && lo <= (k) && (k) < hi)
#define SEAM(k) do { if (IN(k) && IN((k) + 1)) xcd_barrier(bar); } while (0)

    if (IN(0)) { const Params p = fresh_params(); const Frame F = make_frame(lds_raw); p0_prologue(p, F); }
    SEAM(0);
    if (IN(1)) {
        const Params p = fresh_params(); const Frame F = make_frame(lds_raw); unsigned char* ws = p.ws;
        pg8::Gemm g{(const bf16_t*)(ws + WS_XN), (const bf16_t*)(ws + WS_WTINA), D, D, D};
        pg8::InAOrder S{F.G, F.bid};
        EpiInA E{(bf16_t*)(ws + WS_PROJA), (float*)(ws + WS_U32), p.out, (bf16_t*)(ws + WS_VTA)};
        pg8::gemm_phase(ldsl, g, S, E);
    }
    SEAM(1);
    if (IN(2)) {
        const bool sample_first = ((blockIdx.x >> 3) & 1) == 0;
        if (sample_first) { const Params p = fresh_params(); const Frame F = make_frame(lds_raw); p2_attn_sample(p, F); }
        { const Params p = fresh_params(); const Frame F = make_frame(lds_raw); p2_attn_prompt(p, F); }
        { const Params p = fresh_params(); const Frame F = make_frame(lds_raw); p2_pool(p, F); }
        if (!sample_first) { const Params p = fresh_params(); const Frame F = make_frame(lds_raw); p2_attn_sample(p, F); }
    }
    SEAM(2);
    if (IN(3)) { const Params p = fresh_params(); const Frame F = make_frame(lds_raw); p2d_combine(p, F); }
    SEAM(3);
    if (IN(4)) {
        const Params p = fresh_params(); const Frame F = make_frame(lds_raw); unsigned char* ws = p.ws;
        {
            pg8::Gemm g{(const bf16_t*)(ws + WS_MIXED), (const bf16_t*)(ws + WS_WTOUTA), D, D, D};
            pg8::StaticOrder<0> S; S.init(MMAIN, D, F.G, F.bid);
            EpiResX E{(bf16_t*)(ws + WS_H), p.in[0], p.in[1], p.in[10]};
            pg8::gemm_phase(ldsl, g, S, E);
        }
        {
            pg8::Gemm g{(const bf16_t*)(ws + WS_MIXED), (const bf16_t*)(ws + WS_WTOUTA), D, D, 256};
            pg8::TailOrder S; S.init(4, 256, F.G, (F.bid + 128) % F.G);
            EpiPart E{(float*)(ws + WS_PART), 256};
            pg8::gemm_phase(ldsl, g, S, E);
        }
    }
    SEAM(4);
    if (IN(5)) { const Params p = fresh_params(); const Frame F = make_frame(lds_raw); p3b_norm_gates(p, F); }
    SEAM(5);
    if (IN(6)) {
        const Params p = fresh_params(); const Frame F = make_frame(lds_raw); unsigned char* ws = p.ws;
        p4_scan(p, F);
        pg8::Gemm g{(const bf16_t*)(ws + WS_XN), (const bf16_t*)(ws + WS_WTINC), D, D, D};
        pg8::InCMainOrder S{F.G, F.bid};
        EpiInC E{(bf16_t*)(ws + WS_XMZ), p.out};
        pg8::gemm_phase(ldsl, g, S, E);
    }
    SEAM(6);
    if (IN(7)) {
        { const Params p = fresh_params(); const Frame F = make_frame(lds_raw); p4b_conv(p, F); }
        {
            const Params p = fresh_params(); const Frame F = make_frame(lds_raw);
            bf16_t* KTC = (bf16_t*)(p.ws + WS_KTC);
            for (int idx = F.bid * NTHREADS + F.tid; idx < 32 * 8192; idx += F.G * NTHREADS)
                *(u32x4*)(KTC + (size_t)(idx >> 13) * NCH * 65536 + (size_t)(idx & 8191) * 8) = (u32x4){0u, 0u, 0u, 0u};
        }
    }
    SEAM(7);
    if (IN(8)) {
        const Params p = fresh_params(); const Frame F = make_frame(lds_raw); unsigned char* ws = p.ws;
        {
            pg8::Gemm g{(const bf16_t*)(ws + WS_CA), (const bf16_t*)(ws + WS_WTQ), INNER, DHC, DHC};
            pg8::StaticOrder<1> S; S.init(MPAD, 4096, F.G, F.bid);
            EpiQK E{(bf16_t*)(ws + WS_QC), (bf16_t*)(ws + WS_KC), (bf16_t*)(ws + WS_KTC), (bf16_t*)(ws + WS_QF)};
            pg8::gemm_phase(ldsl, g, S, E);
        }
        {
            pg8::Gemm g{(const bf16_t*)(ws + WS_XN), (const bf16_t*)(ws + WS_WTINC), D, D, D};
            pg8::InCTailOrder S{F.G, F.bid};
            EpiInC E{(bf16_t*)(ws + WS_XMZ), p.out};
            pg8::gemm_phase(ldsl, g, S, E);
        }
        {
            pg8::Gemm g{(const bf16_t*)(ws + WS_WTV), (const bf16_t*)(ws + WS_XMZ), DHC, 4096, DHC};
            pg8::VtOrder S{F.G, F.bid};
            EpiVTs E{(bf16_t*)(ws + WS_VTC), (const float*)(ws + WS_SA), (const float*)(ws + WS_MTOP)};
            pg8::gemm_phase(ldsl, g, S, E);
        }
    }
    SEAM(8);
    if (IN(9)) { const Params p = fresh_params(); const Frame F = make_frame(lds_raw); p5b_chunk_scores(p, F); }
    SEAM(9);
    if (IN(10)) {
        const bool sample_first = ((blockIdx.x >> 6) & 1) == 0;
        if (sample_first) { const Params p = fresh_params(); const Frame F = make_frame(lds_raw); p6_mlstm_sample(p, F); }
        { const Params p = fresh_params(); const Frame F = make_frame(lds_raw); p6_mlstm_prompt(p, F); }
        if (!sample_first) { const Params p = fresh_params(); const Frame F = make_frame(lds_raw); p6_mlstm_sample(p, F); }
    }
    SEAM(10);
    if (IN(11)) { const Params p = fresh_params(); const Frame F = make_frame(lds_raw); p6c_prep_out(p, F); }
    SEAM(11);
    if (IN(12)) {
        const Params p = fresh_params(); const Frame F = make_frame(lds_raw); unsigned char* ws = p.ws;
        {
            pg8::Gemm g{(const bf16_t*)(ws + WS_A2), (const bf16_t*)(ws + WS_WTOUTC), INNER, INNER, INNER};
            pg8::StaticOrder<0> S; S.init(MMAIN, D, F.G, F.bid);
            EpiAddHB E{(bf16_t*)(ws + WS_H)};
            pg8::gemm_phase(ldsl, g, S, E);
        }
        {
            pg8::Gemm g{(const bf16_t*)(ws + WS_A2), (const bf16_t*)(ws + WS_WTOUTC), INNER, INNER, 256};
            pg8::TailOrder S; S.init(8, 256, F.G, (F.bid + 128) % F.G);
            EpiPart E{(float*)(ws + WS_PART), 256};
            pg8::gemm_phase(ldsl, g, S, E);
        }
    }
    SEAM(12);
    if (IN(13)) { const Params p = fresh_params(); const Frame F = make_frame(lds_raw); p8_final_norm(p, F); }
#undef IN
#undef SEAM
}

#ifndef MK_ONE_LAUNCH
#define MK_ONE_LAUNCH 1
#endif

extern "C" void kernel_launch(void* const* d_in, const int* in_sizes, int n_in, void* d_out, int out_size, void* d_ws, size_t ws_size, hipStream_t stream) {
    static int grid = 0;
    if (grid == 0) {
        if (n_in != 28 || (size_t)out_size != O_END || ws_size < WS_END) {
            fprintf(stderr, "kernel_launch: unexpected shapes: n_in %d out %d (want %zu) ws %zu (want >= %zu)\n", n_in, out_size, (size_t)O_END, ws_size, (size_t)WS_END);
            grid = -1; return;
        }
        int dev = 0, cus = 0, per_cu = 0;
        if (hipGetDevice(&dev) != hipSuccess || hipDeviceGetAttribute(&cus, hipDeviceAttributeMultiprocessorCount, dev) != hipSuccess) { grid = -1; return; }
        if (hipFuncSetAttribute((const void*)fwd_kernel, hipFuncAttributeMaxDynamicSharedMemorySize, LDS_BYTES) != hipSuccess) { fprintf(stderr, "kernel_launch: hipFuncSetAttribute failed\n"); grid = -1; return; }
        if (hipOccupancyMaxActiveBlocksPerMultiprocessor(&per_cu, (const void*)fwd_kernel, NTHREADS, LDS_BYTES) != hipSuccess || per_cu < 1)
            fprintf(stderr, "kernel_launch: occupancy query reports %d workgroups per CU\n", per_cu);
        (void)hipGetLastError();
        grid = cus;
    }
    if (grid < 0) return;
    (void)hipMemsetAsync((char*)d_ws + WS_CTL, 0, 65536, stream);
    Params p{};
    for (int i = 0; i < 28; ++i) p.in[i] = (const float*)d_in[i];
    p.out = (float*)d_out; p.ws = (unsigned char*)d_ws;
#if MK_ONE_LAUNCH
    p.ph_lo = 0; p.ph_hi = NPHASE;
    hipLaunchKernelGGL(fwd_kernel, dim3(grid), dim3(NTHREADS), LDS_BYTES, stream, p);
#else
    for (int k = 0; k < NPHASE; ++k) { p.ph_lo = k; p.ph_hi = k + 1; hipLaunchKernelGGL(fwd_kernel, dim3(grid), dim3(NTHREADS), LDS_BYTES, stream, p); }
#endif
}
```

```cpp
#include <hip/hip_runtime.h>
#include <cstdio>
#include <cstdint>

#define LAS __attribute__((address_space(3)))
#define DI __device__ __forceinline__

typedef unsigned short bf16_t;
typedef short bf16x8 __attribute__((ext_vector_type(8)));
typedef short bf16x4 __attribute__((ext_vector_type(4)));
typedef float f32x4 __attribute__((ext_vector_type(4)));
typedef float f32x2 __attribute__((ext_vector_type(2)));
typedef float f32x16 __attribute__((ext_vector_type(16)));
typedef unsigned u32x4 __attribute__((ext_vector_type(4)));
typedef unsigned u32x2 __attribute__((ext_vector_type(2)));
typedef __bf16 bf16v2 __attribute__((ext_vector_type(2)));

constexpr int D = 1024, BP = 8, SEQ = 2048, NMETA = 16, LP = NMETA + SEQ  , MP = BP * LP  ;
constexpr int BS = 128, TS = 4, MS = BS * TS  , MT = MP + MS  , MPAD = 17152  ;
constexpr int WA = 512, HA = 8, DHA = 64, WB = 512, NG = 4, GC = 128, PMAX = 16;
constexpr int INNER = 2048, HC = 4, DHC = 512, NCH = 17;
constexpr int NPAGES = 16, PAGE = 128, NPOOL = 2560;
constexpr int LPV = 2112;
constexpr int NA = 3072, NC = 4104;
constexpr float EPS = 1e-6f;
constexpr int NSEQ = BP * HC + BS * HC;

constexpr size_t O_YP = 0;
constexpr size_t O_YS = O_YP + (size_t)BP * SEQ * D;
constexpr size_t O_KP = O_YS + (size_t)MS * D;
constexpr size_t O_VP = O_KP + (size_t)MP * WA;
constexpr size_t O_KS = O_VP + (size_t)MP * WA;
constexpr size_t O_VS = O_KS + (size_t)MS * WA;
constexpr size_t O_POOLP = O_VS + (size_t)MS * WA;
constexpr size_t O_POOLS = O_POOLP + (size_t)BP * 15 * WB;
constexpr size_t O_CP = O_POOLS + (size_t)BS * 15 * WB;
constexpr size_t O_CS = O_CP + (size_t)BP * HC * DHC * DHC;
constexpr size_t O_NP = O_CS + (size_t)BS * HC * DHC * DHC;
constexpr size_t O_NS = O_NP + (size_t)BP * HC * DHC;
constexpr size_t O_MP = O_NS + (size_t)BS * HC * DHC;
constexpr size_t O_MS = O_MP + (size_t)BP * HC;
constexpr size_t O_CVP = O_MS + (size_t)BS * HC;
constexpr size_t O_CVS = O_CVP + (size_t)BP * 3 * INNER;
constexpr size_t O_END = O_CVS + (size_t)BS * 3 * INNER;

constexpr size_t al256(size_t x) { return (x + 255) & ~(size_t)255; }
constexpr size_t WS_CTL = 0;
constexpr size_t WS_H = 65536;
constexpr size_t WS_XN = al256(WS_H + (size_t)MPAD * D * 2);
constexpr size_t WS_WTINA = al256(WS_XN + (size_t)MPAD * D * 2);
constexpr size_t WS_WTOUTA = al256(WS_WTINA + (size_t)NA * D * 2);
constexpr size_t WS_WTPOOL = al256(WS_WTOUTA + (size_t)D * D * 2);
constexpr size_t WS_WTINC = al256(WS_WTPOOL + (size_t)NG * GC * GC * 2);
constexpr size_t WS_WG = al256(WS_WTINC + (size_t)4096 * D * 2);
constexpr size_t WS_WTQ = al256(WS_WG + (size_t)8 * D * 4);
constexpr size_t WS_WTK = WS_WTQ + (size_t)HC * DHC * DHC * 2;
constexpr size_t WS_WTV = al256(WS_WTK + (size_t)HC * DHC * DHC * 2);
constexpr size_t WS_WTOUTC = al256(WS_WTV + (size_t)HC * DHC * DHC * 2);
constexpr size_t WS_PROJA = al256(WS_WTOUTC + (size_t)D * INNER * 2);
constexpr size_t WS_U32 = al256(WS_PROJA + (size_t)MPAD * NA * 2);
constexpr size_t WS_VTA = al256(WS_U32 + (size_t)MPAD * WB * 4);
constexpr size_t WS_MIXED = al256(WS_VTA + (size_t)BP * WA * LPV * 2);
constexpr size_t WS_SPART = al256(WS_MIXED + (size_t)MPAD * D * 2);
constexpr size_t WS_ST = al256(WS_SPART + (size_t)BS * NPAGES * HA * TS * DHA * 4);
constexpr size_t WS_LOGI = al256(WS_ST + (size_t)BS * NPAGES * 32 * 4);
constexpr size_t WS_LOGF = al256(WS_LOGI + (size_t)MPAD * 4 * 4);
constexpr size_t WS_SA = al256(WS_LOGF + (size_t)MPAD * 4 * 4);
constexpr size_t WS_SM = al256(WS_SA + (size_t)MPAD * 4 * 4);
constexpr size_t WS_SB = al256(WS_SM + (size_t)MPAD * 4 * 4);
constexpr size_t WS_MPREV = al256(WS_SB + (size_t)MPAD * 4 * 4);
constexpr size_t WS_MTOP = al256(WS_MPREV + (size_t)(32 * NCH + 512) * 4);
constexpr size_t WS_XMZ = al256(WS_MTOP + (size_t)(32 * NCH + 512) * 4);
constexpr size_t WS_CA = al256(WS_XMZ + (size_t)MPAD * 4096 * 2);
constexpr size_t WS_QC = al256(WS_CA + (size_t)MPAD * INNER * 2);
constexpr size_t WS_KC = al256(WS_QC + (size_t)MPAD * INNER * 2);
constexpr size_t WS_KTC = al256(WS_KC + (size_t)MPAD * INNER * 2);
constexpr size_t WS_VTC = al256(WS_KTC + (size_t)32 * 17 * 65536 * 2);
constexpr size_t WS_SD = al256(WS_VTC + (size_t)MPAD * INNER * 2);
constexpr size_t WS_RS = al256(WS_SD + (size_t)32 * NCH * 128 * 128 * 2);
constexpr size_t WS_DN = al256(WS_RS + (size_t)32 * NCH * 128 * 4);
constexpr size_t WS_HH = al256(WS_DN + (size_t)32 * NCH * 512 * 4);
constexpr size_t WS_A2 = al256(WS_HH + (size_t)MPAD * INNER * 2);
constexpr size_t WS_PART = al256(WS_A2 + (size_t)MPAD * INNER * 2);
constexpr size_t WS_QF = al256(WS_PART + (size_t)8 * 768 * D * 4);
constexpr size_t WS_END = al256(WS_QF + (size_t)32 * 17 * 65536 * 2);

constexpr int MMAIN = 16384;
constexpr int LDS_BYTES = 147456;
constexpr int LDS_CTL_OFF = 147456 - 256;
constexpr int NTHREADS = 512;

struct Params {
    const float* in[28];
    float* out;
    unsigned char* ws;
    int ph_lo, ph_hi;
};

DI unsigned pk2(float a, float b) { bf16v2 v = __builtin_convertvector((f32x2){a, b}, bf16v2); return __builtin_bit_cast(unsigned, v); }
DI bf16_t f2bf(float a) { return (bf16_t)(pk2(a, 0.f) & 0xffffu); }
DI float bf2f(bf16_t v) { return __uint_as_float(((unsigned)v) << 16); }
DI float bflo(unsigned w) { return __uint_as_float(w << 16); }
DI float bfhi(unsigned w) { return __uint_as_float(w & 0xffff0000u); }
DI float wave_sum_bperm(float v) {
#pragma unroll
    for (int o = 32; o > 0; o >>= 1) v += __shfl_xor(v, o);
    return v;
}
template <int CTRL> DI float dpp_mov_f(float v) { return __builtin_bit_cast(float, __builtin_amdgcn_update_dpp(0, __builtin_bit_cast(int, v), CTRL, 0xF, 0xF, false)); }
template <int CTRL> DI float dpp_shl_zero(float v) { return __builtin_bit_cast(float, __builtin_amdgcn_update_dpp(0, __builtin_bit_cast(int, v), CTRL, 0xF, 0xF, true)); }
DI float row16_sum(float v) { v += dpp_mov_f<0x128>(v); v += dpp_mov_f<0x124>(v); v += dpp_mov_f<0x122>(v); v += dpp_mov_f<0x121>(v); return v; }
template <int CTRL, int RMASK> DI float dpp_old_f(float old, float v) { return __builtin_bit_cast(float, __builtin_amdgcn_update_dpp(__builtin_bit_cast(int, old), __builtin_bit_cast(int, v), CTRL, RMASK, 0xF, false)); }
DI float wave_scan_add(float v) {
    v += dpp_old_f<0x111, 0xF>(0.f, v); v += dpp_old_f<0x112, 0xF>(0.f, v); v += dpp_old_f<0x114, 0xF>(0.f, v); v += dpp_old_f<0x118, 0xF>(0.f, v);
    v += dpp_old_f<0x142, 0xA>(0.f, v); v += dpp_old_f<0x143, 0xC>(0.f, v);
    return v;
}
DI float wave_scan_max(float v) {
    const float ninf = -INFINITY;
    v = fmaxf(v, dpp_old_f<0x111, 0xF>(ninf, v)); v = fmaxf(v, dpp_old_f<0x112, 0xF>(ninf, v)); v = fmaxf(v, dpp_old_f<0x114, 0xF>(ninf, v)); v = fmaxf(v, dpp_old_f<0x118, 0xF>(ninf, v));
    v = fmaxf(v, dpp_old_f<0x142, 0xA>(ninf, v)); v = fmaxf(v, dpp_old_f<0x143, 0xC>(ninf, v));
    return v;
}
DI float wave_sum(float v) { v = row16_sum(v); v += __shfl_xor(v, 16); v += __shfl_xor(v, 32); return v; }
DI float softplus_f(float z) {
    const float t = __expf(-fabsf(z));
    const float l = (t < 0.02f) ? t * (1.f - t * (0.5f - t * (0.33333333f - 0.25f * t))) : __logf(1.f + t);
    return fmaxf(z, 0.f) + l;
}
DI float silu_f(float x) { return x / (1.f + __expf(-x)); }
DI bf16x8 pack8(const f32x16& x, int s) {
    u32x4 p;
    p.x = pk2(x[8 * s + 0], x[8 * s + 1]); p.y = pk2(x[8 * s + 2], x[8 * s + 3]); p.z = pk2(x[8 * s + 4], x[8 * s + 5]); p.w = pk2(x[8 * s + 6], x[8 * s + 7]);
    return __builtin_bit_cast(bf16x8, p);
}
DI bf16x8 cat4(bf16x4 a, bf16x4 b) { return __builtin_shufflevector(a, b, 0, 1, 2, 3, 4, 5, 6, 7); }
#define MFMA32(a, b, c) __builtin_amdgcn_mfma_f32_32x32x16_bf16((a), (b), (c), 0, 0, 0)
DI f32x16 zero16() { f32x16 z;
#pragma unroll
    for (int i = 0; i < 16; ++i) z[i] = 0.f;
    return z; }
DI int crow(int reg, int h) { return (reg & 3) + 8 * (reg >> 2) + 4 * h; }

#define XB_TMO      128
#define XB_XCNT(j)  (256  + 64 * (j))
#define XB_XSUB(j)  (1280 + 64 * (j))
#define XB_XGEN(j)  (2304 + 64 * (j))
#define XB_TOP      3328
#define XB_TOPGEN   3392
#define XCD_BAR_WORDS 3456
#define XB_SPIN_CAP (1u << 18)

__device__ __forceinline__ unsigned xb_ld(unsigned* p)              { return __hip_atomic_load(p, __ATOMIC_RELAXED, __HIP_MEMORY_SCOPE_AGENT); }
__device__ __forceinline__ unsigned xb_add(unsigned* p, unsigned v) { return __hip_atomic_fetch_add(p, v, __ATOMIC_RELAXED, __HIP_MEMORY_SCOPE_AGENT); }
__device__ __forceinline__ unsigned xb_xcc_id() { return (unsigned)__builtin_amdgcn_s_getreg((3 << 11) | 20) & 0xFu; }
#define XB_SPIN(cond, bar) do { unsigned _sp = 0; while (cond) { __builtin_amdgcn_s_sleep(1); \
    if ((++_sp & 255u) == 0u) { if (xb_ld(&(bar)[XB_TMO])) break; if (_sp > XB_SPIN_CAP) { atomicAdd(&(bar)[XB_TMO], 1u); break; } } } } while (0)

struct XcdBarrier { unsigned* bar; unsigned x; volatile LAS unsigned* st; };

__device__ __forceinline__ XcdBarrier xcd_barrier_post(unsigned* bar, volatile LAS unsigned* st) {
    XcdBarrier b; b.bar = bar; b.x = xb_xcc_id(); b.st = st;
    if (threadIdx.x == 0) (void)xb_add(&bar[XB_XCNT(b.x)], 1u);
    return b;
}
__device__ __forceinline__ void xcd_barrier_complete(unsigned* bar, unsigned x, unsigned& nloc, unsigned& nx) {
    const unsigned G = gridDim.x * gridDim.y * gridDim.z;
    unsigned sum, cnt, mine, sp = 0u;
    for (;;) {
        sum = 0u; cnt = 0u; mine = 0u;
#pragma unroll
        for (unsigned j = 0; j < 16; ++j) { const unsigned c = xb_ld(&bar[XB_XCNT(j)]); sum += c; cnt += (c > 0u) ? 1u : 0u; mine = (j == x) ? c : mine; }
        if (sum == G) break;
        __builtin_amdgcn_s_sleep(1);
        if ((++sp & 255u) == 0u) { if (xb_ld(&bar[XB_TMO])) break; if (sp > XB_SPIN_CAP) { atomicAdd(&bar[XB_TMO], 1u); break; } }
    }
    nloc = mine > 0u ? mine : 1u; nx = cnt > 0u ? cnt : 1u;
}
__device__ __forceinline__ void xcd_barrier(const XcdBarrier& b) {
    asm volatile("s_waitcnt vmcnt(0)" ::: "memory");
    __syncthreads();
    if (threadIdx.x == 0) {
        unsigned* bar = b.bar;
        __builtin_amdgcn_s_waitcnt(0);
        unsigned nloc = b.st[0], nx = b.st[1];
        if (nloc == 0u) { xcd_barrier_complete(bar, b.x, nloc, nx); b.st[0] = nloc; b.st[1] = nx; }
        const unsigned old = xb_add(&bar[XB_XSUB(b.x)], 1u);
        const unsigned gen = old / nloc;
        if (old + 1u == (gen + 1u) * nloc) {
            __builtin_amdgcn_fence(__ATOMIC_RELEASE, "agent");
            asm volatile("s_waitcnt vmcnt(0)" ::: "memory");
            const unsigned og = xb_add(&bar[XB_TOP], 1u);
            const unsigned tg = og / nx;
            if (og + 1u == (tg + 1u) * nx) xb_add(&bar[XB_TOPGEN], 1u);
            else XB_SPIN(xb_ld(&bar[XB_TOPGEN]) == tg, bar);
            __builtin_amdgcn_fence(__ATOMIC_ACQUIRE, "agent");
            xb_add(&bar[XB_XGEN(b.x)], 1u);
            asm volatile("s_waitcnt vmcnt(0)" ::: "memory");
        } else {
            XB_SPIN(xb_ld(&bar[XB_XGEN(b.x)]) == gen, bar);
            __builtin_amdgcn_fence(__ATOMIC_ACQUIRE, "agent");
            asm volatile("s_waitcnt vmcnt(0)" ::: "memory");
        }
    }
    __syncthreads();
}

namespace pg8 {
constexpr int BM = 256, BK = 64, HALF = 128, HTB = HALF * BK * 2, STAGE_BYTES = 8 * HTB, NXCD = 8, WGM = 8;
__host__ __device__ __forceinline__ int lds_byte(int r, int c) { const int st = (r >> 4) * 2 + (c >> 5), rr = r & 15, cc = c & 31, ob = rr * 64 + cc * 2; return st * 1024 + (ob ^ (((ob >> 9) & 1) << 5)); }
__host__ __device__ __forceinline__ void stage_rc(int b, int& R, int& C) { const int st = b / 1024, sb = b % 1024, swz = sb ^ (((sb >> 9) & 1) << 5); R = (st >> 1) * 16 + swz / 64; C = (st & 1) * 32 + (swz % 64) / 2; }
__host__ __device__ __forceinline__ int perm32(int rho) { const int n = rho >> 4, i = rho & 15; return 8 * (i >> 2) + 4 * n + (i & 3); }

struct Unit { int pm, pn, aoff, boff; };
struct Gemm { const bf16_t* A; const bf16_t* Bt; int lda, ldb, K; };

template <int OFFK> struct StaticOrder {
    int nM, nN, nwg, G, c;
    __device__ void init(int M, int N, int G_, int c_) { nM = M / BM; nN = N / BM; nwg = nM * nN; G = G_; c = c_; }
    __device__ bool next(int i, Unit& u) const {
        const long L = (long)i * G + c; if (L >= nwg) return false;
        int wgid = (int)L; { const int q = nwg / NXCD, r = nwg % NXCD, xcd = wgid % NXCD, off = wgid / NXCD; wgid = (xcd < r ? xcd * (q + 1) : r * (q + 1) + (xcd - r) * q) + off; }
        const int nig = WGM * nN, gid = wgid / nig, fm = gid * WGM, gsz = (nM - fm) < WGM ? (nM - fm) : WGM;
        u.pm = fm + ((wgid % nig) % gsz); u.pn = (wgid % nig) / gsz;
        u.aoff = (OFFK == 1) ? ((u.pn >> 1) & 3) * 512 : 0; u.boff = (OFFK == 2) ? (u.pm >> 1) * 512 : 0;
        return true;
    }
};

__device__ __forceinline__ void so_map(int L, int nM, int nN, Unit& u) {
    const int nwg = nM * nN;
    int wgid = L; { const int q = nwg / NXCD, r = nwg % NXCD, xcd = wgid % NXCD, off = wgid / NXCD; wgid = (xcd < r ? xcd * (q + 1) : r * (q + 1) + (xcd - r) * q) + off; }
    const int nig = WGM * nN, gid = wgid / nig, fm = gid * WGM, gsz = (nM - fm) < WGM ? (nM - fm) : WGM;
    u.pm = fm + ((wgid % nig) % gsz); u.pn = (wgid % nig) / gsz;
}
struct InAOrder {
    int G, b;
    __device__ static void light(int idx, Unit& u) { so_map(idx, 67, 8, u); u.pn = (u.pn < 2) ? u.pn : u.pn + 4; }
    __device__ static void heavy(int idx, Unit& u) { so_map(idx, 67, 4, u); u.pn += 2; }
    __device__ bool next(int i, Unit& u) const {
        u.aoff = 0; u.boff = 0;
        if (G != 256) { const long LL = (long)i * G + b; if (LL >= 804) return false; so_map((int)LL, 67, 12, u); return true; }
        if (i == 0) { if (b < 36) light(b, u); else heavy(b - 36, u); return true; }
        if (i == 1) { if (b < 36) light(36 + b, u); else if (b < 84) heavy(220 + (b - 36), u); else light(72 + (b - 84), u); return true; }
        if (i == 2) { if (b < 36) light(244 + b, u); else light(280 + (b - 36), u); return true; }
        if (i == 3 && b < 36) { light(500 + b, u); return true; }
        return false;
    }
};
struct InCMainOrder {
    int G, b;
    __device__ bool next(int i, Unit& u) const {
        int L;
        if (G == 256) { if (i < 3) L = i * 256 + b; else if (i == 3 && !(b >= 64 && b < 68)) L = 768 + (b < 64 ? b : b - 4); else return false; }
        else { const long LL = (long)i * G + b; if (LL >= 1020) return false; L = (int)LL; }
        if (L < 960) so_map(L, 60, 16, u);
        else if (L < 972) { u.pm = 60; u.pn = L - 960; }
        else { const int j = L - 972; u.pm = 61 + j % 6; u.pn = j / 6; }
        u.aoff = 0; u.boff = 0;
        return true;
    }
};
struct InCTailOrder {
    int G, b;
    __device__ bool next(int i, Unit& u) const {
        const long LL = (long)i * G + (b + 52) % G; if (LL >= 52) return false;
        const int j = (int)LL;
        if (j < 48) { u.pm = 61 + j % 6; u.pn = 8 + j / 6; } else { u.pm = 60; u.pn = 12 + (j - 48); }
        u.aoff = 0; u.boff = 0;
        return true;
    }
};
struct VtOrder {
    int G, b;
    __device__ bool next(int i, Unit& u) const {
        int L;
        if (G == 256) { if (i == 0) L = b; else if (i == 1 && b < 204) L = 256 + b; else if (i == 2 && b >= 48 && b < 124) L = 460 + (b - 48); else return false; }
        else { const long LL = (long)i * G + (b + 48) % G; if (LL >= 536) return false; L = (int)LL; }
        so_map(L, 8, 67, u);
        u.aoff = 0; u.boff = (u.pm >> 1) * 512;
        return true;
    }
};

struct TailOrder {
    int nks, ksl, G, c;
    __device__ void init(int nks_, int ksl_, int G_, int c_) { nks = nks_; ksl = ksl_; G = G_; c = c_; }
    __device__ bool next(int i, Unit& u) const {
        const int L = i * G + c; if (L >= 12 * nks) return false;
        const int ks = L % nks, t = L / nks;
        u.pm = 64 + (t >> 2); u.pn = t & 3; u.aoff = ks * ksl; u.boff = ks * ksl;
        return true;
    }
};

template <class Epi, class Sched>
__device__ __forceinline__ void gemm_phase(LAS unsigned char* lds, const Gemm g, const Sched& S, const Epi& E) {
    const int tid = threadIdx.x, wid = __builtin_amdgcn_readfirstlane(tid >> 6), lane = tid & 63, wr = wid >> 2, wc = wid & 3, fr = lane & 15, fq = lane >> 4;
    const int K = g.K, nt = K / BK;
    unsigned voffA[2], voffB[2];
#pragma unroll
    for (int i = 0; i < 2; ++i) { int R, C; stage_rc(tid * 16 + i * 8192, R, C); const int Rb = Epi::PERM ? ((R & ~31) + perm32(R & 31)) : R;
        voffA[i] = (unsigned)(R * g.lda + C) * 2u; voffB[i] = (unsigned)(Rb * g.ldb + C) * 2u; }
    const size_t kstep = (size_t)(BK * 2);
    const size_t hsA = (size_t)HALF * g.lda * 2, hsB = (size_t)HALF * g.ldb * 2;
    const size_t tsA = 2 * hsA, tsB = 2 * hsB;
    const unsigned ldsw = (unsigned)wid * 1024u;
    const int aoff = lds_byte(wr * 64 + fr, fq * 8), boff = lds_byte(wc * 32 + fr, fq * 8);
#define PG8_SA(b, h) (((b) * 2 + (h)) * HTB)
#define PG8_SB(b, h) ((4 + (b) * 2 + (h)) * HTB)
#define PG8_STAGE(bufoff, gbase, voff) do { _Pragma("unroll") for (int _i = 0; _i < 2; ++_i) \
        __builtin_amdgcn_global_load_lds((const unsigned*)((const char*)(gbase) + (voff)[_i]), (LAS unsigned*)(lds + (bufoff) + ldsw + _i * 8192), 16, 0, 0); } while (0)
#define PG8_LDA(dst, b, h) do { _Pragma("unroll") for (int m = 0; m < 4; ++m) _Pragma("unroll") for (int k = 0; k < 2; ++k) dst[m][k] = *(const LAS bf16x8*)(lds + PG8_SA(b, h) + aoff + m * 2048 + k * 1024); } while (0)
#define PG8_LDB(dst, b, h) do { _Pragma("unroll") for (int n = 0; n < 2; ++n) _Pragma("unroll") for (int k = 0; k < 2; ++k) dst[n][k] = *(const LAS bf16x8*)(lds + PG8_SB(b, h) + boff + n * 2048 + k * 1024); } while (0)
#define PG8_MMA(ai, bj, At, Bt) do { __builtin_amdgcn_s_setprio(1); _Pragma("unroll") for (int m = 0; m < 4; ++m) _Pragma("unroll") for (int n = 0; n < 2; ++n) _Pragma("unroll") for (int k = 0; k < 2; ++k) \
        acc[ai][bj][m][n] = __builtin_amdgcn_mfma_f32_16x16x32_bf16(Bt[n][k], At[m][k], acc[ai][bj][m][n], 0, 0, 0); __builtin_amdgcn_s_setprio(0); } while (0)
#define PG8_WAIT_V(n) asm volatile("s_waitcnt vmcnt(" #n ")" ::: "memory")
#define PG8_WAIT_L(n) asm volatile("s_waitcnt lgkmcnt(" #n ")" ::: "memory")
#define PG8_BAR __builtin_amdgcn_s_barrier()
#define PG8_SCHED __builtin_amdgcn_sched_barrier(0)
    Unit cur, nxt; int ui = 0;
    if (!S.next(0, cur)) return;
    f32x4 acc[2][2][4][2];
#pragma unroll
    for (int a = 0; a < 2; ++a)
#pragma unroll
        for (int b = 0; b < 2; ++b)
#pragma unroll
            for (int m = 0; m < 4; ++m)
#pragma unroll
                for (int n = 0; n < 2; ++n) acc[a][b][m][n] = (f32x4){0.f, 0.f, 0.f, 0.f};
    bf16x8 At[4][2], B0[2][2], B1[2][2];
    const char* cA = (const char*)g.A + (size_t)cur.pm * tsA + (size_t)cur.aoff * 2; const char* cB = (const char*)g.Bt + (size_t)cur.pn * tsB + (size_t)cur.boff * 2;
    PG8_STAGE(PG8_SB(0, 0), cB, voffB); PG8_STAGE(PG8_SA(0, 0), cA, voffA); PG8_STAGE(PG8_SB(0, 1), cB + hsB, voffB); PG8_STAGE(PG8_SA(0, 1), cA + hsA, voffA);
    if (wr == 1) PG8_BAR;
    PG8_WAIT_V(4); PG8_BAR;
    PG8_STAGE(PG8_SB(1, 0), cB + kstep, voffB); PG8_STAGE(PG8_SA(1, 0), cA + kstep, voffA); PG8_STAGE(PG8_SB(1, 1), cB + hsB + kstep, voffB);
    PG8_WAIT_V(6); PG8_BAR;
    for (;;) {
        const bool has_next = S.next(ui + 1, nxt);
        const char* nA = has_next ? (const char*)g.A + (size_t)nxt.pm * tsA + (size_t)nxt.aoff * 2 : cA; const char* nB = has_next ? (const char*)g.Bt + (size_t)nxt.pn * tsB + (size_t)nxt.boff * 2 : cB;
        for (int t = 0; t < nt; t += 2) {
            const bool last = (t == nt - 2);
            const char* a1 = cA + (size_t)(t + 1) * kstep;
            const char* a2 = last ? nA : cA + (size_t)(t + 2) * kstep; const char* b2 = last ? nB : cB + (size_t)(t + 2) * kstep;
            const char* a3 = a2 + kstep; const char* b3 = b2 + kstep;
            PG8_LDB(B0, 0, 0); PG8_SCHED; PG8_LDA(At, 0, 0); PG8_STAGE(PG8_SA(1, 1), a1 + hsA, voffA);
            PG8_WAIT_L(8); PG8_BAR; PG8_WAIT_L(0); PG8_MMA(0, 0, At, B0); PG8_BAR; PG8_SCHED;
            PG8_LDB(B1, 0, 1); PG8_STAGE(PG8_SB(0, 0), b2, voffB);
            PG8_BAR; PG8_WAIT_L(0); PG8_MMA(0, 1, At, B1); PG8_BAR;
            PG8_LDA(At, 0, 1); PG8_STAGE(PG8_SA(0, 0), a2, voffA);
            PG8_BAR; PG8_WAIT_L(0); PG8_MMA(1, 0, At, B0); PG8_BAR; PG8_SCHED;
            PG8_STAGE(PG8_SB(0, 1), b2 + hsB, voffB);
            PG8_WAIT_V(6); PG8_BAR; PG8_MMA(1, 1, At, B1); PG8_BAR;
            PG8_LDB(B0, 1, 0); PG8_SCHED; PG8_LDA(At, 1, 0); PG8_STAGE(PG8_SA(0, 1), a2 + hsA, voffA);
            PG8_WAIT_L(8); PG8_BAR; PG8_WAIT_L(0); PG8_MMA(0, 0, At, B0); PG8_BAR; PG8_SCHED;
            PG8_LDB(B1, 1, 1); PG8_STAGE(PG8_SB(1, 0), b3, voffB);
            PG8_BAR; PG8_WAIT_L(0); PG8_MMA(0, 1, At, B1); PG8_BAR;
            PG8_LDA(At, 1, 1); PG8_STAGE(PG8_SA(1, 0), a3, voffA);
            PG8_BAR; PG8_WAIT_L(0); PG8_MMA(1, 0, At, B0); PG8_BAR; PG8_SCHED;
            PG8_STAGE(PG8_SB(1, 1), b3 + hsB, voffB);
            PG8_WAIT_V(6); PG8_BAR; PG8_MMA(1, 1, At, B1); PG8_BAR;
        }
        E(acc, cur, wr, wc, fr, fq);
        if (!has_next) break;
#pragma unroll
        for (int a = 0; a < 2; ++a)
#pragma unroll
            for (int b = 0; b < 2; ++b)
#pragma unroll
                for (int m = 0; m < 4; ++m)
#pragma unroll
                    for (int n = 0; n < 2; ++n) acc[a][b][m][n] = (f32x4){0.f, 0.f, 0.f, 0.f};
        cur = nxt; cA = nA; cB = nB; ++ui;
    }
    PG8_WAIT_V(0);
    if (wr == 0) PG8_BAR;
    PG8_BAR;
#undef PG8_SA
#undef PG8_SB
#undef PG8_STAGE
#undef PG8_LDA
#undef PG8_LDB
#undef PG8_MMA
#undef PG8_WAIT_V
#undef PG8_WAIT_L
#undef PG8_BAR
#undef PG8_SCHED
}
}

using pg8::Unit;
typedef f32x4 AccT[2][2][4][2];

DI u32x4 pack_row8(const f32x4& v0, const f32x4& v1) { u32x4 w; w.x = pk2(v0[0], v0[1]); w.y = pk2(v0[2], v0[3]); w.z = pk2(v1[0], v1[1]); w.w = pk2(v1[2], v1[3]); return w; }

struct EpiInA {
    static constexpr bool PERM = true;
    bf16_t* proja; float* u32; float* out; bf16_t* vta;
    DI void operator()(const AccT& acc, const Unit& u, int wr, int wc, int fr, int fq) const {
        const int region = u.pn >> 1;
#pragma unroll
        for (int ai = 0; ai < 2; ++ai)
#pragma unroll
            for (int m = 0; m < 4; ++m) {
                const int row = u.pm * 256 + ai * 128 + wr * 64 + m * 16 + fr;
#pragma unroll
                for (int bj = 0; bj < 2; ++bj) {
                    const int col = u.pn * 256 + bj * 128 + wc * 32 + 8 * fq;
                    const f32x4 v0 = acc[ai][bj][m][0], v1 = acc[ai][bj][m][1];
                    *(u32x4*)(proja + (size_t)row * NA + col) = pack_row8(v0, v1);
                    if (region == 1 || region == 2) {
                        const int cc = col - region * 512;
                        float* dst = nullptr;
                        if (row < MP) dst = out + (region == 1 ? O_KP : O_VP) + (size_t)row * WA + cc;
                        else if (row < MT) dst = out + (region == 1 ? O_KS : O_VS) + (size_t)(row - MP) * WA + cc;
                        if (dst) { *(f32x4*)dst = v0; *(f32x4*)(dst + 4) = v1; }
                    }
                }
            }
    }
};

struct EpiPart {
    static constexpr bool PERM = false;
    float* part; int ksl;
    DI void operator()(const AccT& acc, const Unit& u, int wr, int wc, int fr, int fq) const {
        float* base = part + (size_t)(u.aoff / ksl) * 768 * D;
#pragma unroll
        for (int ai = 0; ai < 2; ++ai)
#pragma unroll
            for (int m = 0; m < 4; ++m) {
                const int row = u.pm * 256 + ai * 128 + wr * 64 + m * 16 + fr - MMAIN;
                float* rowp = base + (size_t)row * D + u.pn * 256 + wc * 32 + 4 * fq;
#pragma unroll
                for (int bj = 0; bj < 2; ++bj)
#pragma unroll
                    for (int n = 0; n < 2; ++n) *(f32x4*)(rowp + bj * 128 + n * 16) = acc[ai][bj][m][n];
            }
    }
};
struct EpiResX {
    static constexpr bool PERM = true;
    bf16_t* hb; const float* xp; const float* xs; const float* meta;
    DI void operator()(const AccT& acc, const Unit& u, int wr, int wc, int fr, int fq) const {
#pragma unroll
        for (int ai = 0; ai < 2; ++ai)
#pragma unroll
            for (int m = 0; m < 4; ++m) {
                const int row = u.pm * 256 + ai * 128 + wr * 64 + m * 16 + fr;
                const float* src = nullptr;
                if (row < MP) { const int b = row / LP, t = row - b * LP; src = (t < NMETA) ? meta + (size_t)t * D : xp + ((size_t)b * SEQ + (t - NMETA)) * D; }
                else if (row < MT) src = xs + (size_t)(row - MP) * D;
#pragma unroll
                for (int bj = 0; bj < 2; ++bj) {
                    const int col = u.pn * 256 + bj * 128 + wc * 32 + 8 * fq;
                    f32x4 v0 = acc[ai][bj][m][0], v1 = acc[ai][bj][m][1];
                    if (src) { v0 += *(const f32x4*)(src + col); v1 += *(const f32x4*)(src + col + 4); }
                    *(u32x4*)(hb + (size_t)row * D + col) = pack_row8(v0, v1);
                }
            }
    }
};
struct EpiAddHB {
    static constexpr bool PERM = true;
    bf16_t* hb;
    DI void operator()(const AccT& acc, const Unit& u, int wr, int wc, int fr, int fq) const {
#pragma unroll
        for (int ai = 0; ai < 2; ++ai)
#pragma unroll
            for (int m = 0; m < 4; ++m) {
                const int row = u.pm * 256 + ai * 128 + wr * 64 + m * 16 + fr;
#pragma unroll
                for (int bj = 0; bj < 2; ++bj) {
                    const int col = u.pn * 256 + bj * 128 + wc * 32 + 8 * fq;
                    u32x4* pp = (u32x4*)(hb + (size_t)row * D + col);
                    const u32x4 w = *pp;
                    const f32x4 v0 = acc[ai][bj][m][0] + (f32x4){bflo(w.x), bfhi(w.x), bflo(w.y), bfhi(w.y)};
                    const f32x4 v1 = acc[ai][bj][m][1] + (f32x4){bflo(w.z), bfhi(w.z), bflo(w.w), bfhi(w.w)};
                    *pp = pack_row8(v0, v1);
                }
            }
    }
};

struct EpiInC {
    static constexpr bool PERM = true;
    bf16_t* xmz; float* out;
    DI void operator()(const AccT& acc, const Unit& u, int wr, int wc, int fr, int fq) const {
#pragma unroll
        for (int ai = 0; ai < 2; ++ai)
#pragma unroll
            for (int m = 0; m < 4; ++m) {
                const int row = u.pm * 256 + ai * 128 + wr * 64 + m * 16 + fr;
                float* cdst = nullptr;
                if (u.pn < 8) {
                    if (row < MP) { const int b = row / LP, t = row - b * LP; if (t >= LP - 3) cdst = out + O_CVP + ((size_t)b * 3 + (t - (LP - 3))) * INNER; }
                    else if (row < MT) { const int sb = (row - MP) >> 2, i = (row - MP) & 3; if (i >= 1) cdst = out + O_CVS + ((size_t)sb * 3 + (i - 1)) * INNER; }
                }
#pragma unroll
                for (int bj = 0; bj < 2; ++bj) {
                    const int col = u.pn * 256 + bj * 128 + wc * 32 + 8 * fq;
                    const f32x4 v0 = acc[ai][bj][m][0], v1 = acc[ai][bj][m][1];
                    *(u32x4*)(xmz + (size_t)row * 4096 + col) = pack_row8(v0, v1);
                    if (cdst) { *(f32x4*)(cdst + col) = v0; *(f32x4*)(cdst + col + 4) = v1; }
                }
            }
    }
};

struct EpiQK {
    static constexpr bool PERM = true;
    bf16_t* qc; bf16_t* kc; bf16_t* ktc; bf16_t* qf;
    DI void operator()(const AccT& acc, const Unit& u, int wr, int wc, int fr, int fq) const {
        const bool isk = u.pn >= 8;
        bf16_t* base = isk ? kc : qc;
        const int colt = (u.pn & 7) * 256;
#pragma unroll
        for (int ai = 0; ai < 2; ++ai)
#pragma unroll
            for (int m = 0; m < 4; ++m) {
                const int row = u.pm * 256 + ai * 128 + wr * 64 + m * 16 + fr;
#pragma unroll
                for (int bj = 0; bj < 2; ++bj) {
                    const int col = colt + bj * 128 + wc * 32 + 8 * fq;
                    const u32x4 w = pack_row8(acc[ai][bj][m][0], acc[ai][bj][m][1]);
                    if (!isk && row < MP) {
                        const int b_ = row / LP, tl = row - b_ * LP;
                        const int c_ = (tl < NMETA) ? 0 : 1 + ((tl - NMETA) >> 7), pos = (tl < NMETA) ? tl : ((tl - NMETA) & 127);
                        const int hd = col >> 9, d_ = col & 511;
                        *(u32x4*)(qf + ((size_t)(((b_ * 4 + hd) * NCH + c_) * 8 + (pos >> 4)) * 16 + (d_ >> 5)) * 512 + (((d_ >> 3) & 3) * 16 + (pos & 15)) * 8) = w;
                    } else
                        *(u32x4*)(base + (size_t)row * INNER + col) = w;
                    if (isk && row < MP) {
                        const int b_ = row / LP, tl = row - b_ * LP;
                        const int c_ = (tl < NMETA) ? 0 : 1 + ((tl - NMETA) >> 7), pos = (tl < NMETA) ? tl : ((tl - NMETA) & 127);
                        const int hd = col >> 9, d_ = col & 511;
                        const int i_ = 8 * (pos >> 6) + 4 * ((d_ >> 5) & 1) + ((pos >> 3) & 3);
                        bf16_t* kt = ktc + ((size_t)(((b_ * 4 + hd) * NCH + c_) * 8 + (d_ >> 6)) * 16 + i_) * 512 + (32 * ((pos >> 5) & 1) + (d_ & 31)) * 8 + (pos & 7);
                        asm volatile("" : "+v"(kt));
                        kt[0] = (bf16_t)(w.x & 0xffffu); kt[8] = (bf16_t)(w.x >> 16); kt[16] = (bf16_t)(w.y & 0xffffu); kt[24] = (bf16_t)(w.y >> 16);
                        kt[32] = (bf16_t)(w.z & 0xffffu); kt[40] = (bf16_t)(w.z >> 16); kt[48] = (bf16_t)(w.w & 0xffffu); kt[56] = (bf16_t)(w.w >> 16);
                    }
                }
            }
    }
};

struct EpiPlain {
    static constexpr bool PERM = true;
    bf16_t* o; int ldc;
    DI void operator()(const AccT& acc, const Unit& u, int wr, int wc, int fr, int fq) const {
#pragma unroll
        for (int ai = 0; ai < 2; ++ai)
#pragma unroll
            for (int m = 0; m < 4; ++m) {
                const int row = u.pm * 256 + ai * 128 + wr * 64 + m * 16 + fr;
#pragma unroll
                for (int bj = 0; bj < 2; ++bj) {
                    const int col = u.pn * 256 + bj * 128 + wc * 32 + 8 * fq;
                    *(u32x4*)(o + (size_t)row * ldc + col) = pack_row8(acc[ai][bj][m][0], acc[ai][bj][m][1]);
                }
            }
    }
};

struct EpiVTs {
    static constexpr bool PERM = true;
    bf16_t* o; const float* sa; const float* mtop;
    DI void operator()(const AccT& acc, const Unit& u, int wr, int wc, int fr, int fq) const {
        const int h = u.pm >> 1;
        float w[2][8];
#pragma unroll
        for (int bj = 0; bj < 2; ++bj)
#pragma unroll
            for (int j = 0; j < 8; ++j) {
                const int r = u.pn * 256 + bj * 128 + wc * 32 + 8 * fq + j;
                float wv = 1.f;
                if (r < MP) { const int b = r / LP, t = r - b * LP; const int c = (t < NMETA) ? 0 : 1 + ((t - NMETA) >> 7); wv = __expf(sa[(size_t)r * 4 + h] - mtop[(b * 4 + h) * NCH + c]); }
                w[bj][j] = wv;
            }
#pragma unroll
        for (int ai = 0; ai < 2; ++ai)
#pragma unroll
            for (int m = 0; m < 4; ++m) {
                const int row = u.pm * 256 + ai * 128 + wr * 64 + m * 16 + fr;
#pragma unroll
                for (int bj = 0; bj < 2; ++bj) {
                    const int col = u.pn * 256 + bj * 128 + wc * 32 + 8 * fq;
                    const f32x4 a0 = acc[ai][bj][m][0], a1 = acc[ai][bj][m][1];
                    const f32x4 v0 = (f32x4){a0[0] * w[bj][0], a0[1] * w[bj][1], a0[2] * w[bj][2], a0[3] * w[bj][3]};
                    const f32x4 v1 = (f32x4){a1[0] * w[bj][4], a1[1] * w[bj][5], a1[2] * w[bj][6], a1[3] * w[bj][7]};
                    *(u32x4*)(o + (size_t)row * MPAD + col) = pack_row8(v0, v1);
                }
            }
    }
};

struct Frame {
    unsigned char* lds;
    int tid, lane, wave, G, bid;
};
DI Frame make_frame(unsigned char* lds) {
    Frame F; int t = threadIdx.x; asm volatile("" : "+v"(t));
    F.lds = lds; F.tid = t; F.lane = t & 63; F.wave = __builtin_amdgcn_readfirstlane(t >> 6); F.G = gridDim.x; F.bid = blockIdx.x;
    return F;
}

DI void tr_tile_wave(const float* src, int sld, bf16_t* dst, int dld, int k0, int n0, float scale, float* tile, int lane) {
    f32x4 v[16];
#pragma unroll
    for (int p = 0; p < 16; ++p) v[p] = *(const f32x4*)(src + (size_t)(k0 + p * 4 + (lane >> 4)) * sld + n0 + (lane & 15) * 4);
#pragma unroll
    for (int p = 0; p < 16; ++p) { float* t = tile + (p * 4 + (lane >> 4)) * 65 + (lane & 15) * 4; t[0] = v[p][0]; t[1] = v[p][1]; t[2] = v[p][2]; t[3] = v[p][3]; }
    __builtin_amdgcn_fence(__ATOMIC_RELEASE, "wavefront"); __builtin_amdgcn_wave_barrier(); __builtin_amdgcn_fence(__ATOMIC_ACQUIRE, "wavefront");
#pragma unroll
    for (int kc = 0; kc < 8; ++kc) {
        const float* t = tile + (kc * 8) * 65 + lane;
        u32x4 w;
        w.x = pk2(t[0] * scale, t[65] * scale); w.y = pk2(t[2 * 65] * scale, t[3 * 65] * scale); w.z = pk2(t[4 * 65] * scale, t[5 * 65] * scale); w.w = pk2(t[6 * 65] * scale, t[7 * 65] * scale);
        *(u32x4*)(dst + (size_t)(n0 + lane) * dld + k0 + kc * 8) = w;
    }
    __builtin_amdgcn_fence(__ATOMIC_RELEASE, "wavefront"); __builtin_amdgcn_wave_barrier(); __builtin_amdgcn_fence(__ATOMIC_ACQUIRE, "wavefront");
}

DI void p0_prologue(const Params& p, const Frame& F) {
    unsigned char* ws = p.ws;
    float* tile = (float*)F.lds + F.wave * (64 * 65);
    const float* wq_ = p.in[22]; const float* wk_ = p.in[23]; const float* wv_ = p.in[24];
    asm volatile("" : "+s"(wq_), "+s"(wk_), "+s"(wv_));
    const int gw = F.bid * 8 + F.wave, nw = F.G * 8, lane = F.lane;
    constexpr int T0 = 768, T1 = T0 + 256, T2 = T1 + 1024, T3 = T2 + 768, T4 = T3 + 512, T5 = T4 + 16;
    for (int ti = gw; ti < T5; ti += nw) {
        const float* src; int sld, dld, k0, n0; bf16_t* dst; float scale = 1.f;
        if (ti < T0) { const int j = ti; src = p.in[13]; sld = NA; dst = (bf16_t*)(ws + WS_WTINA); dld = D; k0 = (j / 48) * 64; n0 = (j % 48) * 64; }
        else if (ti < T1) { const int j = ti - T0; src = p.in[14]; sld = D; dst = (bf16_t*)(ws + WS_WTOUTA); dld = D; k0 = (j / 16) * 64; n0 = (j % 16) * 64; }
        else if (ti < T2) { const int j = ti - T1; src = p.in[18]; sld = NC; dst = (bf16_t*)(ws + WS_WTINC); dld = D; k0 = (j / 64) * 64; n0 = (j % 64) * 64; }
        else if (ti < T3) { const int j = ti - T2; const int mat = j / 64, t = j % 64, which = mat / 4, hd = mat % 4;
            src = (which == 0 ? wq_ : which == 1 ? wk_ : wv_) + (size_t)hd * DHC * DHC; sld = DHC;
            dst = (bf16_t*)(ws + (which == 0 ? WS_WTQ : which == 1 ? WS_WTK : WS_WTV)) + (size_t)hd * DHC * DHC; dld = DHC; k0 = (t / 8) * 64; n0 = (t % 8) * 64;
            if (which == 1) scale = 0.044194173824159216f; }
        else if (ti < T4) { const int j = ti - T3; src = p.in[27]; sld = D; dst = (bf16_t*)(ws + WS_WTOUTC); dld = INNER; k0 = (j / 16) * 64; n0 = (j % 16) * 64; }
        else { const int j = ti - T4; const int g = j / 4, t = j % 4; src = p.in[16] + (size_t)g * GC * GC; sld = GC; dst = (bf16_t*)(ws + WS_WTPOOL) + (size_t)g * GC * GC; dld = GC; k0 = (t / 2) * 64; n0 = (t % 2) * 64; }
        tr_tile_wave(src, sld, dst, dld, k0, n0, scale, tile, lane);
    }
    {
        float* wg = (float*)(ws + WS_WG);
        for (int i = F.bid * NTHREADS + F.tid; i < 8 * D; i += F.G * NTHREADS) { const int j = i / D, k = i % D; wg[i] = p.in[18][(size_t)k * NC + 4096 + j]; }
    }
    {
        bf16_t* XN = (bf16_t*)(ws + WS_XN);
        const float* g0 = p.in[11];
        constexpr int RB = 2;
        for (int r0 = gw * RB; r0 < MPAD; r0 += nw * RB) {
            f32x4 v[RB][4];
#pragma unroll
            for (int rr = 0; rr < RB; ++rr) {
                const int r = r0 + rr;
                if (r < MT) {
                    const float* src;
                    if (r < MP) { const int b = r / LP, t = r - b * LP; src = (t < NMETA) ? p.in[10] + (size_t)t * D : p.in[0] + ((size_t)b * SEQ + (t - NMETA)) * D; }
                    else src = p.in[1] + (size_t)(r - MP) * D;
#pragma unroll
                    for (int j = 0; j < 4; ++j) v[rr][j] = *(const f32x4*)(src + j * 256 + lane * 4);
                } else {
#pragma unroll
                    for (int j = 0; j < 4; ++j) v[rr][j] = (f32x4){0.f, 0.f, 0.f, 0.f};
                }
            }
#pragma unroll
            for (int rr = 0; rr < RB; ++rr) {
                const int r = r0 + rr;
                float ss = 0.f;
#pragma unroll
                for (int j = 0; j < 4; ++j) ss += v[rr][j][0] * v[rr][j][0] + v[rr][j][1] * v[rr][j][1] + v[rr][j][2] * v[rr][j][2] + v[rr][j][3] * v[rr][j][3];
                ss = wave_sum(ss);
                const float rstd = rsqrtf(ss * (1.f / D) + EPS);
#pragma unroll
                for (int j = 0; j < 4; ++j) {
                    const int c = j * 256 + lane * 4;
                    const f32x4 g = *(const f32x4*)(g0 + c);
                    u32x2 w; w.x = pk2(v[rr][j][0] * rstd * g[0], v[rr][j][1] * rstd * g[1]); w.y = pk2(v[rr][j][2] * rstd * g[2], v[rr][j][3] * rstd * g[3]);
                    *(u32x2*)(XN + (size_t)r * D + c) = w;
                }
            }
        }
    }
}

DI void attn_prompt_tile(const bf16_t* __restrict__ PA, const bf16_t* __restrict__ VTA, bf16_t* __restrict__ MIX, const float* __restrict__ sb_bias, int bh, int qt, int lane, int tmax) {
    const int b = bh >> 3, h = bh & 7, r31 = lane & 31, hh = lane >> 5;
    const size_t rowbase = (size_t)b * LP;
    const int t0 = qt * 32, tq = t0 + r31;
    bf16x8 qf[4];
#pragma unroll
    for (int i = 0; i < 4; ++i) qf[i] = *(const bf16x8*)(PA + (rowbase + tq) * NA + h * 64 + 16 * i + 8 * hh);
    const float bias = sb_bias[h];
    bf16x8 tm[2];
#pragma unroll
    for (int s = 0; s < 2; ++s)
#pragma unroll
        for (int j = 0; j < 8; ++j) { const int sin = 16 * s + 8 * (j >> 2) + 4 * hh + (j & 3); tm[s][j] = (sin >= r31) ? (short)0x3F80 : (short)0; }
    f32x16 o0 = zero16(), o1 = zero16();
    float R = 0.f;
    const bf16_t* vnat = PA + rowbase * NA + 1024 + h * 64 + r31;
#define VGATH(s_, e_off) ((bf16x4){(short)vnat[(size_t)((s_) + 4 * hh + 0) * NA + (e_off)], (short)vnat[(size_t)((s_) + 4 * hh + 1) * NA + (e_off)], (short)vnat[(size_t)((s_) + 4 * hh + 2) * NA + (e_off)], (short)vnat[(size_t)((s_) + 4 * hh + 3) * NA + (e_off)]})
    const bf16_t* kbase = PA + (rowbase + r31) * NA + 512 + h * 64 + 8 * hh;
    bf16x8 kc[4]; bf16x4 vc[8];
    {
        const int s0 = qt * 32;
        const bf16_t* kp = kbase + (size_t)s0 * NA;
#pragma unroll
        for (int i = 0; i < 4; ++i) kc[i] = *(const bf16x8*)(kp + 16 * i);
#pragma unroll
        for (int i = 0; i < 4; ++i) { vc[i] = VGATH(s0 + 8 * i, 0); vc[4 + i] = VGATH(s0 + 8 * i, 32); }
    }
    const float c1 = 0.125f * 1.4426950408889634f, bias2 = bias * 1.4426950408889634f;
    for (int kb = qt; kb >= 0; --kb) {
        const int s0 = kb * 32;
        bf16x8 kn[4]; bf16x4 vn[8];
        {
            const int sn = (kb > 0 ? kb - 1 : 0) * 32;
            const bf16_t* kp = kbase + (size_t)sn * NA;
#pragma unroll
            for (int i = 0; i < 4; ++i) kn[i] = *(const bf16x8*)(kp + 16 * i);
#pragma unroll
            for (int i = 0; i < 4; ++i) { vn[i] = VGATH(sn + 8 * i, 0); vn[4 + i] = VGATH(sn + 8 * i, 32); }
        }
        f32x16 S = zero16();
#pragma unroll
        for (int i = 0; i < 4; ++i) S = MFMA32(kc[i], qf[i], S);
        f32x16 L, Z;
        const int lim = tq - s0 - 4 * hh;
        if (kb == qt) {
#pragma unroll
            for (int reg = 0; reg < 16; ++reg) {
                const float z2 = fminf(__builtin_fmaf(S[reg], c1, bias2), 100.f);
                const float l2 = -__builtin_amdgcn_logf(1.f + __builtin_amdgcn_exp2f(z2));
                L[reg] = (crow(reg, 0) < lim) ? l2 : 0.f;
                Z[reg] = z2;
            }
        } else {
#pragma unroll
            for (int reg = 0; reg < 16; ++reg) {
                const float z2 = fminf(__builtin_fmaf(S[reg], c1, bias2), 100.f);
                L[reg] = -__builtin_amdgcn_logf(1.f + __builtin_amdgcn_exp2f(z2));
                Z[reg] = z2;
            }
        }
        const bf16x8 lb0 = pack8(L, 0), lb1 = pack8(L, 1);
        f32x16 Y = MFMA32(tm[0], lb0, zero16());
        Y = MFMA32(tm[1], lb1, Y);
        f32x16 Aw;
        if (kb == qt) {
#pragma unroll
            for (int reg = 0; reg < 16; ++reg) { const float a = __builtin_amdgcn_exp2f(Z[reg] + R + Y[reg]); Aw[reg] = (crow(reg, 0) < lim) ? a : 0.f; }
        } else {
#pragma unroll
            for (int reg = 0; reg < 16; ++reg) Aw[reg] = __builtin_amdgcn_exp2f(Z[reg] + R + Y[reg]);
        }
        const bf16x8 ab0 = pack8(Aw, 0), ab1 = pack8(Aw, 1);
        o0 = MFMA32(cat4(vc[0], vc[1]), ab0, o0); o1 = MFMA32(cat4(vc[4], vc[5]), ab0, o1);
        o0 = MFMA32(cat4(vc[2], vc[3]), ab1, o0); o1 = MFMA32(cat4(vc[6], vc[7]), ab1, o1);
        R += __shfl(Y[0], r31);
#pragma unroll
        for (int i = 0; i < 4; ++i) kc[i] = kn[i];
#pragma unroll
        for (int i = 0; i < 8; ++i) vc[i] = vn[i];
    }
    if (tq < tmax) {
        const size_t row = rowbase + tq;
        const bf16_t* gap = PA + row * NA + 1536 + h * 64;
        bf16_t* mp = MIX + row * D + h * 64;
#pragma unroll
        for (int et = 0; et < 2; ++et)
#pragma unroll
            for (int g = 0; g < 4; ++g) {
                const int e0 = 32 * et + 8 * g + 4 * hh;
                const u32x2 gw = *(const u32x2*)(gap + e0);
                const f32x16& o = et ? o1 : o0;
                u32x2 w;
                w.x = pk2(o[4 * g + 0] * silu_f(bflo(gw.x)), o[4 * g + 1] * silu_f(bfhi(gw.x)));
                w.y = pk2(o[4 * g + 2] * silu_f(bflo(gw.y)), o[4 * g + 3] * silu_f(bfhi(gw.y)));
                *(u32x2*)(mp + e0) = w;
            }
    }
}

#undef VGATH
DI void att_block(const unsigned char* kb_, int j, int it, int r31, int hh, const bf16x8 (&qf)[4], const bf16x8 (&tm)[2], float c1, float bias2, f32x16& o0, f32x16& o1, float& R) {
    constexpr int KROW = 144, VROW = 72, KBYTES = 32 * KROW;
    const unsigned char* vb_ = kb_ + KBYTES;
    f32x16 S = zero16();
#pragma unroll
    for (int i = 0; i < 4; ++i) { const bf16x8 kf = *(const bf16x8*)(kb_ + r31 * KROW + 32 * i + 16 * hh); S = MFMA32(kf, qf[i], S); }
    bf16x4 vc[8];
#pragma unroll
    for (int i = 0; i < 4; ++i) { vc[i] = *(const bf16x4*)(vb_ + r31 * VROW + 8 * hh + 16 * i); vc[4 + i] = *(const bf16x4*)(vb_ + (32 + r31) * VROW + 8 * hh + 16 * i); }
    f32x16 L, Z;
    const bool diag = (j == it + 1), first = (j == 0);
    if (diag || first) {
#pragma unroll
        for (int reg = 0; reg < 16; ++reg) {
            const float z2 = fminf(__builtin_fmaf(S[reg], c1, bias2), 100.f);
            const float l2 = -__builtin_amdgcn_logf(1.f + __builtin_amdgcn_exp2f(z2));
            const int cr = crow(reg, 0) + 4 * hh;
            const bool valid = diag ? (cr < r31) : (cr >= 16);
            L[reg] = valid ? l2 : 0.f;
            Z[reg] = z2;
        }
    } else {
#pragma unroll
        for (int reg = 0; reg < 16; ++reg) {
            const float z2 = fminf(__builtin_fmaf(S[reg], c1, bias2), 100.f);
            L[reg] = -__builtin_amdgcn_logf(1.f + __builtin_amdgcn_exp2f(z2));
            Z[reg] = z2;
        }
    }
    const bf16x8 lb0 = pack8(L, 0), lb1 = pack8(L, 1);
    f32x16 Y = MFMA32(tm[0], lb0, zero16());
    Y = MFMA32(tm[1], lb1, Y);
    f32x16 Aw;
    if (diag || first) {
#pragma unroll
        for (int reg = 0; reg < 16; ++reg) {
            const float a = __builtin_amdgcn_exp2f(Z[reg] + R + Y[reg]);
            const int cr = crow(reg, 0) + 4 * hh;
            const bool valid = diag ? (cr < r31) : (cr >= 16);
            Aw[reg] = valid ? a : 0.f;
        }
    } else {
#pragma unroll
        for (int reg = 0; reg < 16; ++reg) Aw[reg] = __builtin_amdgcn_exp2f(Z[reg] + R + Y[reg]);
    }
    const bf16x8 ab0 = pack8(Aw, 0), ab1 = pack8(Aw, 1);
    o0 = MFMA32(cat4(vc[0], vc[1]), ab0, o0); o1 = MFMA32(cat4(vc[4], vc[5]), ab0, o1);
    o0 = MFMA32(cat4(vc[2], vc[3]), ab1, o0); o1 = MFMA32(cat4(vc[6], vc[7]), ab1, o1);
    R += __shfl(Y[0], r31);
}

DI void attn_prompt_unit(const bf16_t* __restrict__ PA, bf16_t* __restrict__ MIX, const float* __restrict__ sb_bias, unsigned char* lds, int bh, int g, int tid, int wave, int lane) {
    constexpr int KROW = 144, VROW = 72, KBYTES = 32 * KROW  , BUF = KBYTES + 64 * VROW  ;
    const int b = bh >> 3, h = bh & 7, r31 = lane & 31, hh = lane >> 5;
    const size_t rowbase = (size_t)b * LP;
    const int it = 8 * g + wave;
    const int tq = 16 + 32 * it + r31;
    bf16x8 qf[4];
#pragma unroll
    for (int i = 0; i < 4; ++i) qf[i] = *(const bf16x8*)(PA + (rowbase + tq) * NA + h * 64 + 16 * i + 8 * hh);
    const float bias = sb_bias[h];
    bf16x8 tm[2];
#pragma unroll
    for (int s = 0; s < 2; ++s)
#pragma unroll
        for (int j = 0; j < 8; ++j) { const int sin = 16 * s + 8 * (j >> 2) + 4 * hh + (j & 3); tm[s][j] = (sin >= r31) ? (short)0x3F80 : (short)0; }
    f32x16 o0 = zero16(), o1 = zero16();
    float R = 0.f;
    const float c1 = 0.125f * 1.4426950408889634f, bias2 = bias * 1.4426950408889634f;
    const bool isk = tid < 256;
    const int sr = (tid & 255) >> 3, sc = tid & 7;
    const int scol = (isk ? 512 : 1024) + h * 64 + 8 * sc;
#define ATT_STAGE_LOAD(j_) (*(const u32x4*)(PA + (rowbase + ((32 * (j_) - 16 + sr) > 0 ? (32 * (j_) - 16 + sr) : 0)) * NA + scol))
#define ATT_STAGE_WRITE(base_, stg_) do { if (isk) *(u32x4*)((base_) + sr * KROW + 16 * sc) = stg_; \
        else { bf16_t* vt_ = (bf16_t*)((base_) + KBYTES + (8 * sc) * VROW + 2 * sr); \
            vt_[0 * (VROW / 2)] = (bf16_t)(stg_.x & 0xffffu); vt_[1 * (VROW / 2)] = (bf16_t)(stg_.x >> 16); vt_[2 * (VROW / 2)] = (bf16_t)(stg_.y & 0xffffu); vt_[3 * (VROW / 2)] = (bf16_t)(stg_.y >> 16); \
            vt_[4 * (VROW / 2)] = (bf16_t)(stg_.z & 0xffffu); vt_[5 * (VROW / 2)] = (bf16_t)(stg_.z >> 16); vt_[6 * (VROW / 2)] = (bf16_t)(stg_.w & 0xffffu); vt_[7 * (VROW / 2)] = (bf16_t)(stg_.w >> 16); } } while (0)
    const int jmax = 8 * g + 8;
    u32x4 stgA = ATT_STAGE_LOAD(jmax), stgB = ATT_STAGE_LOAD(jmax - 1);
    ATT_STAGE_WRITE(lds, stgA); ATT_STAGE_WRITE(lds + BUF, stgB);
    __syncthreads();
    int cur = 0;
    for (int jp = jmax; jp >= 0; jp -= 2) {
        const int na = jp - 2, nb2 = jp - 3;
        if (na >= 0) { stgA = ATT_STAGE_LOAD(na); stgB = ATT_STAGE_LOAD(nb2 >= 0 ? nb2 : 0); }
        const unsigned char* cb = lds + cur * 2 * BUF;
        if (jp <= it + 1) att_block(cb, jp, it, r31, hh, qf, tm, c1, bias2, o0, o1, R);
        if (jp >= 1 && jp - 1 <= it + 1) att_block(cb + BUF, jp - 1, it, r31, hh, qf, tm, c1, bias2, o0, o1, R);
        if (na >= 0) { unsigned char* nb = lds + (cur ^ 1) * 2 * BUF; ATT_STAGE_WRITE(nb, stgA); ATT_STAGE_WRITE(nb + BUF, stgB); }
        __syncthreads();
        cur ^= 1;
    }
    {
        const size_t row = rowbase + tq;
        const bf16_t* gap = PA + row * NA + 1536 + h * 64;
        bf16_t* mp = MIX + row * D + h * 64;
#pragma unroll
        for (int et = 0; et < 2; ++et)
#pragma unroll
            for (int gq = 0; gq < 4; ++gq) {
                const int e0 = 32 * et + 8 * gq + 4 * hh;
                const u32x2 gw = *(const u32x2*)(gap + e0);
                const f32x16& o = et ? o1 : o0;
                u32x2 w;
                w.x = pk2(o[4 * gq + 0] * silu_f(bflo(gw.x)), o[4 * gq + 1] * silu_f(bfhi(gw.x)));
                w.y = pk2(o[4 * gq + 2] * silu_f(bflo(gw.y)), o[4 * gq + 3] * silu_f(bfhi(gw.y)));
                *(u32x2*)(mp + e0) = w;
            }
    }
}
#undef ATT_STAGE_LOAD
#undef ATT_STAGE_WRITE
DI void p2_attn_prompt(const Params& p, const Frame& F) {
    const bf16_t* PA = (const bf16_t*)(p.ws + WS_PROJA); const bf16_t* VTA = (const bf16_t*)(p.ws + WS_VTA); bf16_t* MIX = (bf16_t*)(p.ws + WS_MIXED);
    const float* bias = p.in[15];
    {
        const int gw = F.bid * 8 + F.wave, nw = F.G * 8;
        for (int task = gw; task < 64; task += nw) attn_prompt_tile(PA, VTA, MIX, bias, task, 0, F.lane, NMETA);
    }
    for (int u = F.bid; u < 256; u += F.G) {
        const int bh = (u & 7) * 8 + ((u >> 3) & 7), g = u >> 6;
        attn_prompt_unit(PA, MIX, bias, F.lds, bh, g, F.tid, F.wave, F.lane);
        attn_prompt_unit(PA, MIX, bias, F.lds, bh, 7 - g, F.tid, F.wave, F.lane);
    }
}

DI void p2_attn_sample(const Params& p, const Frame& F) {
    const bf16_t* PA = (const bf16_t*)(p.ws + WS_PROJA);
    float* SPART = (float*)(p.ws + WS_SPART); float* ST = (float*)(p.ws + WS_ST);
    const float* cache_k = p.in[2]; const float* cache_v = p.in[3]; const int* ptab = (const int*)p.in[4];
    const float* sbb = p.in[15];
    float* zl = (float*)F.lds;
    float* red = (float*)(F.lds + 16384);
    float* res = (float*)(F.lds + 86016);
    float* pw = red + F.wave * 2176;
    const int tid = F.tid, lane = F.lane, wave = F.wave;
    const int hh = (tid >> 4) & 7, dch = tid & 15, sg = tid >> 7;
    f32x4 b0[8], b1[8], b2[8], b3[8];
#define SA_LOAD(buf, base, bt) do { _Pragma("unroll") for (int u_ = 0; u_ < 8; ++u_) buf[u_] = __builtin_nontemporal_load((const f32x4*)((base) + (size_t)((bt) * 8 + u_) * 2048 + tid * 4)); } while (0)
#define SA_QK(buf, bt) do { _Pragma("unroll") for (int u_ = 0; u_ < 8; ++u_) { \
        f32x4 pq_; \
        pq_[0] = buf[u_][0] * qr[0][0] + buf[u_][1] * qr[0][1] + buf[u_][2] * qr[0][2] + buf[u_][3] * qr[0][3]; \
        pq_[1] = buf[u_][0] * qr[1][0] + buf[u_][1] * qr[1][1] + buf[u_][2] * qr[1][2] + buf[u_][3] * qr[1][3]; \
        pq_[2] = buf[u_][0] * qr[2][0] + buf[u_][1] * qr[2][1] + buf[u_][2] * qr[2][2] + buf[u_][3] * qr[2][3]; \
        pq_[3] = buf[u_][0] * qr[3][0] + buf[u_][1] * qr[3][1] + buf[u_][2] * qr[3][2] + buf[u_][3] * qr[3][3]; \
        *(f32x4*)(pw + (u_ * 4 + (lane >> 4)) * 68 + (lane & 15) * 4) = pq_; } \
        __builtin_amdgcn_fence(__ATOMIC_RELEASE, "wavefront"); __builtin_amdgcn_wave_barrier(); __builtin_amdgcn_fence(__ATOMIC_ACQUIRE, "wavefront"); \
        { const int u2_ = lane >> 3, r_ = (lane >> 1) & 3, ip_ = lane & 1; const float* src_ = pw + (u2_ * 4 + r_) * 68 + 2 * ip_; \
          f32x2 za_ = *(const f32x2*)src_; \
          _Pragma("unroll") for (int j_ = 1; j_ < 16; ++j_) za_ += *(const f32x2*)(src_ + 4 * j_); \
          const int row_ = wave * 4 + r_; \
          *(f32x2*)(zl + ((row_ & 7) * 128 + ((bt) * 8 + u2_) * 4 + (row_ >> 3)) * 4 + 2 * ip_) = za_; } \
        __builtin_amdgcn_fence(__ATOMIC_RELEASE, "wavefront"); __builtin_amdgcn_wave_barrier(); __builtin_amdgcn_fence(__ATOMIC_ACQUIRE, "wavefront"); } while (0)
#define SA_PV(buf, bt) do { _Pragma("unroll") for (int u_ = 0; u_ < 8; ++u_) { const int s_ = ((bt) * 8 + u_) * 4 + sg; const f32x4 a_ = *(const f32x4*)(zl + (hh * 128 + s_) * 4); \
        _Pragma("unroll") for (int i_ = 0; i_ < 4; ++i_) oa[i_] += buf[u_] * a_[i_]; } } while (0)
    int item = F.bid, cnt = 0, first_item = F.bid;
    const float* Kp = nullptr; const float* Vp = nullptr;
    if (item < BS * NPAGES) { const int phys = ptab[item]; Kp = cache_k + (size_t)phys * PAGE * WA; Vp = cache_v + (size_t)phys * PAGE * WA; SA_LOAD(b0, Kp, 0); SA_LOAD(b1, Kp, 1); SA_LOAD(b2, Kp, 2); }
    for (; item < BS * NPAGES; item += F.G) {
        const int sb = item >> 4;
        const int nitem = item + F.G;
        const float* Kn = Kp; const float* Vn = Vp;
        if (nitem < BS * NPAGES) { const int phys = ptab[nitem]; Kn = cache_k + (size_t)phys * PAGE * WA; Vn = cache_v + (size_t)phys * PAGE * WA; }
        f32x4 qr[4];
#pragma unroll
        for (int i = 0; i < 4; ++i) {
            const u32x2 w = *(const u32x2*)(PA + (size_t)(MP + sb * 4 + i) * NA + hh * 64 + dch * 4);
            qr[i] = (f32x4){bflo(w.x) * 0.125f, bfhi(w.x) * 0.125f, bflo(w.y) * 0.125f, bfhi(w.y) * 0.125f};
        }
        SA_LOAD(b3, Kp, 3); SA_QK(b0, 0);
        SA_LOAD(b0, Vp, 0); SA_QK(b1, 1);
        SA_LOAD(b1, Vp, 1); SA_QK(b2, 2);
        SA_LOAD(b2, Vp, 2); SA_QK(b3, 3);
        __syncthreads();
        {
            const int row = tid >> 4, seg = tid & 15, h = row >> 2, i = row & 3;
            const float bias = sbb[h];
            float zz[8], suf[8];
            float run = 0.f;
#pragma unroll
            for (int k = 7; k >= 0; --k) { zz[k] = zl[(h * 128 + seg * 8 + k) * 4 + i] + bias; run += -softplus_f(zz[k]); suf[k] = run; }
            float inc = run;
            inc += dpp_shl_zero<0x101>(inc); inc += dpp_shl_zero<0x102>(inc); inc += dpp_shl_zero<0x104>(inc); inc += dpp_shl_zero<0x108>(inc);
            const float off = inc - run;
#pragma unroll
            for (int k = 0; k < 8; ++k) zl[(h * 128 + seg * 8 + k) * 4 + i] = __expf(zz[k] + suf[k] + off);
            if (seg == 0) res[cnt * 2080 + 2048 + row] = inc;
        }
        __syncthreads();
        f32x4 oa[4];
#pragma unroll
        for (int i = 0; i < 4; ++i) oa[i] = (f32x4){0.f, 0.f, 0.f, 0.f};
        SA_LOAD(b3, Vp, 3); SA_PV(b0, 0);
        SA_LOAD(b0, Kn, 0); SA_PV(b1, 1);
        SA_LOAD(b1, Kn, 1); SA_PV(b2, 2);
        SA_LOAD(b2, Kn, 2); SA_PV(b3, 3);
#pragma unroll
        for (int i = 0; i < 4; ++i) *(f32x4*)(red + ((sg * 8 + hh) * 4 + i) * 64 + dch * 4) = oa[i];
        __syncthreads();
        {
            const f32x4 r0 = *(const f32x4*)(red + tid * 4), r1 = *(const f32x4*)(red + 2048 + tid * 4), r2 = *(const f32x4*)(red + 4096 + tid * 4), r3 = *(const f32x4*)(red + 6144 + tid * 4);
            *(f32x4*)(res + cnt * 2080 + tid * 4) = (r0 + r1) + (r2 + r3);
        }
        ++cnt;
        __syncthreads();
        if (cnt == 4 || nitem >= BS * NPAGES) {
            for (int k = 0; k < cnt; ++k) {
                const size_t it = (size_t)first_item + (size_t)k * F.G;
                *(f32x4*)(SPART + it * 2048 + tid * 4) = *(const f32x4*)(res + k * 2080 + tid * 4);
                if (tid < 32) ST[it * 32 + tid] = res[k * 2080 + 2048 + tid];
            }
            first_item = nitem; cnt = 0;
            __syncthreads();
        }
        Kp = Kn; Vp = Vn;
    }
#undef SA_LOAD
#undef SA_QK
#undef SA_PV
}

DI void p2_pool(const Params& p, const Frame& F) {
    const bf16_t* PA = (const bf16_t*)(p.ws + WS_PROJA); bf16_t* MIX = (bf16_t*)(p.ws + WS_MIXED);
    const bf16_t* WTP = (const bf16_t*)(p.ws + WS_WTPOOL);
    const float* spool = p.in[5]; const float* scale = p.in[17];
    bf16_t* dl = (bf16_t*)F.lds;
    bf16_t* wl = (bf16_t*)(F.lds + 17408);
    const int tid = F.tid, lane = F.lane, r31 = lane & 31, hh = lane >> 5;
    constexpr int NT = MT / 64;
    for (int unit = F.bid; unit < NT * NG; unit += F.G) {
        const int g = unit & 3, tile = unit >> 2;
        const int w = 2 << g;
        for (int i = tid; i < 128 * 16; i += NTHREADS) { const int e = i >> 4, c8 = (i & 15) * 8; *(u32x4*)(wl + e * 136 + c8) = *(const u32x4*)(WTP + ((size_t)g * GC + e) * GC + c8); }
        {
            const int tl = tid >> 3, cc = (tid & 7) * 16;
            const int r = tile * 64 + tl;
            const int col = g * GC + cc;
            float sum[16];
#pragma unroll
            for (int k = 0; k < 16; ++k) sum[k] = 0.f;
            float cnt;
            const bf16_t* ur = PA + (size_t)r * NA + 2048 + col;
            const u32x4 ua = *(const u32x4*)ur, ub = *(const u32x4*)(ur + 8);
            const float u0[16] = {bflo(ua.x), bfhi(ua.x), bflo(ua.y), bfhi(ua.y), bflo(ua.z), bfhi(ua.z), bflo(ua.w), bfhi(ua.w), bflo(ub.x), bfhi(ub.x), bflo(ub.y), bfhi(ub.y), bflo(ub.z), bfhi(ub.z), bflo(ub.w), bfhi(ub.w)};
#define POOL_ADD_BF(src_) do { const u32x4 a_ = *(const u32x4*)(src_), b_ = *(const u32x4*)((src_) + 8); \
                sum[0] += bflo(a_.x); sum[1] += bfhi(a_.x); sum[2] += bflo(a_.y); sum[3] += bfhi(a_.y); sum[4] += bflo(a_.z); sum[5] += bfhi(a_.z); sum[6] += bflo(a_.w); sum[7] += bfhi(a_.w); \
                sum[8] += bflo(b_.x); sum[9] += bfhi(b_.x); sum[10] += bflo(b_.y); sum[11] += bfhi(b_.y); sum[12] += bflo(b_.z); sum[13] += bfhi(b_.z); sum[14] += bflo(b_.w); sum[15] += bfhi(b_.w); } while (0)
#define POOL_WINDOW(W) do { \
                if (r < MP) { const int t = r % LP; cnt = (float)((W) < t + 1 ? (W) : t + 1); \
                    _Pragma("unroll") for (int j = 0; j < (W); ++j) { if (j <= t) { const bf16_t* src = ur - (size_t)j * NA; POOL_ADD_BF(src); } } } \
                else { const int sb = (r - MP) >> 2, i = (r - MP) & 3; cnt = (float)(W); \
                    _Pragma("unroll") for (int j = 0; j < (W); ++j) { \
                        if (j <= i) { const bf16_t* src = ur - (size_t)j * NA; POOL_ADD_BF(src); } \
                        else { const float* src = spool + ((size_t)sb * 15 + (15 + i - j)) * WB + col; \
                            _Pragma("unroll") for (int q = 0; q < 4; ++q) { const f32x4 v = *(const f32x4*)(src + 4 * q); sum[4 * q] += v[0]; sum[4 * q + 1] += v[1]; sum[4 * q + 2] += v[2]; sum[4 * q + 3] += v[3]; } } } } } while (0)
            if (g == 0) POOL_WINDOW(2); else if (g == 1) POOL_WINDOW(4); else if (g == 2) POOL_WINDOW(8); else POOL_WINDOW(16);
#undef POOL_WINDOW
#undef POOL_ADD_BF
            const float inv = 1.f / cnt;
            u32x4 w0, w1;
            w0.x = pk2(sum[0] * inv - u0[0], sum[1] * inv - u0[1]); w0.y = pk2(sum[2] * inv - u0[2], sum[3] * inv - u0[3]);
            w0.z = pk2(sum[4] * inv - u0[4], sum[5] * inv - u0[5]); w0.w = pk2(sum[6] * inv - u0[6], sum[7] * inv - u0[7]);
            w1.x = pk2(sum[8] * inv - u0[8], sum[9] * inv - u0[9]); w1.y = pk2(sum[10] * inv - u0[10], sum[11] * inv - u0[11]);
            w1.z = pk2(sum[12] * inv - u0[12], sum[13] * inv - u0[13]); w1.w = pk2(sum[14] * inv - u0[14], sum[15] * inv - u0[15]);
            *(u32x4*)(dl + tl * 136 + cc) = w0; *(u32x4*)(dl + tl * 136 + cc + 8) = w1;
        }
        __syncthreads();
        {
            const int tt = F.wave >> 2, et = F.wave & 3;
            f32x16 acc = zero16();
#pragma unroll
            for (int ks = 0; ks < 8; ++ks) {
                const bf16x8 a = *(const bf16x8*)(wl + (32 * et + r31) * 136 + 16 * ks + 8 * hh);
                const bf16x8 bq = *(const bf16x8*)(dl + (32 * tt + r31) * 136 + 16 * ks + 8 * hh);
                acc = MFMA32(a, bq, acc);
            }
            const int r = tile * 64 + 32 * tt + r31;
#pragma unroll
            for (int gq = 0; gq < 4; ++gq) {
                const int e = g * GC + 32 * et + 8 * gq + 4 * hh;
                const f32x4 sc = *(const f32x4*)(scale + e);
                const u32x2 gw = *(const u32x2*)(PA + (size_t)r * NA + 2560 + e);
                u32x2 w2;
                w2.x = pk2(acc[4 * gq + 0] * sc[0] * silu_f(bflo(gw.x)), acc[4 * gq + 1] * sc[1] * silu_f(bfhi(gw.x)));
                w2.y = pk2(acc[4 * gq + 2] * sc[2] * silu_f(bflo(gw.y)), acc[4 * gq + 3] * sc[3] * silu_f(bfhi(gw.y)));
                *(u32x2*)(MIX + (size_t)r * D + 512 + e) = w2;
            }
        }
        __syncthreads();
    }
    {
        float* outp = p.out + O_POOLP; float* outs = p.out + O_POOLS;
        const int gt = F.bid * NTHREADS + tid, nt = F.G * NTHREADS;
        for (int i = gt; i < BP * 15 * (WB / 4); i += nt) { const int c4 = i % (WB / 4), j = (i / (WB / 4)) % 15, b = i / (15 * (WB / 4));
            const u32x2 w = *(const u32x2*)(PA + ((size_t)b * LP + (LP - 15) + j) * NA + 2048 + c4 * 4);
            *(f32x4*)(outp + ((size_t)b * 15 + j) * WB + c4 * 4) = (f32x4){bflo(w.x), bfhi(w.x), bflo(w.y), bfhi(w.y)}; }
        for (int i = gt; i < BS * 15 * (WB / 4); i += nt) { const int c4 = i % (WB / 4), j = (i / (WB / 4)) % 15, sb = i / (15 * (WB / 4));
            f32x4 v;
            if (j < 11) v = *(const f32x4*)(spool + ((size_t)sb * 15 + j + 4) * WB + c4 * 4);
            else { const u32x2 w = *(const u32x2*)(PA + ((size_t)(MP + sb * 4 + (j - 11))) * NA + 2048 + c4 * 4); v = (f32x4){bflo(w.x), bfhi(w.x), bflo(w.y), bfhi(w.y)}; }
            *(f32x4*)(outs + ((size_t)sb * 15 + j) * WB + c4 * 4) = v; }
    }
}

DI void p2d_combine(const Params& p, const Frame& F) {
    const bf16_t* PA = (const bf16_t*)(p.ws + WS_PROJA); bf16_t* MIX = (bf16_t*)(p.ws + WS_MIXED);
    const float* SPART = (const float*)(p.ws + WS_SPART); const float* ST = (const float*)(p.ws + WS_ST);
    const float* sbb = p.in[15];
    const int gt = F.bid * NTHREADS + F.tid, nt = F.G * NTHREADS;
    for (int idx = gt; idx < BS * HA * TS * 16; idx += nt) {
        const int e4 = idx & 15, i = (idx >> 4) & 3, h = (idx >> 6) & 7, sb = idx >> 9;
        const size_t rq = (size_t)(MP + sb * 4 + i);
        const float bias = sbb[h];
        f32x4 o = (f32x4){0.f, 0.f, 0.f, 0.f};
        float R = 0.f;
        for (int ip = i - 1; ip >= 0; --ip) {
            const size_t rk = (size_t)(MP + sb * 4 + ip);
            float dot = 0.f;
            for (int d = 0; d < 64; d += 8) {
                const u32x4 qa = *(const u32x4*)(PA + rq * NA + h * 64 + d), ka = *(const u32x4*)(PA + rk * NA + 512 + h * 64 + d);
                dot += bflo(qa.x) * bflo(ka.x) + bfhi(qa.x) * bfhi(ka.x) + bflo(qa.y) * bflo(ka.y) + bfhi(qa.y) * bfhi(ka.y)
                     + bflo(qa.z) * bflo(ka.z) + bfhi(qa.z) * bfhi(ka.z) + bflo(qa.w) * bflo(ka.w) + bfhi(qa.w) * bfhi(ka.w);
            }
            const float z = dot * 0.125f + bias;
            const float ln = -softplus_f(z);
            const float a = __expf(z + R + ln);
            const u32x2 vw = *(const u32x2*)(PA + rk * NA + 1024 + h * 64 + e4 * 4);
            o[0] += a * bflo(vw.x); o[1] += a * bfhi(vw.x); o[2] += a * bflo(vw.y); o[3] += a * bfhi(vw.y);
            R += ln;
        }
        for (int pg = NPAGES - 1; pg >= 0; --pg) {
            const size_t it = (size_t)sb * NPAGES + pg;
            const f32x4 po = *(const f32x4*)(SPART + it * 2048 + (h * 4 + i) * 64 + e4 * 4);
            const float w = __expf(R);
            o += po * w;
            R += ST[it * 32 + h * 4 + i];
        }
        const u32x2 gw = *(const u32x2*)(PA + rq * NA + 1536 + h * 64 + e4 * 4);
        u32x2 w;
        w.x = pk2(o[0] * silu_f(bflo(gw.x)), o[1] * silu_f(bfhi(gw.x)));
        w.y = pk2(o[2] * silu_f(bflo(gw.y)), o[3] * silu_f(bfhi(gw.y)));
        *(u32x2*)(MIX + rq * D + h * 64 + e4 * 4) = w;
    }
}

DI void p3b_norm_gates(const Params& p, const Frame& F) {
    const bf16_t* HB = (const bf16_t*)(p.ws + WS_H); bf16_t* HBw = (bf16_t*)(p.ws + WS_H); bf16_t* XN = (bf16_t*)(p.ws + WS_XN);
    const float* PART = (const float*)(p.ws + WS_PART);
    const float* WG = (const float*)(p.ws + WS_WG);
    float* LOGI = (float*)(p.ws + WS_LOGI); float* LOGF = (float*)(p.ws + WS_LOGF);
    const float* g1 = p.in[11] + D; const float* bg = p.in[19];
    const int gw = F.bid * 8 + F.wave, nw = F.G * 8, lane = F.lane;
    constexpr int RB = 2;
    for (int r0 = gw * RB; r0 < MT; r0 += nw * RB) {
        float v[RB][2][8]; float rstd[RB];
        if (r0 < MMAIN) {
            u32x4 hw[RB][2];
#pragma unroll
            for (int rr = 0; rr < RB; ++rr)
#pragma unroll
                for (int j = 0; j < 2; ++j) hw[rr][j] = *(const u32x4*)(HB + (size_t)(r0 + rr) * D + j * 512 + lane * 8);
#pragma unroll
            for (int rr = 0; rr < RB; ++rr)
#pragma unroll
                for (int j = 0; j < 2; ++j) {
                    const u32x4 w = hw[rr][j];
                    v[rr][j][0] = bflo(w.x); v[rr][j][1] = bfhi(w.x); v[rr][j][2] = bflo(w.y); v[rr][j][3] = bfhi(w.y); v[rr][j][4] = bflo(w.z); v[rr][j][5] = bfhi(w.z); v[rr][j][6] = bflo(w.w); v[rr][j][7] = bfhi(w.w);
                }
        } else {
#pragma unroll
            for (int rr = 0; rr < RB; ++rr) {
                const int r = r0 + rr;
                const float* src;
                if (r < MP) { const int b = r / LP, t = r - b * LP; src = (t < NMETA) ? p.in[10] + (size_t)t * D : p.in[0] + ((size_t)b * SEQ + (t - NMETA)) * D; }
                else src = p.in[1] + (size_t)(r - MP) * D;
#pragma unroll
                for (int j = 0; j < 2; ++j) {
                    const int c = j * 512 + lane * 8;
                    f32x4 a0 = *(const f32x4*)(src + c), a1 = *(const f32x4*)(src + c + 4);
#pragma unroll
                    for (int ks = 0; ks < 4; ++ks) { const float* pp = PART + ((size_t)ks * 768 + (r - MMAIN)) * D + c; a0 += *(const f32x4*)pp; a1 += *(const f32x4*)(pp + 4); }
                    v[rr][j][0] = a0[0]; v[rr][j][1] = a0[1]; v[rr][j][2] = a0[2]; v[rr][j][3] = a0[3]; v[rr][j][4] = a1[0]; v[rr][j][5] = a1[1]; v[rr][j][6] = a1[2]; v[rr][j][7] = a1[3];
                    *(u32x4*)(HBw + (size_t)r * D + c) = pack_row8(a0, a1);
                }
            }
        }
#pragma unroll
        for (int rr = 0; rr < RB; ++rr) {
            float ss = 0.f;
#pragma unroll
            for (int j = 0; j < 2; ++j)
#pragma unroll
                for (int k = 0; k < 8; ++k) ss += v[rr][j][k] * v[rr][j][k];
            rstd[rr] = rsqrtf(wave_sum(ss) * (1.f / D) + EPS);
        }
        float gsum[RB][8];
#pragma unroll
        for (int rr = 0; rr < RB; ++rr)
#pragma unroll
            for (int q = 0; q < 8; ++q) gsum[rr][q] = 0.f;
#pragma unroll
        for (int j = 0; j < 2; ++j) {
            const int c = j * 512 + lane * 8;
            const f32x4 ga = *(const f32x4*)(g1 + c), gb = *(const f32x4*)(g1 + c + 4);
            const float g[8] = {ga[0], ga[1], ga[2], ga[3], gb[0], gb[1], gb[2], gb[3]};
            float xn[RB][8];
#pragma unroll
            for (int rr = 0; rr < RB; ++rr) {
#pragma unroll
                for (int k = 0; k < 8; ++k) xn[rr][k] = v[rr][j][k] * rstd[rr] * g[k];
                u32x4 w; w.x = pk2(xn[rr][0], xn[rr][1]); w.y = pk2(xn[rr][2], xn[rr][3]); w.z = pk2(xn[rr][4], xn[rr][5]); w.w = pk2(xn[rr][6], xn[rr][7]);
                *(u32x4*)(XN + (size_t)(r0 + rr) * D + c) = w;
            }
#pragma unroll
            for (int q = 0; q < 8; ++q) {
                const f32x4 wa = *(const f32x4*)(WG + q * D + c), wb = *(const f32x4*)(WG + q * D + c + 4);
#pragma unroll
                for (int rr = 0; rr < RB; ++rr)
                    gsum[rr][q] += xn[rr][0] * wa[0] + xn[rr][1] * wa[1] + xn[rr][2] * wa[2] + xn[rr][3] * wa[3] + xn[rr][4] * wb[0] + xn[rr][5] * wb[1] + xn[rr][6] * wb[2] + xn[rr][7] * wb[3];
            }
        }
#pragma unroll
        for (int rr = 0; rr < RB; ++rr) {
#pragma unroll
            for (int q = 0; q < 8; ++q) gsum[rr][q] = wave_sum(gsum[rr][q]);
            if (lane < 8) {
                const float gsel = lane == 0 ? gsum[rr][0] : lane == 1 ? gsum[rr][1] : lane == 2 ? gsum[rr][2] : lane == 3 ? gsum[rr][3] : lane == 4 ? gsum[rr][4] : lane == 5 ? gsum[rr][5] : lane == 6 ? gsum[rr][6] : gsum[rr][7];
                const float x = gsel + bg[lane];
                if (lane < 4) LOGI[(size_t)(r0 + rr) * 4 + lane] = x;
                else LOGF[(size_t)(r0 + rr) * 4 + (lane - 4)] = -softplus_f(-x);
            }
        }
    }
}

DI void p4_scan(const Params& p, const Frame& F) {
    const float* LOGI = (const float*)(p.ws + WS_LOGI); const float* LOGF = (const float*)(p.ws + WS_LOGF);
    float* SA = (float*)(p.ws + WS_SA); float* SM = (float*)(p.ws + WS_SM); float* SBt = (float*)(p.ws + WS_SB);
    float* MPREV = (float*)(p.ws + WS_MPREV); float* MTOP = (float*)(p.ws + WS_MTOP);
    const int gw = F.bid * 8 + F.wave, nw = F.G * 8, lane = F.lane;
    const int soff = (F.G >= 128) ? 64 * 8 : 0;
    for (int seq = gw - soff; seq >= 0 && seq < BP * HC; seq += nw) {
        const int b = seq >> 2, h = seq & 3;
        float m = 0.f;
        for (int c = 0; c < NCH; ++c) {
            const int t0 = (c == 0) ? 0 : NMETA + 128 * (c - 1), len = (c == 0) ? NMETA : 128;
            const size_t r0 = (size_t)b * LP + t0;
            const int tA = 2 * lane, tB = 2 * lane + 1;
            const bool vA = tA < len, vB = tB < len;
            const float lfA = vA ? LOGF[(r0 + tA) * 4 + h] : 0.f, lfB = vB ? LOGF[(r0 + tB) * 4 + h] : 0.f;
            const float liA = vA ? LOGI[(r0 + tA) * 4 + h] : 0.f, liB = vB ? LOGI[(r0 + tB) * 4 + h] : 0.f;
            const float pB = lfA + lfB;
            const float inc = wave_scan_add(pB);
            const float exc = inc - pB;
            const float bA = exc + lfA, bB = exc + pB;
            const float aA = vA ? liA - bA : -INFINITY, aB = vB ? liB - bB : -INFINITY;
            const float mB = fmaxf(aA, aB);
            const float minc = wave_scan_max(mB);
            float mexc = __shfl_up(minc, 1); if (lane == 0) mexc = -INFINITY;
            const float MA = fmaxf(m, fmaxf(mexc, aA)), MB = fmaxf(m, fmaxf(mexc, mB));
            if (vA) { SA[(r0 + tA) * 4 + h] = aA; SM[(r0 + tA) * 4 + h] = MA; SBt[(r0 + tA) * 4 + h] = bA; }
            if (vB) { SA[(r0 + tB) * 4 + h] = aB; SM[(r0 + tB) * 4 + h] = MB; SBt[(r0 + tB) * 4 + h] = bB; }
            const int ll = (len - 1) >> 1;
            const float bT = __shfl(bB, ll), MT_ = __shfl(MB, ll);
            if (lane == 0) { MPREV[seq * NCH + c] = m; MTOP[seq * NCH + c] = MT_; }
            m = bT + MT_;
        }
        if (lane == 0) p.out[O_MP + seq] = m;
    }
    const int gt = F.bid * NTHREADS + F.tid, nt = F.G * NTHREADS;
    for (int sq = gt; sq < BS * HC; sq += nt) {
        const int sb = sq >> 2, h = sq & 3;
        const float m = p.in[8][sq];
        float bsum = 0.f, pm = -INFINITY, MT_ = 0.f;
        for (int i = 0; i < 4; ++i) {
            const size_t r = (size_t)MP + sb * 4 + i;
            bsum += LOGF[r * 4 + h];
            const float a = LOGI[r * 4 + h] - bsum;
            pm = fmaxf(pm, a);
            MT_ = fmaxf(m, pm);
            SA[r * 4 + h] = a; SM[r * 4 + h] = MT_; SBt[r * 4 + h] = bsum;
        }
        MPREV[32 * NCH + sq] = m; MTOP[32 * NCH + sq] = MT_;
        p.out[O_MS + sq] = bsum + MT_;
    }
}

DI void p4b_conv(const Params& p, const Frame& F) {
    const bf16_t* XMZ = (const bf16_t*)(p.ws + WS_XMZ); bf16_t* CA = (bf16_t*)(p.ws + WS_CA);
    const float* cw = p.in[20]; const float* cb = p.in[21]; const float* sconv = p.in[9];
    const int gt = F.bid * NTHREADS + F.tid, nt = F.G * NTHREADS;
    for (int idx = gt; idx < (MT / 4) * (INNER / 8); idx += nt) {
        const int rg = idx >> 8, c = (idx & 255) * 8, r = rg * 4;
        const bool samp = r >= MP;
        const int tpos = samp ? 0 : (r % LP), sb = samp ? ((r - MP) >> 2) : 0;
        float x[7][8];
#pragma unroll
        for (int k = 0; k < 4; ++k) {
            const u32x4 w = *(const u32x4*)(XMZ + (size_t)(r + k) * 4096 + c);
            x[3 + k][0] = bflo(w.x); x[3 + k][1] = bfhi(w.x); x[3 + k][2] = bflo(w.y); x[3 + k][3] = bfhi(w.y); x[3 + k][4] = bflo(w.z); x[3 + k][5] = bfhi(w.z); x[3 + k][6] = bflo(w.w); x[3 + k][7] = bfhi(w.w);
        }
        if (samp) {
#pragma unroll
            for (int k = 0; k < 3; ++k) {
                const float* src = sconv + ((size_t)sb * 3 + k) * INNER + c;
                const f32x4 a = *(const f32x4*)src, b2 = *(const f32x4*)(src + 4);
                x[k][0] = a[0]; x[k][1] = a[1]; x[k][2] = a[2]; x[k][3] = a[3]; x[k][4] = b2[0]; x[k][5] = b2[1]; x[k][6] = b2[2]; x[k][7] = b2[3];
            }
        } else if (tpos >= 4) {
#pragma unroll
            for (int k = 0; k < 3; ++k) {
                const u32x4 w = *(const u32x4*)(XMZ + (size_t)(r - 3 + k) * 4096 + c);
                x[k][0] = bflo(w.x); x[k][1] = bfhi(w.x); x[k][2] = bflo(w.y); x[k][3] = bfhi(w.y); x[k][4] = bflo(w.z); x[k][5] = bfhi(w.z); x[k][6] = bflo(w.w); x[k][7] = bfhi(w.w);
            }
        } else {
#pragma unroll
            for (int k = 0; k < 3; ++k)
#pragma unroll
                for (int e = 0; e < 8; ++e) x[k][e] = 0.f;
        }
        float wt[4][8], bias[8];
#pragma unroll
        for (int j = 0; j < 4; ++j) { const f32x4 w0 = *(const f32x4*)(cw + (size_t)j * INNER + c), w1 = *(const f32x4*)(cw + (size_t)j * INNER + c + 4);
            wt[j][0] = w0[0]; wt[j][1] = w0[1]; wt[j][2] = w0[2]; wt[j][3] = w0[3]; wt[j][4] = w1[0]; wt[j][5] = w1[1]; wt[j][6] = w1[2]; wt[j][7] = w1[3]; }
        { const f32x4 b0 = *(const f32x4*)(cb + c), b1 = *(const f32x4*)(cb + c + 4);
          bias[0] = b0[0]; bias[1] = b0[1]; bias[2] = b0[2]; bias[3] = b0[3]; bias[4] = b1[0]; bias[5] = b1[1]; bias[6] = b1[2]; bias[7] = b1[3]; }
#pragma unroll
        for (int k = 0; k < 4; ++k) {
            float acc[8];
#pragma unroll
            for (int e = 0; e < 8; ++e) acc[e] = bias[e] + x[k][e] * wt[0][e] + x[k + 1][e] * wt[1][e] + x[k + 2][e] * wt[2][e] + x[k + 3][e] * wt[3][e];
            u32x4 o;
            o.x = pk2(silu_f(acc[0]), silu_f(acc[1])); o.y = pk2(silu_f(acc[2]), silu_f(acc[3])); o.z = pk2(silu_f(acc[4]), silu_f(acc[5])); o.w = pk2(silu_f(acc[6]), silu_f(acc[7]));
            *(u32x4*)(CA + (size_t)(r + k) * INNER + c) = o;
        }
    }
    for (int idx = gt; idx < (MPAD - MT) * (INNER / 8); idx += nt) *(u32x4*)(CA + (size_t)MT * INNER + (size_t)idx * 8) = (u32x4){0u, 0u, 0u, 0u};
}

DI void p5b_chunk_scores(const Params& p, const Frame& F) {
    const bf16_t* QF = (const bf16_t*)(p.ws + WS_QF); const bf16_t* KC = (const bf16_t*)(p.ws + WS_KC); const bf16_t* KTC = (const bf16_t*)(p.ws + WS_KTC);
    const float* SA = (const float*)(p.ws + WS_SA); const float* SM = (const float*)(p.ws + WS_SM); const float* MTOP = (const float*)(p.ws + WS_MTOP);
    bf16_t* SD = (bf16_t*)(p.ws + WS_SD); float* RS = (float*)(p.ws + WS_RS); float* DN = (float*)(p.ws + WS_DN);
    float* la = (float*)F.lds;
    float* lm = la + 128;
    float* lw = lm + 128;
    float* lrs = lw + 128;
    float* ldn = lrs + 128;
    const int tid = F.tid, lane = F.lane, r31 = lane & 31, hh = lane >> 5;
    for (int ui = F.bid; ui < 32 * NCH; ui += F.G) {
        const int seq = (ui < 512) ? (ui >> 4) : (ui - 512), c = (ui < 512) ? 1 + (ui & 15) : 0, unit = seq * NCH + c, b = seq >> 2, h = seq & 3;
        const int t0 = (c == 0) ? 0 : NMETA + 128 * (c - 1), len = (c == 0) ? NMETA : 128;
        const size_t r0 = (size_t)b * LP + t0;
        if (tid < 128) {
            const bool v = tid < len;
            const float a = v ? SA[(r0 + tid) * 4 + h] : 0.f, M = v ? SM[(r0 + tid) * 4 + h] : 0.f;
            la[tid] = a; lm[tid] = M; lw[tid] = v ? __expf(a - MTOP[unit]) : 0.f; lrs[tid] = 0.f;
        }
        __syncthreads();
        {
            const int tt = F.wave & 3, sp = F.wave >> 2;
            const int t = 32 * tt + r31;
            const float Mt = lm[t];
            const float gT = __expf(MTOP[unit] - Mt);
            float rsum = 0.f;
#pragma unroll
            for (int q = 0; q < 2; ++q) {
                const int st = 2 * sp + q;
                f32x16 acc = zero16();
                if (st <= tt && 32 * st < len) {
                    const bf16_t* kp = KC + (r0 + 32 * st + r31) * INNER + h * DHC + 8 * hh;
                    const bf16_t* qp = QF + ((size_t)(unit * 8 + 2 * tt + (r31 >> 4)) * 16) * 512 + (hh * 16 + (r31 & 15)) * 8;
#pragma unroll 8
                    for (int ks = 0; ks < 32; ++ks) { const bf16x8 a = *(const bf16x8*)(kp + 16 * ks); const bf16x8 bq = *(const bf16x8*)(qp + 256 * ks); acc = MFMA32(a, bq, acc); }
                }
                bf16_t* dst = SD + ((size_t)unit * 128 + t) * 128 + 32 * st + 4 * hh;
#pragma unroll
                for (int g = 0; g < 4; ++g) {
                    float v[4];
#pragma unroll
                    for (int j = 0; j < 4; ++j) {
                        const int s = 32 * st + 8 * g + 4 * hh + j;
                        const bool ok = (s <= t) && (t < len) && (s < len);
                        rsum += ok ? acc[4 * g + j] * __expf(la[s] - Mt) : 0.f;
                        v[j] = ok ? acc[4 * g + j] * gT : 0.f;
                    }
                    u32x2 w; w.x = pk2(v[0], v[1]); w.y = pk2(v[2], v[3]);
                    *(u32x2*)(dst + 8 * g) = w;
                }
            }
            atomicAdd(&lrs[t], rsum);
        }
        float dacc0 = 0.f, dacc1 = 0.f;
        {
            const int dp = tid & 255, sh = tid >> 8;
            const bf16_t* kp = KC + (r0 + 64 * sh) * INNER + h * DHC + 2 * dp;
#pragma unroll 8
            for (int s8 = 0; s8 < 64; ++s8) {
                const unsigned w = *(const unsigned*)(kp + (size_t)s8 * INNER);
                const float ws_ = lw[64 * sh + s8];
                dacc0 += ws_ * bflo(w); dacc1 += ws_ * bfhi(w);
            }
            if (sh == 1) { ldn[2 * dp] = dacc0; ldn[2 * dp + 1] = dacc1; }
        }
        __syncthreads();
        if (tid < 256) { DN[(size_t)unit * DHC + 2 * tid] = dacc0 + ldn[2 * tid]; DN[(size_t)unit * DHC + 2 * tid + 1] = dacc1 + ldn[2 * tid + 1]; }
        if (tid < 128) RS[(size_t)unit * 128 + tid] = lrs[tid];
        __syncthreads();
    }
}

DI void p6_mlstm_prompt(const Params& p, const Frame& F) {
    const bf16_t* QF = (const bf16_t*)(p.ws + WS_QF); const bf16_t* KTC = (const bf16_t*)(p.ws + WS_KTC); const bf16_t* VTC = (const bf16_t*)(p.ws + WS_VTC);
    const bf16_t* SD = (const bf16_t*)(p.ws + WS_SD); const float* RS = (const float*)(p.ws + WS_RS); const float* DN = (const float*)(p.ws + WS_DN);
    const float* SA = (const float*)(p.ws + WS_SA); const float* SM = (const float*)(p.ws + WS_SM); const float* SBt = (const float*)(p.ws + WS_SB);
    const float* MPREV = (const float*)(p.ws + WS_MPREV); const float* MTOP = (const float*)(p.ws + WS_MTOP);
    bf16_t* HH = (bf16_t*)(p.ws + WS_HH);
    constexpr int CTS = 520, VTS = 136, SDS = 136;
    bf16_t* CT = (bf16_t*)F.lds;
    bf16_t* VT = (bf16_t*)(F.lds + 66560);
    bf16_t* SDl = (bf16_t*)(F.lds + 66560 + 17408);
    float* nvec = (float*)(F.lds + 118784);
    float* lwi = nvec + 512;
    float* lws = lwi + 128;
    float* lrs = lws + 128;
    float* lel = lrs + 128;
    bf16_t* nb16 = (bf16_t*)(lel + 128);
    bf16_t* hbuf = nb16 + 512;
    const int tid = F.tid, lane = F.lane, wave = F.wave, r31 = lane & 31, hh = lane >> 5;
    const int et2 = wave >> 2, tt = wave & 3;
    for (int unit = F.bid; unit < 256; unit += F.G) {
        const int xcd = unit & 7, jj = unit >> 3, seq = xcd * 4 + (jj >> 3), sl = jj & 7;
        const int b = seq >> 2, h = seq & 3, e0 = sl * 64;
        const size_t rb = (size_t)b * LP;
        f32x16 accC[2][2];
#pragma unroll
        for (int a2 = 0; a2 < 2; ++a2)
#pragma unroll
            for (int c2 = 0; c2 < 2; ++c2) accC[a2][c2] = zero16();
        nvec[tid] = 0.f;
#define P6_QLANE(tz) (QF + ((size_t)(seq * NCH) * 8 + ((tz) >> 6)) * 8192 + ((tz) & 63) * 8)
#define P6_KLANE(tz) (KTC + ((size_t)(seq * NCH) * 8 + ((tz) >> 6)) * 8192 + ((tz) & 63) * 8)
#define P6_VSRC(tz) (VTC + ((size_t)h * DHC + e0 + ((tz) >> 3)) * MPAD + rb + ((tz) & 7) * 16)
#define P6_SSRC(tz) (SD + ((size_t)seq * NCH * 128 + ((tz) >> 2)) * 128 + ((tz) & 3) * 32)
        int tu = tid; asm volatile("" : "+v"(tu));
        const bf16_t* qlane = P6_QLANE(tu); const bf16_t* vsrc = P6_VSRC(tu); const bf16_t* ssrc = P6_SSRC(tu);
        bf16x8 win[16];
#pragma unroll
        for (int u = 0; u < 16; ++u) win[u] = *(const bf16x8*)(qlane + 512 * u);
        u32x4 sv[2], ss[4];
        sv[0] = *(const u32x4*)(vsrc); sv[1] = *(const u32x4*)(vsrc + 8);
#pragma unroll
        for (int q = 0; q < 4; ++q) ss[q] = *(const u32x4*)(ssrc + 8 * q);
        float sa = 0.f, sm = 0.f, sb = 0.f, rs = 0.f, dn = 0.f, decay_prev = 0.f;
        if (tid < 128) { const size_t r = rb + tid; sa = SA[r * 4 + h]; sm = SM[r * 4 + h]; sb = SBt[r * 4 + h]; rs = RS[(size_t)(seq * NCH) * 128 + tid]; }
        float mprev = MPREV[seq * NCH], mtop = MTOP[seq * NCH];
        unsigned pf = 0u;
        for (int c = 0; c < NCH; ++c) {
            const int cu = seq * NCH + c;
            const int t0 = (c == 0) ? 0 : NMETA + 128 * (c - 1), len = (c == 0) ? NMETA : 128;
            const size_t r0 = rb + t0;
            const float decay = __expf(mprev - mtop);
#pragma unroll
            for (int dt = 0; dt < 2; ++dt)
#pragma unroll
                for (int et = 0; et < 2; ++et)
#pragma unroll
                    for (int g = 0; g < 4; ++g) {
                        u32x2 w; w.x = pk2(accC[dt][et][4 * g], accC[dt][et][4 * g + 1]); w.y = pk2(accC[dt][et][4 * g + 2], accC[dt][et][4 * g + 3]);
                        *(u32x2*)(CT + (32 * et + r31) * CTS + 64 * wave + 32 * dt + 8 * g + 4 * hh) = w;
                    }
            if (c == 0 && (tid & 7) != 0) { sv[0] = (u32x4){0u, 0u, 0u, 0u}; sv[1] = (u32x4){0u, 0u, 0u, 0u}; }
            *(u32x4*)(VT + (tid >> 3) * VTS + (tid & 7) * 16) = sv[0]; *(u32x4*)(VT + (tid >> 3) * VTS + (tid & 7) * 16 + 8) = sv[1];
#pragma unroll
            for (int q = 0; q < 4; ++q) *(u32x4*)(SDl + (tid >> 2) * SDS + (tid & 3) * 32 + 8 * q) = ss[q];
            asm volatile("" :: "v"(pf));
            { const float nv = (c > 0) ? decay_prev * nvec[tid] + dn : 0.f; nvec[tid] = nv; nb16[tid] = f2bf(nv); }
            if (tid < 128) {
                const bool v = tid < len;
                lwi[tid] = __expf(mprev - sm); lws[tid] = v ? __expf(sa - mtop) : 0.f; lrs[tid] = rs; lel[tid] = __expf(-(sb + sm));
            }
            __syncthreads();
            {
                const int l15 = lane & 15, kq = lane >> 4;
                const int t = 16 * wave + l15;
                f32x4 acc[4];
#pragma unroll
                for (int q4 = 0; q4 < 4; ++q4) acc[q4] = (f32x4){0.f, 0.f, 0.f, 0.f};
                float qn = 0.f;
                const bf16_t* ap = CT + l15 * CTS + 8 * kq;
                const bf16_t* np_ = nb16 + 8 * kq;
                int tz = tid; asm volatile("" : "+v"(tz));
                const bf16_t* kc0 = P6_KLANE(tz) + (size_t)c * 65536;
#pragma unroll
                for (int ks = 0; ks < 16; ++ks) {
                    const bf16x8 f = win[ks];
#pragma unroll
                    for (int q4 = 0; q4 < 4; ++q4) { const bf16x8 a_ = *(const bf16x8*)(ap + 16 * q4 * CTS + 32 * ks); acc[q4] = __builtin_amdgcn_mfma_f32_16x16x32_bf16(a_, f, acc[q4], 0, 0, 0); }
                    const u32x4 w_ = __builtin_bit_cast(u32x4, f); const u32x4 n_ = *(const u32x4*)(np_ + 32 * ks);
                    qn = __builtin_amdgcn_fdot2_f32_bf16(__builtin_bit_cast(bf16v2, w_.x), __builtin_bit_cast(bf16v2, n_.x), qn, false);
                    qn = __builtin_amdgcn_fdot2_f32_bf16(__builtin_bit_cast(bf16v2, w_.y), __builtin_bit_cast(bf16v2, n_.y), qn, false);
                    qn = __builtin_amdgcn_fdot2_f32_bf16(__builtin_bit_cast(bf16v2, w_.z), __builtin_bit_cast(bf16v2, n_.z), qn, false);
                    qn = __builtin_amdgcn_fdot2_f32_bf16(__builtin_bit_cast(bf16v2, w_.w), __builtin_bit_cast(bf16v2, n_.w), qn, false);
                    win[ks] = *(const bf16x8*)(kc0 + 512 * ks);
                }
                const float wi = lwi[t];
#pragma unroll
                for (int q4 = 0; q4 < 4; ++q4) acc[q4] *= wi;
                const bf16_t* vp = VT + l15 * VTS + 8 * kq;
                const bf16_t* sp = SDl + t * SDS + 8 * kq;
#pragma unroll
                for (int ks = 0; ks < 4; ++ks) {
                    const bf16x8 bq = *(const bf16x8*)(sp + 32 * ks);
#pragma unroll
                    for (int q4 = 0; q4 < 4; ++q4) { const bf16x8 a_ = *(const bf16x8*)(vp + 16 * q4 * VTS + 32 * ks); acc[q4] = __builtin_amdgcn_mfma_f32_16x16x32_bf16(a_, bq, acc[q4], 0, 0, 0); }
                }
                qn += __shfl_xor(qn, 16); qn += __shfl_xor(qn, 32);
                const float den = wi * qn + lrs[t];
                const float inv = 1.f / fmaxf(fabsf(den), lel[t]);
#pragma unroll
                for (int q4 = 0; q4 < 4; ++q4) { u32x2 w; w.x = pk2(acc[q4][0] * inv, acc[q4][1] * inv); w.y = pk2(acc[q4][2] * inv, acc[q4][3] * inv);
                    *(u32x2*)(hbuf + wave * 1024 + l15 * 64 + 16 * q4 + 4 * kq) = w; }
            }
            const int cn = (c + 1 < NCH) ? c + 1 : c;
            const int t0n = (cn == 0) ? 0 : NMETA + 128 * (cn - 1);
            { int tz = tid; asm volatile("" : "+v"(tz)); const bf16_t* vs_ = P6_VSRC(tz) + t0n; const bf16_t* ss_ = P6_SSRC(tz) + (size_t)cn * 16384;
              sv[0] = *(const u32x4*)(vs_); sv[1] = *(const u32x4*)(vs_ + 8);
#pragma unroll
              for (int q = 0; q < 4; ++q) ss[q] = *(const u32x4*)(ss_ + 8 * q); }
            if (tid < 128) { const size_t r = rb + t0n + tid; sa = SA[r * 4 + h]; sm = SM[r * 4 + h]; sb = SBt[r * 4 + h]; rs = RS[(size_t)(seq * NCH + cn) * 128 + tid]; }
            const float mprev_n = MPREV[seq * NCH + cn], mtop_n = MTOP[seq * NCH + cn];
            dn = DN[(size_t)cu * DHC + tid]; decay_prev = decay;
            if (tid < 256) {
                int tz = tid; asm volatile("" : "+v"(tz));
                const int li = sl * 256 + tz;
                const int cq = (c + 2 < NCH) ? c + 2 : NCH - 1, ck = (c + 1 < NCH) ? c + 1 : NCH - 1;
                const bf16_t* a_ = (li < 1024) ? QF + (size_t)(seq * NCH + cq) * 65536 + li * 64 : KTC + (size_t)(seq * NCH + ck) * 65536 + (li - 1024) * 64;
                pf = *(const unsigned*)a_;
            }
            {
#pragma unroll
                for (int dt = 0; dt < 2; ++dt)
#pragma unroll
                    for (int et = 0; et < 2; ++et)
#pragma unroll
                        for (int reg = 0; reg < 16; ++reg) accC[dt][et][reg] *= decay;
                int tz = tid; asm volatile("" : "+v"(tz));
                const bf16_t* qn0 = P6_QLANE(tz) + (size_t)cn * 65536;
                const bf16_t* vp0 = VT + r31 * VTS + 32 * hh;
                const bf16_t* vp1 = vp0 + 32 * VTS;
#pragma unroll
                for (int GP = 0; GP < 4; ++GP) {
                    const int G = GP >> 1, sb0 = 2 * (GP & 1);
                    bf16x8 vs0[2], vs1[2];
#pragma unroll
                    for (int sq = 0; sq < 2; ++sq) { vs0[sq] = *(const bf16x8*)(vp0 + 64 * G + 8 * (sb0 + sq)); vs1[sq] = *(const bf16x8*)(vp1 + 64 * G + 8 * (sb0 + sq)); }
#pragma unroll
                    for (int q = 0; q < 4; ++q) {
                        const int dt = q >> 1, sq = q & 1, i = 8 * G + 4 * dt + sb0 + sq;
                        const bf16x8 f = win[i];
                        if (dt == 0) { accC[0][0] = MFMA32(f, vs0[sq], accC[0][0]); accC[0][1] = MFMA32(f, vs1[sq], accC[0][1]); }
                        else { accC[1][0] = MFMA32(f, vs0[sq], accC[1][0]); accC[1][1] = MFMA32(f, vs1[sq], accC[1][1]); }
                        win[i] = *(const bf16x8*)(qn0 + 512 * i);
                        __builtin_amdgcn_sched_barrier(0);
                    }
                }
            }
            {
                const int tl = lane >> 2, ec = (lane & 3) * 16, t = 16 * wave + tl;
                const u32x4 h0 = *(const u32x4*)(hbuf + wave * 1024 + tl * 64 + ec), h1 = *(const u32x4*)(hbuf + wave * 1024 + tl * 64 + ec + 8);
                if (t < len) { bf16_t* dst = HH + (r0 + t) * INNER + h * DHC + e0 + ec; *(u32x4*)dst = h0; *(u32x4*)(dst + 8) = h1; }
            }
            __syncthreads();
            mprev = mprev_n; mtop = mtop_n;
        }
        {
            nvec[tid] = decay_prev * nvec[tid] + dn;
            float* cb = p.out + O_CP + ((size_t)seq * DHC) * DHC + (size_t)(64 * wave + 4 * hh) * DHC + e0 + r31;
            asm volatile("" : "+v"(cb));
#pragma unroll
            for (int dt = 0; dt < 2; ++dt)
#pragma unroll
                for (int et = 0; et < 2; ++et)
#pragma unroll
                    for (int reg = 0; reg < 16; ++reg) cb[(size_t)(32 * dt + (reg & 3) + 8 * (reg >> 2)) * DHC + 32 * et] = accC[dt][et][reg];
            if (sl == 0) p.out[O_NP + (size_t)seq * DHC + tid] = nvec[tid];
        }
        __syncthreads();
    }
}

DI void p6_mlstm_sample(const Params& p, const Frame& F) {
    const bf16_t* QC = (const bf16_t*)(p.ws + WS_QC); const bf16_t* KC = (const bf16_t*)(p.ws + WS_KC); const bf16_t* VTC = (const bf16_t*)(p.ws + WS_VTC);
    const float* SA = (const float*)(p.ws + WS_SA); const float* SM = (const float*)(p.ws + WS_SM); const float* SBt = (const float*)(p.ws + WS_SB);
    const float* MTOP = (const float*)(p.ws + WS_MTOP);
    bf16_t* HH = (bf16_t*)(p.ws + WS_HH);
    const float* stC = p.in[6]; const float* stn = p.in[7]; const float* stm = p.in[8];
    float* qk = (float*)F.lds;
    float* kraw = qk + 4096;
    float* nl = kraw + 2048;
    float* red = nl + 512;
    float* dots = red + 8192;
    float* sc = dots + 32;
    const int tid = F.tid, lane = F.lane, wave = F.wave;
    f32x4 cA[8], cB[8];
    if (F.bid < BS * HC) {
        const float* C0 = stC + ((size_t)F.bid * DHC + (tid >> 7) * 128) * DHC + (tid & 127) * 4;
#pragma unroll
        for (int u = 0; u < 8; ++u) cA[u] = __builtin_nontemporal_load((const f32x4*)(C0 + (size_t)u * DHC));
    }
    for (int item = F.bid; item < BS * HC; item += F.G) {
        const int sb = item >> 2, h = item & 3;
        const size_t rb = (size_t)MP + sb * 4;
        const float mprev = stm[item], MTc = MTOP[32 * NCH + item];
        const float decay = __expf(mprev - MTc);
        float wsr[4];
#pragma unroll
        for (int s = 0; s < 4; ++s) wsr[s] = __expf(SA[(rb + s) * 4 + h] - MTc);
        {
            const int d = tid;
#pragma unroll
            for (int t = 0; t < 4; ++t) qk[d * 8 + t] = bf2f(QC[(rb + t) * INNER + h * DHC + d]);
#pragma unroll
            for (int s = 0; s < 4; ++s) { const float kv = bf2f(KC[(rb + s) * INNER + h * DHC + d]); kraw[s * 512 + d] = kv; qk[d * 8 + 4 + s] = kv * wsr[s]; }
            nl[d] = stn[(size_t)item * DHC + d];
        }
        const int e4 = tid & 127, dg = tid >> 7;
        f32x4 vr[4];
        {
#pragma unroll
            for (int j = 0; j < 4; ++j) {
                const u32x2 w = *(const u32x2*)(VTC + ((size_t)h * DHC + e4 * 4 + j) * MPAD + rb);
                vr[0][j] = bflo(w.x); vr[1][j] = bfhi(w.x); vr[2][j] = bflo(w.y); vr[3][j] = bfhi(w.y);
            }
        }
        __syncthreads();
#pragma unroll
        for (int rep = 0; rep < 3; ++rep) {
            const int di = wave + 8 * rep;
            if (di < 20) {
                const int t = (di < 16) ? (di >> 2) : (di - 16);
                const float* other = (di < 16) ? (kraw + (di & 3) * 512) : nl;
                float acc = 0.f;
#pragma unroll
                for (int k = 0; k < 8; ++k) { const int d = lane + 64 * k; acc += qk[d * 8 + t] * other[d]; }
                acc = wave_sum(acc);
                if (lane == 0) dots[di] = acc;
            }
        }
        __syncthreads();
        if (tid < 4) {
            const int t = tid;
            const float M = SM[(rb + t) * 4 + h], bt = SBt[(rb + t) * 4 + h];
            const float wi = __expf(mprev - M);
            float rs = 0.f;
#pragma unroll
            for (int s = 0; s < 4; ++s) {
                const float v = (s <= t) ? dots[t * 4 + s] * __expf(SA[(rb + s) * 4 + h] - M) : 0.f;
                sc[16 + t * 4 + s] = v; rs += v;
            }
            const float den = wi * dots[16 + t] + rs;
            sc[t] = wi; sc[8 + t] = 1.f / fmaxf(fabsf(den), __expf(-(bt + M)));
        }
        f32x4 it[4];
#pragma unroll
        for (int t = 0; t < 4; ++t) it[t] = (f32x4){0.f, 0.f, 0.f, 0.f};
        {
            const float* Cin = stC + ((size_t)item * DHC + dg * 128) * DHC + e4 * 4;
            float* Cout = p.out + O_CS + ((size_t)item * DHC + dg * 128) * DHC + e4 * 4;
            const int nitem = (item + F.G < BS * HC) ? item + F.G : item;
            const float* Cnx = stC + ((size_t)nitem * DHC + dg * 128) * DHC + e4 * 4;
#define MS_LOAD(buf, base, bt) do { _Pragma("unroll") for (int u_ = 0; u_ < 8; ++u_) buf[u_] = __builtin_nontemporal_load((const f32x4*)((base) + (size_t)((bt) * 8 + u_) * DHC)); } while (0)
#define MS_USE(buf, bt) do { _Pragma("unroll") for (int u_ = 0; u_ < 8; ++u_) { const int d_ = dg * 128 + (bt) * 8 + u_; \
                const f32x4 qv_ = *(const f32x4*)(qk + d_ * 8), kw_ = *(const f32x4*)(qk + d_ * 8 + 4); \
                _Pragma("unroll") for (int t_ = 0; t_ < 4; ++t_) it[t_] += buf[u_] * qv_[t_]; \
                f32x4 cn_ = buf[u_] * decay; \
                _Pragma("unroll") for (int s_ = 0; s_ < 4; ++s_) cn_ += vr[s_] * kw_[s_]; \
                __builtin_nontemporal_store(cn_, (f32x4*)(Cout + (size_t)((bt) * 8 + u_) * DHC)); } } while (0)
            for (int bt = 0; bt < 16; bt += 2) {
                MS_LOAD(cB, Cin, bt + 1); MS_USE(cA, bt);
                if (bt + 2 < 16) MS_LOAD(cA, Cin, bt + 2); else MS_LOAD(cA, Cnx, 0);
                MS_USE(cB, bt + 1);
            }
#undef MS_LOAD
#undef MS_USE
        }
#pragma unroll
        for (int t = 0; t < 4; ++t) *(f32x4*)(red + (dg * 4 + t) * 512 + e4 * 4) = it[t];
        __syncthreads();
        {
            const int e = tid;
            float vcol[4];
            { const u32x2 w = *(const u32x2*)(VTC + ((size_t)h * DHC + e) * MPAD + rb); vcol[0] = bflo(w.x); vcol[1] = bfhi(w.x); vcol[2] = bflo(w.y); vcol[3] = bfhi(w.y); }
#pragma unroll
            for (int t = 0; t < 4; ++t) {
                const float inter = (red[(0 * 4 + t) * 512 + e] + red[(1 * 4 + t) * 512 + e]) + (red[(2 * 4 + t) * 512 + e] + red[(3 * 4 + t) * 512 + e]);
                float num = sc[t] * inter;
#pragma unroll
                for (int s = 0; s < 4; ++s) num += sc[16 + t * 4 + s] * vcol[s];
                HH[(rb + t) * INNER + h * DHC + e] = f2bf(num * sc[8 + t]);
            }
            float nn = decay * nl[tid];
#pragma unroll
            for (int s = 0; s < 4; ++s) nn += qk[tid * 8 + 4 + s];
            p.out[O_NS + (size_t)item * DHC + tid] = nn;
        }
        __syncthreads();
    }
}

DI void p6c_prep_out(const Params& p, const Frame& F) {
    const bf16_t* HH = (const bf16_t*)(p.ws + WS_HH); const bf16_t* CA = (const bf16_t*)(p.ws + WS_CA); const bf16_t* XMZ = (const bf16_t*)(p.ws + WS_XMZ);
    bf16_t* A2 = (bf16_t*)(p.ws + WS_A2);
    const float* skip = p.in[25]; const float* ong = p.in[26];
    const int gw = F.bid * 8 + F.wave, nw = F.G * 8, lane = F.lane;
    for (int task = gw; task < MT * 2; task += nw) {
        const int r = task >> 1, hbase = (task & 1) * 2;
        const float* ong_ = ong; const float* skip_ = skip; asm volatile("" : "+s"(ong_), "+s"(skip_));
        u32x4 hw[2], cw4[2], zw[2];
#pragma unroll
        for (int h = 0; h < 2; ++h) {
            const int c = (hbase + h) * DHC + lane * 8;
            hw[h] = *(const u32x4*)(HH + (size_t)r * INNER + c); cw4[h] = *(const u32x4*)(CA + (size_t)r * INNER + c); zw[h] = *(const u32x4*)(XMZ + (size_t)r * 4096 + INNER + c);
        }
#pragma unroll
        for (int h = 0; h < 2; ++h) {
            const int c = (hbase + h) * DHC + lane * 8;
            float x[8] = {bflo(hw[h].x), bfhi(hw[h].x), bflo(hw[h].y), bfhi(hw[h].y), bflo(hw[h].z), bfhi(hw[h].z), bflo(hw[h].w), bfhi(hw[h].w)};
            float sm_ = 0.f;
#pragma unroll
            for (int k = 0; k < 8; ++k) sm_ += x[k];
            const float mu = wave_sum(sm_) * (1.f / DHC);
            float q = 0.f;
#pragma unroll
            for (int k = 0; k < 8; ++k) { x[k] -= mu; q += x[k] * x[k]; }
            const float rstd = rsqrtf(wave_sum(q) * (1.f / DHC) + EPS);
            const float cav[8] = {bflo(cw4[h].x), bfhi(cw4[h].x), bflo(cw4[h].y), bfhi(cw4[h].y), bflo(cw4[h].z), bfhi(cw4[h].z), bflo(cw4[h].w), bfhi(cw4[h].w)};
            const float zv[8] = {bflo(zw[h].x), bfhi(zw[h].x), bflo(zw[h].y), bfhi(zw[h].y), bflo(zw[h].z), bfhi(zw[h].z), bflo(zw[h].w), bfhi(zw[h].w)};
            const f32x4 g0 = *(const f32x4*)(ong_ + c), g1 = *(const f32x4*)(ong_ + c + 4), s0 = *(const f32x4*)(skip_ + c), s1 = *(const f32x4*)(skip_ + c + 4);
            const float gv[8] = {g0[0], g0[1], g0[2], g0[3], g1[0], g1[1], g1[2], g1[3]};
            const float sv[8] = {s0[0], s0[1], s0[2], s0[3], s1[0], s1[1], s1[2], s1[3]};
            float o[8];
#pragma unroll
            for (int k = 0; k < 8; ++k) o[k] = (x[k] * rstd * gv[k] + sv[k] * cav[k]) * silu_f(zv[k]);
            u32x4 w; w.x = pk2(o[0], o[1]); w.y = pk2(o[2], o[3]); w.z = pk2(o[4], o[5]); w.w = pk2(o[6], o[7]);
            *(u32x4*)(A2 + (size_t)r * INNER + c) = w;
        }
    }
    const int gt = F.bid * NTHREADS + F.tid, nt = F.G * NTHREADS;
    for (int idx = gt; idx < (MPAD - MT) * (INNER / 8); idx += nt) *(u32x4*)(A2 + (size_t)MT * INNER + (size_t)idx * 8) = (u32x4){0u, 0u, 0u, 0u};
}

DI void p8_final_norm(const Params& p, const Frame& F) {
    const bf16_t* HB = (const bf16_t*)(p.ws + WS_H); const float* gf = p.in[12]; const float* PART = (const float*)(p.ws + WS_PART);
    const int gw = F.bid * 8 + F.wave, nw = F.G * 8, lane = F.lane;
    constexpr int RB = 4;
    for (int r0 = gw * RB; r0 < MT; r0 += nw * RB) {
        float* dst;
        if (r0 < MP) { const int b = r0 / LP, t = r0 - b * LP; if (t < NMETA) continue; dst = p.out + O_YP + ((size_t)b * SEQ + (t - NMETA)) * D; }
        else dst = p.out + O_YS + (size_t)(r0 - MP) * D;
        u32x4 hw[RB][2];
#pragma unroll
        for (int rr = 0; rr < RB; ++rr)
#pragma unroll
            for (int j = 0; j < 2; ++j) hw[rr][j] = *(const u32x4*)(HB + (size_t)(r0 + rr) * D + j * 512 + lane * 8);
#pragma unroll
        for (int rr = 0; rr < RB; ++rr) {
            float v[2][8]; float ss = 0.f;
#pragma unroll
            for (int j = 0; j < 2; ++j) {
                const u32x4 w = hw[rr][j];
                v[j][0] = bflo(w.x); v[j][1] = bfhi(w.x); v[j][2] = bflo(w.y); v[j][3] = bfhi(w.y); v[j][4] = bflo(w.z); v[j][5] = bfhi(w.z); v[j][6] = bflo(w.w); v[j][7] = bfhi(w.w);
                if (r0 >= MMAIN) {
#pragma unroll
                    for (int ks = 0; ks < 8; ++ks) {
                        const float* pp = PART + ((size_t)ks * 768 + (r0 + rr - MMAIN)) * D + j * 512 + lane * 8;
                        const f32x4 a0 = *(const f32x4*)pp, a1 = *(const f32x4*)(pp + 4);
                        v[j][0] += a0[0]; v[j][1] += a0[1]; v[j][2] += a0[2]; v[j][3] += a0[3]; v[j][4] += a1[0]; v[j][5] += a1[1]; v[j][6] += a1[2]; v[j][7] += a1[3];
                    }
                }
#pragma unroll
                for (int k = 0; k < 8; ++k) ss += v[j][k] * v[j][k];
            }
            const float rstd = rsqrtf(wave_sum(ss) * (1.f / D) + EPS);
#pragma unroll
            for (int j = 0; j < 2; ++j) {
                const int c = j * 512 + lane * 8;
                const f32x4 ga = *(const f32x4*)(gf + c), gb = *(const f32x4*)(gf + c + 4);
                *(f32x4*)(dst + (size_t)rr * D + c) = (f32x4){v[j][0] * rstd * ga[0], v[j][1] * rstd * ga[1], v[j][2] * rstd * ga[2], v[j][3] * rstd * ga[3]};
                *(f32x4*)(dst + (size_t)rr * D + c + 4) = (f32x4){v[j][4] * rstd * gb[0], v[j][5] * rstd * gb[1], v[j][6] * rstd * gb[2], v[j][7] * rstd * gb[3]};
            }
        }
    }
}

DI Params fresh_params() {
    Params q;
#if defined(__HIP_DEVICE_COMPILE__)
    const __attribute__((address_space(4))) unsigned long long* k = (const __attribute__((address_space(4))) unsigned long long*)__builtin_amdgcn_kernarg_segment_ptr();
    asm volatile("" : "+s"(k));
#pragma unroll
    for (int i = 0; i < 28; ++i) q.in[i] = (const float*)(const __attribute__((address_space(1))) float*)k[i];
    q.out = (float*)(__attribute__((address_space(1))) float*)k[28]; q.ws = (unsigned char*)(__attribute__((address_space(1))) unsigned char*)k[29];
    const unsigned long long w = k[30]; q.ph_lo = (int)(unsigned)w; q.ph_hi = (int)(unsigned)(w >> 32);
#else
    q = Params{};
#endif
    return q;
}

constexpr int NPHASE = 14;
__global__ void __launch_bounds__(NTHREADS, 2) fwd_kernel(Params p_unused) {
    extern __shared__ __attribute__((aligned(16))) unsigned char lds_raw[];
    LAS unsigned char* ldsl = (LAS unsigned char*)lds_raw;
    volatile LAS unsigned* ctl = (volatile LAS unsigned*)(ldsl + LDS_CTL_OFF);
    if (threadIdx.x < 4) ctl[threadIdx.x] = 0u;
    __syncthreads();
    int lo, hi; unsigned* barw; { const Params q = fresh_params(); lo = q.ph_lo; hi = q.ph_hi; barw = (unsigned*)(q.ws + WS_CTL); }
    XcdBarrier bar; bar.bar = barw; bar.x = 0; bar.st = ctl;
    if (hi - lo > 1) bar = xcd_barrier_post(barw, ctl);
#ifndef PHMASK
#define PHMASK 0xFFFFFFFFu
#endif
#define IN(k) ((((PHMASK) >> (k)) & 1u) && lo <= (k) && (k) < hi)
#define SEAM(k) do { if (IN(k) && IN((k) + 1)) xcd_barrier(bar); } while (0)

    if (IN(0)) { const Params p = fresh_params(); const Frame F = make_frame(lds_raw); p0_prologue(p, F); }
    SEAM(0);
    if (IN(1)) {
        const Params p = fresh_params(); const Frame F = make_frame(lds_raw); unsigned char* ws = p.ws;
        pg8::Gemm g{(const bf16_t*)(ws + WS_XN), (const bf16_t*)(ws + WS_WTINA), D, D, D};
        pg8::InAOrder S{F.G, F.bid};
        EpiInA E{(bf16_t*)(ws + WS_PROJA), (float*)(ws + WS_U32), p.out, (bf16_t*)(ws + WS_VTA)};
        pg8::gemm_phase(ldsl, g, S, E);
    }
    SEAM(1);
    if (IN(2)) {
        const bool sample_first = ((blockIdx.x >> 3) & 1) == 0;
        if (sample_first) { const Params p = fresh_params(); const Frame F = make_frame(lds_raw); p2_attn_sample(p, F); }
        { const Params p = fresh_params(); const Frame F = make_frame(lds_raw); p2_attn_prompt(p, F); }
        { const Params p = fresh_params(); const Frame F = make_frame(lds_raw); p2_pool(p, F); }
        if (!sample_first) { const Params p = fresh_params(); const Frame F = make_frame(lds_raw); p2_attn_sample(p, F); }
    }
    SEAM(2);
    if (IN(3)) { const Params p = fresh_params(); const Frame F = make_frame(lds_raw); p2d_combine(p, F); }
    SEAM(3);
    if (IN(4)) {
        const Params p = fresh_params(); const Frame F = make_frame(lds_raw); unsigned char* ws = p.ws;
        {
            pg8::Gemm g{(const bf16_t*)(ws + WS_MIXED), (const bf16_t*)(ws + WS_WTOUTA), D, D, D};
            pg8::StaticOrder<0> S; S.init(MMAIN, D, F.G, F.bid);
            EpiResX E{(bf16_t*)(ws + WS_H), p.in[0], p.in[1], p.in[10]};
            pg8::gemm_phase(ldsl, g, S, E);
        }
        {
            pg8::Gemm g{(const bf16_t*)(ws + WS_MIXED), (const bf16_t*)(ws + WS_WTOUTA), D, D, 256};
            pg8::TailOrder S; S.init(4, 256, F.G, (F.bid + 128) % F.G);
            EpiPart E{(float*)(ws + WS_PART), 256};
            pg8::gemm_phase(ldsl, g, S, E);
        }
    }
    SEAM(4);
    if (IN(5)) { const Params p = fresh_params(); const Frame F = make_frame(lds_raw); p3b_norm_gates(p, F); }
    SEAM(5);
    if (IN(6)) {
        const Params p = fresh_params(); const Frame F = make_frame(lds_raw); unsigned char* ws = p.ws;
        p4_scan(p, F);
        pg8::Gemm g{(const bf16_t*)(ws + WS_XN), (const bf16_t*)(ws + WS_WTINC), D, D, D};
        pg8::InCMainOrder S{F.G, F.bid};
        EpiInC E{(bf16_t*)(ws + WS_XMZ), p.out};
        pg8::gemm_phase(ldsl, g, S, E);
    }
    SEAM(6);
    if (IN(7)) {
        { const Params p = fresh_params(); const Frame F = make_frame(lds_raw); p4b_conv(p, F); }
        {
            const Params p = fresh_params(); const Frame F = make_frame(lds_raw);
            bf16_t* KTC = (bf16_t*)(p.ws + WS_KTC);
            for (int idx = F.bid * NTHREADS + F.tid; idx < 32 * 8192; idx += F.G * NTHREADS)
                *(u32x4*)(KTC + (size_t)(idx >> 13) * NCH * 65536 + (size_t)(idx & 8191) * 8) = (u32x4){0u, 0u, 0u, 0u};
        }
    }
    SEAM(7);
    if (IN(8)) {
        const Params p = fresh_params(); const Frame F = make_frame(lds_raw); unsigned char* ws = p.ws;
        {
            pg8::Gemm g{(const bf16_t*)(ws + WS_CA), (const bf16_t*)(ws + WS_WTQ), INNER, DHC, DHC};
            pg8::StaticOrder<1> S; S.init(MPAD, 4096, F.G, F.bid);
            EpiQK E{(bf16_t*)(ws + WS_QC), (bf16_t*)(ws + WS_KC), (bf16_t*)(ws + WS_KTC), (bf16_t*)(ws + WS_QF)};
            pg8::gemm_phase(ldsl, g, S, E);
        }
        {
            pg8::Gemm g{(const bf16_t*)(ws + WS_XN), (const bf16_t*)(ws + WS_WTINC), D, D, D};
            pg8::InCTailOrder S{F.G, F.bid};
            EpiInC E{(bf16_t*)(ws + WS_XMZ), p.out};
            pg8::gemm_phase(ldsl, g, S, E);
        }
        {
            pg8::Gemm g{(const bf16_t*)(ws + WS_WTV), (const bf16_t*)(ws + WS_XMZ), DHC, 4096, DHC};
            pg8::VtOrder S{F.G, F.bid};
            EpiVTs E{(bf16_t*)(ws + WS_VTC), (const float*)(ws + WS_SA), (const float*)(ws + WS_MTOP)};
            pg8::gemm_phase(ldsl, g, S, E);
        }
    }
    SEAM(8);
    if (IN(9)) { const Params p = fresh_params(); const Frame F = make_frame(lds_raw); p5b_chunk_scores(p, F); }
    SEAM(9);
    if (IN(10)) {
        const bool sample_first = ((blockIdx.x >> 6) & 1) == 0;
        if (sample_first) { const Params p = fresh_params(); const Frame F = make_frame(lds_raw); p6_mlstm_sample(p, F); }
        { const Params p = fresh_params(); const Frame F = make_frame(lds_raw); p6_mlstm_prompt(p, F); }
        if (!sample_first) { const Params p = fresh_params(); const Frame F = make_frame(lds_raw); p6_mlstm_sample(p, F); }
    }
    SEAM(10);
    if (IN(11)) { const Params p = fresh_params(); const Frame F = make_frame(lds_raw); p6c_prep_out(p, F); }
    SEAM(11);
    if (IN(12)) {
        const Params p = fresh_params(); const Frame F = make_frame(lds_raw); unsigned char* ws = p.ws;
        {
            pg8::Gemm g{(const bf16_t*)(ws + WS_A2), (const bf16_t*)(ws + WS_WTOUTC), INNER, INNER, INNER};
            pg8::StaticOrder<0> S; S.init(MMAIN, D, F.G, F.bid);
            EpiAddHB E{(bf16_t*)(ws + WS_H)};
            pg8::gemm_phase(ldsl, g, S, E);
        }
        {
            pg8::Gemm g{(const bf16_t*)(ws + WS_A2), (const bf16_t*)(ws + WS_WTOUTC), INNER, INNER, 256};
            pg8::TailOrder S; S.init(8, 256, F.G, (F.bid + 128) % F.G);
            EpiPart E{(float*)(ws + WS_PART), 256};
            pg8::gemm_phase(ldsl, g, S, E);
        }
    }
    SEAM(12);
    if (IN(13)) { const Params p = fresh_params(); const Frame F = make_frame(lds_raw); p8_final_norm(p, F); }
#undef IN
#undef SEAM
}

#ifndef MK_ONE_LAUNCH
#define MK_ONE_LAUNCH 1
#endif

extern "C" void kernel_launch(void* const* d_in, const int* in_sizes, int n_in, void* d_out, int out_size, void* d_ws, size_t ws_size, hipStream_t stream) {
    static int grid = 0;
    if (grid == 0) {
        if (n_in != 28 || (size_t)out_size != O_END || ws_size < WS_END) {
            fprintf(stderr, "kernel_launch: unexpected shapes: n_in %d out %d (want %zu) ws %zu (want >= %zu)\n", n_in, out_size, (size_t)O_END, ws_size, (size_t)WS_END);
            grid = -1; return;
        }
        int dev = 0, cus = 0, per_cu = 0;
        if (hipGetDevice(&dev) != hipSuccess || hipDeviceGetAttribute(&cus, hipDeviceAttributeMultiprocessorCount, dev) != hipSuccess) { grid = -1; return; }
        if (hipFuncSetAttribute((const void*)fwd_kernel, hipFuncAttributeMaxDynamicSharedMemorySize, LDS_BYTES) != hipSuccess) { fprintf(stderr, "kernel_launch: hipFuncSetAttribute failed\n"); grid = -1; return; }
        if (hipOccupancyMaxActiveBlocksPerMultiprocessor(&per_cu, (const void*)fwd_kernel, NTHREADS, LDS_BYTES) != hipSuccess || per_cu < 1)
            fprintf(stderr, "kernel_launch: occupancy query reports %d workgroups per CU\n", per_cu);
        (void)hipGetLastError();
        grid = cus;
    }
    if (grid < 0) return;
    (void)hipMemsetAsync((char*)d_ws + WS_CTL, 0, 65536, stream);
    Params p{};
    for (int i = 0; i < 28; ++i) p.in[i] = (const float*)d_in[i];
    p.out = (float*)d_out; p.ws = (unsigned char*)d_ws;
#if MK_ONE_LAUNCH
    p.ph_lo = 0; p.ph_hi = NPHASE;
    hipLaunchKernelGGL(fwd_kernel, dim3(grid), dim3(NTHREADS), LDS_BYTES, stream, p);
#else
    for (int k = 0; k < NPHASE; ++k) { p.ph_lo = k; p.ph_hi = k + 1; hipLaunchKernelGGL(fwd_kernel, dim3(grid), dim3(NTHREADS), LDS_BYTES, stream, p); }
#endif
}
```
